# Optimizing an MI355X kernel written in HIP

```python
import math
import jax, jax.numpy as jnp
from jax import lax
import numpy as np

D_MODEL = 1024
BATCH = 8
SEQ = 2048
DEPTH = 2
DEC_BATCH = 128
DEC_SEQ = 8
PAST_LEN = 16384
PAGE_SIZE = 128

N_AB_LAYERS = (DEPTH + 1) // 2
N_C_LAYERS = DEPTH // 2
A_HEADS = 16
A_HEAD_DIM = 64
A_D_INNER = A_HEADS * A_HEAD_DIM
A_GROUPS = 4
A_STATE = 128
A_CONV = 4
A_CONV_DIM = A_D_INNER + 2 * A_GROUPS * A_STATE
A_CHUNK = 128
A_PROJ = A_D_INNER + A_CONV_DIM + A_HEADS
B_CH = 1024
B_GROUP_CH = 16
B_GROUPS = B_CH // B_GROUP_CH
B_STATE = 64
IN_COLS = A_PROJ + B_CH
MIX_WIDTH = A_D_INNER + B_CH
C_CH = D_MODEL
C_WIDTH = 31
D_FF = 4 * D_MODEL
EPS = 1e-6

kernel_name = "hybrid_ssd_s5_conformer_decode_step"


def rms_norm(x, w):
    xf = x.astype(jnp.float32)
    y = xf * lax.rsqrt(jnp.mean(xf * xf, axis=-1, keepdims=True) + EPS)
    return (y * w.astype(jnp.float32)).astype(x.dtype)


def layer_norm(x, w, b):
    xf = x.astype(jnp.float32)
    mu = jnp.mean(xf, axis=-1, keepdims=True)
    xc = xf - mu
    y = xc * lax.rsqrt(jnp.mean(xc * xc, axis=-1, keepdims=True) + EPS)
    return (y * w.astype(jnp.float32) + b.astype(jnp.float32)).astype(x.dtype)


def causal_depthwise_conv(x, buf, w, b):
    width = w.shape[0]
    xp = jnp.concatenate([buf.astype(x.dtype), x], axis=1)
    y = lax.conv_general_dilated(xp, w.astype(x.dtype)[:, None, :], window_strides=(1,), padding="VALID",
                                 dimension_numbers=("NWC", "WIO", "NWC"), feature_group_count=x.shape[-1])
    return y + b.astype(x.dtype), xp[:, xp.shape[1] - (width - 1):]


def ssd_chunked_scan(xh, dt, a, bm, cm, h0):
    f32 = jnp.float32
    bsz, seqlen = xh.shape[0], xh.shape[1]
    q = math.gcd(seqlen, A_CHUNK)
    nc = seqlen // q
    hpg = A_HEADS // A_GROUPS
    xf = xh.astype(f32).reshape(bsz, nc, q, A_GROUPS, hpg, A_HEAD_DIM)
    dtc = dt.reshape(bsz, nc, q, A_GROUPS, hpg)
    bc = bm.astype(f32).reshape(bsz, nc, q, A_GROUPS, A_STATE)
    cc = cm.astype(f32).reshape(bsz, nc, q, A_GROUPS, A_STATE)
    cum = jnp.cumsum(dtc * a.reshape(A_GROUPS, hpg), axis=2)
    causal = jnp.tril(jnp.ones((q, q), dtype=bool))[:, :, None, None]
    seg = cum[:, :, :, None] - cum[:, :, None, :]
    decay = jnp.exp(jnp.where(causal, seg, -jnp.inf))
    scores = jnp.einsum("bcign,bcjgn->bcijg", cc, bc)
    y_diag = jnp.einsum("bcijge,bcjgep->bcigep", scores[..., None] * decay * dtc[:, :, None], xf)
    decay_end = jnp.exp(cum[:, :, -1:] - cum)
    chunk_states = jnp.einsum("bcjgn,bcjge,bcjgep->bcgepn", bc, decay_end * dtc, xf)
    chunk_decay = jnp.exp(cum[:, :, -1])

    def carry_step(h, inp):
        dec, st = inp
        return h * dec[..., None, None] + st, h

    h_start = h0.astype(f32).reshape(bsz, A_GROUPS, hpg, A_HEAD_DIM, A_STATE)
    h_final, h_in = lax.scan(carry_step, h_start,
                             (jnp.moveaxis(chunk_decay, 1, 0), jnp.moveaxis(chunk_states, 1, 0)))
    h_in = jnp.moveaxis(h_in, 0, 1)
    y_off = jnp.einsum("bcign,bcgepn,bcige->bcigep", cc, h_in, jnp.exp(cum))
    y = (y_diag + y_off).reshape(bsz, seqlen, A_HEADS, A_HEAD_DIM)
    return y, h_final.reshape(bsz, A_HEADS, A_HEAD_DIM, A_STATE)


def mamba2_mixer(proj, conv_buf, ssm_state, conv_w, conv_b, dt_bias, a_log, d_skip, norm_w):
    f32 = jnp.float32
    bsz, seqlen = proj.shape[0], proj.shape[1]
    z = proj[..., :A_D_INNER]
    xbc = proj[..., A_D_INNER:A_D_INNER + A_CONV_DIM]
    dt_raw = proj[..., A_D_INNER + A_CONV_DIM:]
    xbc, new_buf = causal_depthwise_conv(xbc, conv_buf, conv_w, conv_b)
    xbc = jax.nn.silu(xbc)
    xh = xbc[..., :A_D_INNER].reshape(bsz, seqlen, A_HEADS, A_HEAD_DIM)
    bm = xbc[..., A_D_INNER:A_D_INNER + A_GROUPS * A_STATE].reshape(bsz, seqlen, A_GROUPS, A_STATE)
    cm = xbc[..., A_D_INNER + A_GROUPS * A_STATE:].reshape(bsz, seqlen, A_GROUPS, A_STATE)
    dt = jax.nn.softplus(dt_raw.astype(f32) + dt_bias.astype(f32))
    a = -jnp.exp(a_log.astype(f32))
    y, h_final = ssd_chunked_scan(xh, dt, a, bm, cm, ssm_state)
    y = y + d_skip.astype(f32)[:, None] * xh.astype(f32)
    g = (y.reshape(bsz, seqlen, A_D_INNER) * jax.nn.silu(z.astype(f32)))
    g = g.reshape(bsz, seqlen, A_GROUPS, A_D_INNER // A_GROUPS)
    g = g * lax.rsqrt(jnp.mean(g * g, axis=-1, keepdims=True) + EPS)
    y = g.reshape(bsz, seqlen, A_D_INNER) * norm_w.astype(f32)
    return y.astype(proj.dtype), new_buf, h_final


def complex_affine_combine(left, right):
    ar_l, ai_l, br_l, bi_l = left
    ar_r, ai_r, br_r, bi_r = right
    ar = ar_r * ar_l - ai_r * ai_l
    ai = ar_r * ai_l + ai_r * ar_l
    br = ar_r * br_l - ai_r * bi_l + br_r
    bi = ar_r * bi_l + ai_r * br_l + bi_r
    return ar, ai, br, bi


def s5_mixer(u, h0_re, h0_im, lam_re, lam_im, log_step, b_re, b_im, c_re, c_im, d_skip, w_glu, b_glu):
    f32 = jnp.float32
    bsz, seqlen = u.shape[0], u.shape[1]
    uf = u.astype(f32).reshape(bsz, seqlen, B_GROUPS, B_GROUP_CH)
    lr, li = lam_re.astype(f32), lam_im.astype(f32)
    step = jnp.exp(log_step.astype(f32))[:, None]
    mag = jnp.exp(lr * step)
    ab_re, ab_im = mag * jnp.cos(li * step), mag * jnp.sin(li * step)
    den = lr * lr + li * li
    k_re = ((ab_re - 1.0) * lr + ab_im * li) / den
    k_im = (ab_im * lr - (ab_re - 1.0) * li) / den
    br, bi = b_re.astype(f32), b_im.astype(f32)
    bb_re = k_re[..., None] * br - k_im[..., None] * bi
    bb_im = k_re[..., None] * bi + k_im[..., None] * br
    bu_re = jnp.einsum("gpc,blgc->blgp", bb_re, uf)
    bu_im = jnp.einsum("gpc,blgc->blgp", bb_im, uf)
    a_re = jnp.broadcast_to(ab_re, (1, seqlen, B_GROUPS, B_STATE))
    a_im = jnp.broadcast_to(ab_im, (1, seqlen, B_GROUPS, B_STATE))
    p_re, p_im, h_re, h_im = lax.associative_scan(complex_affine_combine, (a_re, a_im, bu_re, bu_im), axis=1)
    s_re, s_im = h0_re.astype(f32)[:, None], h0_im.astype(f32)[:, None]
    h_re = h_re + p_re * s_re - p_im * s_im
    h_im = h_im + p_re * s_im + p_im * s_re
    y = (jnp.einsum("gcp,blgp->blgc", c_re.astype(f32), h_re)
         - jnp.einsum("gcp,blgp->blgc", c_im.astype(f32), h_im)
         + d_skip.astype(f32) * uf)
    y = jax.nn.gelu(y.reshape(bsz, seqlen, B_CH)).astype(u.dtype)
    out = y * jax.nn.sigmoid(y @ w_glu + b_glu)
    return out, h_re[:, -1], h_im[:, -1]


def conformer_conv_module(xn, buf, w_pw1, b_pw1, w_dw, b_dw, ln_w, ln_b, w_pw2, b_pw2):
    h = xn @ w_pw1 + b_pw1
    h = h[..., :C_CH] * jax.nn.sigmoid(h[..., C_CH:])
    h, new_buf = causal_depthwise_conv(h, buf, w_dw, b_dw)
    h = jax.nn.silu(layer_norm(h, ln_w, ln_b))
    return h @ w_pw2 + b_pw2, new_buf


def run_trunk(x, a_conv_state, a_ssm_state, b_state_re, b_state_im, c_conv_state, p):
    new_a_conv, new_a_ssm, new_b_re, new_b_im, new_c_conv = [], [], [], [], []
    ab_i = 0
    c_i = 0
    for layer in range(DEPTH):
        xn = rms_norm(x, p["norm_mix"][layer])
        if layer % 2 == 0:
            proj = xn @ p["w_in_ab"][ab_i]
            ya, buf_a, h_a = mamba2_mixer(proj[..., :A_PROJ], a_conv_state[ab_i], a_ssm_state[ab_i],
                                          p["a_conv_w"][ab_i], p["a_conv_b"][ab_i], p["a_dt_bias"][ab_i],
                                          p["a_log"][ab_i], p["a_d"][ab_i], p["a_norm"][ab_i])
            yb, hb_re, hb_im = s5_mixer(proj[..., A_PROJ:], b_state_re[ab_i], b_state_im[ab_i],
                                        p["s5_lam_re"][ab_i], p["s5_lam_im"][ab_i], p["s5_log_step"][ab_i],
                                        p["s5_b_re"][ab_i], p["s5_b_im"][ab_i], p["s5_c_re"][ab_i],
                                        p["s5_c_im"][ab_i], p["s5_d"][ab_i], p["s5_w_glu"][ab_i],
                                        p["s5_b_glu"][ab_i])
            x = x + jnp.concatenate([ya, yb], axis=-1) @ p["w_out_ab"][ab_i]
            new_a_conv.append(buf_a)
            new_a_ssm.append(h_a)
            new_b_re.append(hb_re)
            new_b_im.append(hb_im)
            ab_i += 1
        else:
            yc, buf_c = conformer_conv_module(xn, c_conv_state[c_i], p["c_w_pw1"][c_i], p["c_b_pw1"][c_i],
                                              p["c_w_dw"][c_i], p["c_b_dw"][c_i], p["c_ln_w"][c_i],
                                              p["c_ln_b"][c_i], p["c_w_pw2"][c_i], p["c_b_pw2"][c_i])
            x = x + yc
            new_c_conv.append(buf_c)
            c_i += 1
        xn = rms_norm(x, p["norm_ff"][layer])
        x = x + jnp.square(jax.nn.relu(xn @ p["w_ff1"][layer])) @ p["w_ff2"][layer]
    y = rms_norm(x, p["norm_final"])
    return (y, jnp.stack(new_a_conv), jnp.stack(new_a_ssm), jnp.stack(new_b_re), jnp.stack(new_b_im),
            jnp.stack(new_c_conv))


def setup_inputs(seed: int = 0) -> dict:
    key = jax.random.key(seed)
    ks = iter(jax.random.split(key, 64))
    f32 = jnp.float32

    def nrm(shape, scale):
        return scale * jax.random.normal(next(ks), shape, f32)

    def unif(shape, lo, hi):
        return jax.random.uniform(next(ks), shape, f32, lo, hi)

    n_ab, n_c = N_AB_LAYERS, N_C_LAYERS
    x_prompt = nrm((BATCH, SEQ, D_MODEL), 1.0)
    x_sample = nrm((DEC_BATCH, DEC_SEQ, D_MODEL), 1.0)
    state_a_conv = nrm((n_ab, DEC_BATCH, A_CONV - 1, A_CONV_DIM), 1.0)
    state_a_ssm = nrm((n_ab, DEC_BATCH, A_HEADS, A_HEAD_DIM, A_STATE), 0.5)
    state_b_re = nrm((n_ab, DEC_BATCH, B_GROUPS, B_STATE), 0.5)
    state_b_im = nrm((n_ab, DEC_BATCH, B_GROUPS, B_STATE), 0.5)
    state_c_conv = nrm((n_c, DEC_BATCH, C_WIDTH - 1, C_CH), 1.0)
    norm_mix = 1.0 + nrm((DEPTH, D_MODEL), 0.02)
    norm_ff = 1.0 + nrm((DEPTH, D_MODEL), 0.02)
    norm_final = 1.0 + nrm((D_MODEL,), 0.02)
    w_in_ab = nrm((n_ab, D_MODEL, IN_COLS), D_MODEL ** -0.5)
    a_conv_w = nrm((n_ab, A_CONV, A_CONV_DIM), A_CONV ** -0.5)
    a_conv_b = nrm((n_ab, A_CONV_DIM), 0.02)
    dt0 = jnp.exp(unif((n_ab, A_HEADS), math.log(1e-3), math.log(1e-1)))
    a_dt_bias = dt0 + jnp.log(-jnp.expm1(-dt0))
    a_log = jnp.log(unif((n_ab, A_HEADS), 1.0, 16.0))
    a_d = 1.0 + nrm((n_ab, A_HEADS), 0.1)
    a_norm = 1.0 + nrm((n_ab, A_D_INNER), 0.02)
    s5_lam_re = -0.5 + nrm((n_ab, B_GROUPS, B_STATE), 0.01)
    s5_lam_im = math.pi * jnp.arange(B_STATE, dtype=f32) + nrm((n_ab, B_GROUPS, B_STATE), 0.01)
    s5_log_step = unif((n_ab, B_GROUPS), math.log(1e-3), math.log(1e-1))
    s5_b_re = nrm((n_ab, B_GROUPS, B_STATE, B_GROUP_CH), (2 * B_GROUP_CH) ** -0.5)
    s5_b_im = nrm((n_ab, B_GROUPS, B_STATE, B_GROUP_CH), (2 * B_GROUP_CH) ** -0.5)
    s5_c_re = nrm((n_ab, B_GROUPS, B_GROUP_CH, B_STATE), (2 * B_STATE) ** -0.5)
    s5_c_im = nrm((n_ab, B_GROUPS, B_GROUP_CH, B_STATE), (2 * B_STATE) ** -0.5)
    s5_d = nrm((n_ab, B_GROUPS, B_GROUP_CH), 0.5)
    s5_w_glu = nrm((n_ab, B_CH, B_CH), B_CH ** -0.5)
    s5_b_glu = nrm((n_ab, B_CH), 0.02)
    w_out_ab = nrm((n_ab, MIX_WIDTH, D_MODEL), MIX_WIDTH ** -0.5)
    c_w_pw1 = nrm((n_c, D_MODEL, 2 * C_CH), D_MODEL ** -0.5)
    c_b_pw1 = nrm((n_c, 2 * C_CH), 0.02)
    c_w_dw = nrm((n_c, C_WIDTH, C_CH), C_WIDTH ** -0.5)
    c_b_dw = nrm((n_c, C_CH), 0.02)
    c_ln_w = 1.0 + nrm((n_c, C_CH), 0.02)
    c_ln_b = nrm((n_c, C_CH), 0.02)
    c_w_pw2 = nrm((n_c, C_CH, D_MODEL), C_CH ** -0.5)
    c_b_pw2 = nrm((n_c, D_MODEL), 0.02)
    w_ff1 = nrm((DEPTH, D_MODEL, D_FF), D_MODEL ** -0.5)
    w_ff2 = nrm((DEPTH, D_FF, D_MODEL), D_FF ** -0.5)
    return {"x_prompt": x_prompt, "x_sample": x_sample,
            "state_a_conv": state_a_conv, "state_a_ssm": state_a_ssm,
            "state_b_re": state_b_re, "state_b_im": state_b_im, "state_c_conv": state_c_conv,
            "norm_mix": norm_mix, "norm_ff": norm_ff, "norm_final": norm_final,
            "w_in_ab": w_in_ab, "a_conv_w": a_conv_w, "a_conv_b": a_conv_b, "a_dt_bias": a_dt_bias,
            "a_log": a_log, "a_d": a_d, "a_norm": a_norm,
            "s5_lam_re": s5_lam_re, "s5_lam_im": s5_lam_im, "s5_log_step": s5_log_step,
            "s5_b_re": s5_b_re, "s5_b_im": s5_b_im, "s5_c_re": s5_c_re, "s5_c_im": s5_c_im,
            "s5_d": s5_d, "s5_w_glu": s5_w_glu, "s5_b_glu": s5_b_glu, "w_out_ab": w_out_ab,
            "c_w_pw1": c_w_pw1, "c_b_pw1": c_b_pw1, "c_w_dw": c_w_dw, "c_b_dw": c_b_dw,
            "c_ln_w": c_ln_w, "c_ln_b": c_ln_b, "c_w_pw2": c_w_pw2, "c_b_pw2": c_b_pw2,
            "w_ff1": w_ff1, "w_ff2": w_ff2}


def reference(x_prompt, x_sample, state_a_conv, state_a_ssm, state_b_re, state_b_im, state_c_conv,
              norm_mix, norm_ff, norm_final, w_in_ab, a_conv_w, a_conv_b, a_dt_bias, a_log, a_d, a_norm,
              s5_lam_re, s5_lam_im, s5_log_step, s5_b_re, s5_b_im, s5_c_re, s5_c_im, s5_d, s5_w_glu,
              s5_b_glu, w_out_ab, c_w_pw1, c_b_pw1, c_w_dw, c_b_dw, c_ln_w, c_ln_b, c_w_pw2, c_b_pw2,
              w_ff1, w_ff2):
    p = dict(norm_mix=norm_mix, norm_ff=norm_ff, norm_final=norm_final, w_in_ab=w_in_ab,
             a_conv_w=a_conv_w, a_conv_b=a_conv_b, a_dt_bias=a_dt_bias, a_log=a_log, a_d=a_d, a_norm=a_norm,
             s5_lam_re=s5_lam_re, s5_lam_im=s5_lam_im, s5_log_step=s5_log_step, s5_b_re=s5_b_re,
             s5_b_im=s5_b_im, s5_c_re=s5_c_re, s5_c_im=s5_c_im, s5_d=s5_d, s5_w_glu=s5_w_glu,
             s5_b_glu=s5_b_glu, w_out_ab=w_out_ab, c_w_pw1=c_w_pw1, c_b_pw1=c_b_pw1, c_w_dw=c_w_dw,
             c_b_dw=c_b_dw, c_ln_w=c_ln_w, c_ln_b=c_ln_b, c_w_pw2=c_w_pw2, c_b_pw2=c_b_pw2,
             w_ff1=w_ff1, w_ff2=w_ff2)
    nb = x_prompt.shape[0]
    zero_a_conv = jnp.zeros((N_AB_LAYERS, nb, A_CONV - 1, A_CONV_DIM), x_prompt.dtype)
    zero_a_ssm = jnp.zeros((N_AB_LAYERS, nb, A_HEADS, A_HEAD_DIM, A_STATE), jnp.float32)
    zero_b = jnp.zeros((N_AB_LAYERS, nb, B_GROUPS, B_STATE), jnp.float32)
    zero_c_conv = jnp.zeros((N_C_LAYERS, nb, C_WIDTH - 1, C_CH), x_prompt.dtype)
    y_prompt, p_a_conv, p_a_ssm, p_b_re, p_b_im, p_c_conv = run_trunk(
        x_prompt, zero_a_conv, zero_a_ssm, zero_b, zero_b, zero_c_conv, p)
    y_sample, s_a_conv, s_a_ssm, s_b_re, s_b_im, s_c_conv = run_trunk(
        x_sample, state_a_conv, state_a_ssm, state_b_re, state_b_im, state_c_conv, p)
    return (y_prompt, y_sample, p_a_conv, p_a_ssm, p_b_re, p_b_im, p_c_conv,
            s_a_conv, s_a_ssm, s_b_re, s_b_im, s_c_conv)
```

```cpp
#include <hip/hip_runtime.h>
#include <cstdio>
#include <cstdint>
#ifndef MK_N_LAUNCHES
#define MK_N_LAUNCHES 1
#endif
namespace pg8 {
#define PG8_LAS __attribute__((address_space(3)))
typedef unsigned short bf16_t;
typedef short bf16x8 __attribute__((ext_vector_type(8)));
typedef float f32x4 __attribute__((ext_vector_type(4)));
typedef unsigned u32x4 __attribute__((ext_vector_type(4)));
typedef unsigned u32x2 __attribute__((ext_vector_type(2)));
constexpr int BM = 256, BK = 64, HALF = 128, HTB = HALF * BK * 2  , STAGE_BYTES = 8 * HTB, NXCD = 8, WGM = 8;

__host__ __device__ __forceinline__ int lds_byte(int r, int c) { const int st = (r >> 4) * 2 + (c >> 5), rr = r & 15, cc = c & 31, ob = rr * 64 + cc * 2; return st * 1024 + (ob ^ (((ob >> 9) & 1) << 5)); }
__host__ __device__ __forceinline__ void stage_rc(int b, int& R, int& C) { const int st = b / 1024, sb = b % 1024, swz = sb ^ (((sb >> 9) & 1) << 5); R = (st >> 1) * 16 + swz / 64; C = (st & 1) * 32 + (swz % 64) / 2; }
__host__ __device__ __forceinline__ int perm32(int rho) { const int n = rho >> 4, i = rho & 15; return 8 * (i >> 2) + 4 * n + (i & 3); }

struct Unit { int pm, pn; };
struct Gemm { const bf16_t* A; const bf16_t* Bt; int M, N, K, lda; };

struct StaticOrder {
    int nM, nN, nwg, G, c;
    __host__ __device__ void init(int M, int N, int G_, int c_) { nM = M / BM; nN = N / BM; nwg = nM * nN; G = G_; c = c_; }
    __host__ __device__ bool next(int i, Unit& u) const {
        const long L = (long)i * G + c; if (L >= nwg) return false;
        int wgid = (int)L; { const int q = nwg / NXCD, r = nwg % NXCD, xcd = wgid % NXCD, off = wgid / NXCD; wgid = (xcd < r ? xcd * (q + 1) : r * (q + 1) + (xcd - r) * q) + off; }
        const int nig = WGM * nN, gid = wgid / nig, fm = gid * WGM, gsz = (nM - fm) < WGM ? (nM - fm) : WGM;
        u.pm = fm + ((wgid % nig) % gsz); u.pn = (wgid % nig) / gsz; return true;
    }
};

__device__ __forceinline__ unsigned cvt_pk_bf16(float lo, float hi) { unsigned r; asm volatile("v_cvt_pk_bf16_f32 %0, %1, %2" : "=v"(r) : "v"(lo), "v"(hi)); return r; }

template <class Epi, class Sched, bool ALIGN_EPI = false, bool SP2 = false>
__device__ __forceinline__ void gemm_phase(PG8_LAS unsigned char* lds, const Gemm g, const Sched& S, const Epi& E) {
    const int tid = threadIdx.x, wid = __builtin_amdgcn_readfirstlane(tid >> 6), lane = tid & 63, wr = wid >> 2, wc = wid & 3, fr = lane & 15, fq = lane >> 4;
    const int K = g.K, nt = K / BK, lda = g.lda;
    unsigned voffA[2], voffB[2];
#pragma unroll
    for (int i = 0; i < 2; ++i) { int R, C; stage_rc(tid * 16 + i * 8192, R, C); const int Rb = Epi::PERM ? ((R & ~31) + perm32(R & 31)) : R;
        voffA[i] = (unsigned)(R * lda + C) * 2u; voffB[i] = (unsigned)(Rb * K + C) * 2u; }
    const size_t kstep = (size_t)(BK * 2);
    const size_t hA = (size_t)HALF * lda * 2, hB = (size_t)HALF * K * 2;
    const size_t tA = 2 * hA, tB = 2 * hB;
    const unsigned ldsw = (unsigned)wid * 1024u;
    const int aoff = lds_byte(wr * 64 + fr, fq * 8), boff = lds_byte(wc * 32 + fr, fq * 8);
#define PG8_SA(b, h) (((b) * 2 + (h)) * HTB)
#define PG8_SB(b, h) ((4 + (b) * 2 + (h)) * HTB)
#define PG8_STAGE(bufoff, gbase, voff) do { _Pragma("unroll") for (int _i = 0; _i < 2; ++_i) \
        __builtin_amdgcn_global_load_lds((const unsigned*)((const char*)(gbase) + (voff)[_i]), (PG8_LAS unsigned*)(lds + (bufoff) + ldsw + _i * 8192), 16, 0, 0); } while (0)
#define PG8_LDA(dst, b, h) do { _Pragma("unroll") for (int m = 0; m < 4; ++m) _Pragma("unroll") for (int k = 0; k < 2; ++k) dst[m][k] = *(const PG8_LAS bf16x8*)(lds + PG8_SA(b, h) + aoff + m * 2048 + k * 1024); } while (0)
#define PG8_LDB(dst, b, h) do { _Pragma("unroll") for (int n = 0; n < 2; ++n) _Pragma("unroll") for (int k = 0; k < 2; ++k) dst[n][k] = *(const PG8_LAS bf16x8*)(lds + PG8_SB(b, h) + boff + n * 2048 + k * 1024); } while (0)
#define PG8_MMA(ai, bj, At, Bt) do { __builtin_amdgcn_s_setprio(1); _Pragma("unroll") for (int m = 0; m < 4; ++m) _Pragma("unroll") for (int n = 0; n < 2; ++n) _Pragma("unroll") for (int k = 0; k < 2; ++k) \
        acc[ai][bj][m][n] = __builtin_amdgcn_mfma_f32_16x16x32_bf16(Bt[n][k], At[m][k], acc[ai][bj][m][n], 0, 0, 0); __builtin_amdgcn_s_setprio(0); } while (0)
#define PG8_WAIT_V(n) asm volatile("s_waitcnt vmcnt(" #n ")" ::: "memory")
#define PG8_WAIT_L(n) asm volatile("s_waitcnt lgkmcnt(" #n ")" ::: "memory")
#define PG8_BAR __builtin_amdgcn_s_barrier()
#define PG8_SCHED __builtin_amdgcn_sched_barrier(0)
    Unit cur, nxt; int ui = 0;
    if (!S.next(0, cur)) return;
    f32x4 acc[2][2][4][2];
#pragma unroll
    for (int a = 0; a < 2; ++a)
#pragma unroll
        for (int b = 0; b < 2; ++b)
#pragma unroll
            for (int m = 0; m < 4; ++m)
#pragma unroll
                for (int n = 0; n < 2; ++n) acc[a][b][m][n] = (f32x4){0.f, 0.f, 0.f, 0.f};
    bf16x8 At[4][2], B0[2][2], B1[2][2];
    const char* cA = (const char*)g.A + (size_t)cur.pm * tA; const char* cB = (const char*)g.Bt + (size_t)cur.pn * tB;
    if constexpr (SP2) {
        PG8_STAGE(PG8_SB(0, 0), cB, voffB); PG8_STAGE(PG8_SB(0, 1), cB + hB, voffB); PG8_STAGE(PG8_SA(0, 0), cA, voffA); PG8_STAGE(PG8_SA(0, 1), cA + hA, voffA);
        if (wr == 1) PG8_BAR;
        PG8_WAIT_V(2); PG8_BAR;
        PG8_STAGE(PG8_SB(1, 0), cB + kstep, voffB); PG8_STAGE(PG8_SA(1, 0), cA + kstep, voffA); PG8_STAGE(PG8_SB(1, 1), cB + hB + kstep, voffB);
        PG8_WAIT_V(6); PG8_BAR;
    } else {
        PG8_STAGE(PG8_SB(0, 0), cB, voffB); PG8_STAGE(PG8_SA(0, 0), cA, voffA); PG8_STAGE(PG8_SB(0, 1), cB + hB, voffB); PG8_STAGE(PG8_SA(0, 1), cA + hA, voffA);
        if (wr == 1) PG8_BAR;
        PG8_WAIT_V(4); PG8_BAR;
        PG8_STAGE(PG8_SB(1, 0), cB + kstep, voffB); PG8_STAGE(PG8_SA(1, 0), cA + kstep, voffA); PG8_STAGE(PG8_SB(1, 1), cB + hB + kstep, voffB);
        PG8_WAIT_V(6); PG8_BAR;
    }
    for (;;) {
        const bool has_next = S.next(ui + 1, nxt);
        const char* nA = has_next ? (const char*)g.A + (size_t)nxt.pm * tA : cA; const char* nB = has_next ? (const char*)g.Bt + (size_t)nxt.pn * tB : cB;
        for (int t = 0; t < nt; t += 2) {
            const bool last = (t == nt - 2);
            const char* a1 = cA + (size_t)(t + 1) * kstep;
            const char* a2 = last ? nA : cA + (size_t)(t + 2) * kstep; const char* b2 = last ? nB : cB + (size_t)(t + 2) * kstep;
            const char* a3 = a2 + kstep; const char* b3 = b2 + kstep;
            if constexpr (SP2) {
            PG8_LDB(B0, 0, 0); PG8_LDB(B1, 0, 1); PG8_SCHED; PG8_LDA(At, 0, 0); PG8_STAGE(PG8_SA(1, 1), a1 + hA, voffA);
            PG8_WAIT_V(8); PG8_WAIT_L(0); PG8_BAR; PG8_MMA(0, 0, At, B0); PG8_MMA(0, 1, At, B1); PG8_BAR; PG8_SCHED;
            PG8_LDA(At, 0, 1); PG8_STAGE(PG8_SB(0, 0), b2, voffB); PG8_STAGE(PG8_SB(0, 1), b2 + hB, voffB); PG8_STAGE(PG8_SA(0, 0), a2, voffA);
            PG8_WAIT_V(8); PG8_WAIT_L(0); PG8_BAR; PG8_MMA(1, 0, At, B0); PG8_MMA(1, 1, At, B1); PG8_BAR; PG8_SCHED;
            PG8_LDB(B0, 1, 0); PG8_LDB(B1, 1, 1); PG8_SCHED; PG8_LDA(At, 1, 0); PG8_STAGE(PG8_SA(0, 1), a2 + hA, voffA);
            PG8_WAIT_V(8); PG8_WAIT_L(0); PG8_BAR; PG8_MMA(0, 0, At, B0); PG8_MMA(0, 1, At, B1); PG8_BAR; PG8_SCHED;
            PG8_LDA(At, 1, 1); PG8_STAGE(PG8_SB(1, 0), b3, voffB); PG8_STAGE(PG8_SB(1, 1), b3 + hB, voffB); PG8_STAGE(PG8_SA(1, 0), a3, voffA);
            PG8_WAIT_V(8); PG8_WAIT_L(0); PG8_BAR; PG8_MMA(1, 0, At, B0); PG8_MMA(1, 1, At, B1); PG8_BAR; PG8_SCHED;
            } else {
            PG8_LDB(B0, 0, 0); PG8_SCHED; PG8_LDA(At, 0, 0); PG8_STAGE(PG8_SA(1, 1), a1 + hA, voffA);
            PG8_WAIT_L(8); PG8_BAR; PG8_WAIT_L(0); PG8_MMA(0, 0, At, B0); PG8_BAR; PG8_SCHED;
            PG8_LDB(B1, 0, 1); PG8_STAGE(PG8_SB(0, 0), b2, voffB);
            PG8_BAR; PG8_WAIT_L(0); PG8_MMA(0, 1, At, B1); PG8_BAR;
            PG8_LDA(At, 0, 1); PG8_STAGE(PG8_SA(0, 0), a2, voffA);
            PG8_BAR; PG8_WAIT_L(0); PG8_MMA(1, 0, At, B0); PG8_BAR; PG8_SCHED;
            PG8_STAGE(PG8_SB(0, 1), b2 + hB, voffB);
            PG8_WAIT_V(6); PG8_BAR; PG8_MMA(1, 1, At, B1); PG8_BAR;
            PG8_LDB(B0, 1, 0); PG8_SCHED; PG8_LDA(At, 1, 0); PG8_STAGE(PG8_SA(0, 1), a2 + hA, voffA);
            PG8_WAIT_L(8); PG8_BAR; PG8_WAIT_L(0); PG8_MMA(0, 0, At, B0); PG8_BAR; PG8_SCHED;
            PG8_LDB(B1, 1, 1); PG8_STAGE(PG8_SB(1, 0), b3, voffB);
            PG8_BAR; PG8_WAIT_L(0); PG8_MMA(0, 1, At, B1); PG8_BAR;
            PG8_LDA(At, 1, 1); PG8_STAGE(PG8_SA(1, 0), a3, voffA);
            PG8_BAR; PG8_WAIT_L(0); PG8_MMA(1, 0, At, B0); PG8_BAR; PG8_SCHED;
            PG8_STAGE(PG8_SB(1, 1), b3 + hB, voffB);
            PG8_WAIT_V(6); PG8_BAR; PG8_MMA(1, 1, At, B1); PG8_BAR;
            }
        }
        if constexpr (ALIGN_EPI) { if (wr == 0) PG8_BAR; }
        E(acc, cur, wr, wc, fr, fq);
        if (!has_next) break;
#pragma unroll
        for (int a = 0; a < 2; ++a)
#pragma unroll
            for (int b = 0; b < 2; ++b)
#pragma unroll
                for (int m = 0; m < 4; ++m)
#pragma unroll
                    for (int n = 0; n < 2; ++n) acc[a][b][m][n] = (f32x4){0.f, 0.f, 0.f, 0.f};
        cur = nxt; cA = nA; cB = nB; ++ui;
        if constexpr (ALIGN_EPI) { if (wr == 1) PG8_BAR; }
    }
    PG8_WAIT_V(0);
    if constexpr (!ALIGN_EPI) { if (wr == 0) PG8_BAR; }
    PG8_BAR;
#undef PG8_SA
#undef PG8_SB
#undef PG8_STAGE
#undef PG8_LDA
#undef PG8_LDB
#undef PG8_MMA
#undef PG8_WAIT_V
#undef PG8_WAIT_L
#undef PG8_BAR
#undef PG8_SCHED
}
}
constexpr int NWAVES = 8;
constexpr int DM = 1024, NBP = 8, SEQ = 2048, MP = NBP * SEQ, NBS = 128, DSEQ = 8, MS = NBS * DSEQ, MT = MP + MS;
constexpr int AH = 16, AP = 64, AG = 4, AN = 128, ACD = 2048, INC = 4112, FF = 4096, CWID = 31;
constexpr float EPS = 1e-6f;
constexpr size_t O_Y = 0, O_PAC = 17825792, O_PAS = 17874944, O_PBR = 18923520, O_PBI = 18956288, O_PCC = 18989056,
                 O_SAC = 19234816, O_SAS = 20021248, O_SBR = 36798464, O_SBI = 37322752, O_SCC = 37847040, O_END = 41779200;
constexpr size_t MiB = 1u << 20;
constexpr size_t WS_CTL = 0, CTL_ZERO_BYTES = 64 * 1024;
constexpr size_t WS_SS = 1 * MiB;
constexpr size_t WS_DT = 3 * MiB;
constexpr size_t WS_DA = 5 * MiB;
constexpr size_t WS_W = 8 * MiB;
constexpr size_t WS_WIN = WS_W, WS_WGLU = WS_WIN + 8 * MiB, WS_WOUT = WS_WGLU + 2 * MiB, WS_WFF1 = WS_WOUT + 4 * MiB, WS_WFF2 = WS_WFF1 + 16 * MiB,
                 WS_WPW1 = WS_WFF2 + 16 * MiB, WS_WPW2 = WS_WPW1 + 4 * MiB, WS_WEND = WS_WPW2 + 2 * MiB;
constexpr size_t WS_CAT = 60 * MiB;
constexpr size_t WS_XBC = 128 * MiB;
constexpr size_t WS_U = 196 * MiB;
constexpr size_t WS_XB = WS_U;
constexpr size_t WS_H = 60 * MiB;
constexpr size_t WS_G = 60 * MiB;
constexpr size_t WS_CV = 94 * MiB;
constexpr size_t WS_END = 256 * MiB;
static_assert(WS_WEND == 60 * MiB, "weights end");
constexpr int CW_BAR = 4096;

constexpr int RING_OFF = 0, RING_BYTES = 131072;
constexpr int LDS_BYTES = 155648;
constexpr int LDSCTL_OFF = LDS_BYTES - 512, MISC_OFF = LDSCTL_OFF + 320;

#define GAS __attribute__((address_space(1)))
#define LAS __attribute__((address_space(3)))
typedef unsigned short bf16;
typedef unsigned v4u __attribute__((ext_vector_type(4)));
typedef unsigned v2u __attribute__((ext_vector_type(2)));
typedef float f32x4 __attribute__((ext_vector_type(4)));
typedef float f32x16 __attribute__((ext_vector_type(16)));
typedef short bf16x8 __attribute__((ext_vector_type(8)));
typedef GAS unsigned gu32;
#define RLX_AGENT __ATOMIC_RELAXED, __HIP_MEMORY_SCOPE_AGENT
#define LDS_WAIT() asm volatile("s_waitcnt lgkmcnt(0)" ::: "memory")
#define VM_WAIT() asm volatile("s_waitcnt vmcnt(0)" ::: "memory")
__device__ __forceinline__ unsigned f2bf(float f) { unsigned u = __builtin_bit_cast(unsigned, f); return (u + 0x7fffu + ((u >> 16) & 1u)) >> 16; }
__device__ __forceinline__ unsigned pk2(float lo, float hi) { return f2bf(lo) | (f2bf(hi) << 16); }
__device__ __forceinline__ float bf2f(unsigned short b) { return __builtin_bit_cast(float, ((unsigned)b) << 16); }
__device__ __forceinline__ float bflo(unsigned w) { return __builtin_bit_cast(float, w << 16); }
__device__ __forceinline__ float bfhi(unsigned w) { return __builtin_bit_cast(float, w & 0xffff0000u); }
__device__ __forceinline__ float sigmoidf_(float x) { return 1.0f / (1.0f + __expf(-x)); }
__device__ __forceinline__ float siluf_(float x) { return x / (1.0f + __expf(-x)); }

#define XB_TMO      128
#define XB_XCNT(j)  (256  + 64 * (j))
#define XB_XSUB(j)  (1280 + 64 * (j))
#define XB_XGEN(j)  (2304 + 64 * (j))
#define XB_TOP      3328
#define XB_TOPGEN   3392
#define XCD_BAR_WORDS 3456
#define XB_SPIN_CAP (1u << 20)
__device__ __forceinline__ unsigned xb_ld(unsigned* p)              { return __hip_atomic_load(p, __ATOMIC_RELAXED, __HIP_MEMORY_SCOPE_AGENT); }
__device__ __forceinline__ unsigned xb_add(unsigned* p, unsigned v) { return __hip_atomic_fetch_add(p, v, __ATOMIC_RELAXED, __HIP_MEMORY_SCOPE_AGENT); }
__device__ __forceinline__ unsigned xb_xcc_id() { return (unsigned)__builtin_amdgcn_s_getreg((3 << 11) | 20) & 0xFu; }
#define XB_SPIN(cond, bar) do { unsigned _sp = 0; while (cond) { __builtin_amdgcn_s_sleep(1); \
    if ((++_sp & 255u) == 0u) { if (xb_ld(&(bar)[XB_TMO])) break; if (_sp > XB_SPIN_CAP) { atomicAdd(&(bar)[XB_TMO], 1u); break; } } } } while (0)
struct XcdBarrier { unsigned* bar; unsigned x; volatile LAS unsigned* st; };
__device__ __forceinline__ XcdBarrier xcd_barrier_post(unsigned* bar, volatile LAS unsigned* st) {
    XcdBarrier b; b.bar = bar; b.x = xb_xcc_id(); b.st = st;
    if (threadIdx.x == 0) (void)xb_add(&bar[XB_XCNT(b.x)], 1u);
    return b;
}
__device__ __forceinline__ void xcd_barrier_complete(unsigned* bar, unsigned x, unsigned& nloc, unsigned& nx) {
    const unsigned G = gridDim.x * gridDim.y * gridDim.z;
    unsigned sum, cnt, mine, sp = 0u;
    for (;;) {
        sum = 0u; cnt = 0u; mine = 0u;
#pragma unroll
        for (unsigned j = 0; j < 16; ++j) { const unsigned c = xb_ld(&bar[XB_XCNT(j)]); sum += c; cnt += (c > 0u) ? 1u : 0u; mine = (j == x) ? c : mine; }
        if (sum == G) break;
        __builtin_amdgcn_s_sleep(1);
        if ((++sp & 255u) == 0u) { if (xb_ld(&bar[XB_TMO])) break; if (sp > XB_SPIN_CAP) { atomicAdd(&bar[XB_TMO], 1u); break; } }
    }
    nloc = mine > 0u ? mine : 1u; nx = cnt > 0u ? cnt : 1u;
}
__device__ __forceinline__ void xcd_barrier(const XcdBarrier& b) {
    asm volatile("s_waitcnt vmcnt(0)" ::: "memory");
    __syncthreads();
    if (threadIdx.x == 0) {
        unsigned* bar = b.bar;
        __builtin_amdgcn_s_waitcnt(0);
        unsigned nloc = b.st[0], nx = b.st[1];
        if (nloc == 0u) { xcd_barrier_complete(bar, b.x, nloc, nx); b.st[0] = nloc; b.st[1] = nx; }
        const unsigned old = xb_add(&bar[XB_XSUB(b.x)], 1u);
        const unsigned gen = old / nloc;
        if (old + 1u == (gen + 1u) * nloc) {
            __builtin_amdgcn_fence(__ATOMIC_RELEASE, "agent");
            asm volatile("s_waitcnt vmcnt(0)" ::: "memory");
            const unsigned og = xb_add(&bar[XB_TOP], 1u);
            const unsigned tg = og / nx;
            if (og + 1u == (tg + 1u) * nx) xb_add(&bar[XB_TOPGEN], 1u);
            else XB_SPIN(xb_ld(&bar[XB_TOPGEN]) == tg, bar);
            __builtin_amdgcn_fence(__ATOMIC_ACQUIRE, "agent");
            xb_add(&bar[XB_XGEN(b.x)], 1u);
            asm volatile("s_waitcnt vmcnt(0)" ::: "memory");
        } else {
            XB_SPIN(xb_ld(&bar[XB_XGEN(b.x)]) == gen, bar);
            __builtin_amdgcn_fence(__ATOMIC_ACQUIRE, "agent");
            asm volatile("s_waitcnt vmcnt(0)" ::: "memory");
        }
    }
    __syncthreads();
}

struct Frame {
    LAS unsigned char* lds;
    volatile LAS unsigned* MISC;
    gu32* ctl;
    int tid, lane, wave;
    int vcu, G;
    const float* const* in;
    float* out;
    unsigned char* ws;
};
__device__ __forceinline__ float wave_sum(float v) {
#pragma unroll
    for (int o = 1; o < 64; o <<= 1) v += __shfl_xor(v, o);
    return v;
}
__device__ __forceinline__ float row_rstd(const float* SS, int r) {
    const f32x4* p = (const f32x4*)(SS + (size_t)r * 16);
    const f32x4 a = p[0], b = p[1], c = p[2], d = p[3];
    const float s = ((a.x + a.y) + (a.z + a.w)) + ((b.x + b.y) + (b.z + b.w)) + ((c.x + c.y) + (c.z + c.w)) + ((d.x + d.y) + (d.z + d.w));
    return 1.0f / sqrtf(s * (1.0f / DM) + EPS);
}
namespace pg8 {
struct EpiInProj {
    static constexpr bool PERM = true;
    bf16_t* CAT; bf16_t* XBC; bf16_t* U; const float* SS; float* out; bf16_t* HALO;
    __device__ __forceinline__ void operator()(const f32x4 (&acc)[2][2][4][2], const Unit& u, int wr, int wc, int fr, int fq) const {
        const int row0 = u.pm * BM + wr * 64 + fr; const int colt = u.pn * BM;
        bf16_t* base; int ldc, c0; const bool isx = (colt >= 1024 && colt < 3072);
        if (colt < 1024) { base = CAT; ldc = 2048; c0 = colt; } else if (colt < 3072) { base = XBC; ldc = 2048; c0 = colt - 1024; } else { base = U; ldc = 1024; c0 = colt - 3072; }
        const int col0 = c0 + wc * 32 + 8 * fq;
#pragma unroll
        for (int ai = 0; ai < 2; ++ai)
#pragma unroll
            for (int m = 0; m < 4; ++m) {
                const int r = row0 + ai * HALF + m * 16; const float rs = row_rstd(SS, r);
                bf16_t* rowp = base + (size_t)r * ldc + col0;
                float* st = nullptr; bf16_t* hl = nullptr;
                if (isx) { if (r < MP) { const int t = r & 2047; if (t >= 2045) st = out + O_PAC + ((size_t)(r >> 11) * 3 + (t - 2045)) * 2048;
                                         if ((t & 63) >= 61) hl = HALO + ((size_t)((r >> 11) * 32 + (t >> 6)) * 3 + ((t & 63) - 61)) * 2048; }
                           else { const int rr = r - MP, t = rr & 7; if (t >= 5) st = out + O_SAC + ((size_t)(rr >> 3) * 3 + (t - 5)) * 2048; } }
#pragma unroll
                for (int bj = 0; bj < 2; ++bj) { const f32x4 v0 = acc[ai][bj][m][0] * rs, v1 = acc[ai][bj][m][1] * rs;
                    u32x4 w; w.x = cvt_pk_bf16(v0[0], v0[1]); w.y = cvt_pk_bf16(v0[2], v0[3]); w.z = cvt_pk_bf16(v1[0], v1[1]); w.w = cvt_pk_bf16(v1[2], v1[3]);
                    *(u32x4*)(rowp + bj * HALF) = w;
                    if (hl) *(u32x4*)(hl + col0 + bj * HALF) = w;
                    if (st) { *(f32x4*)(st + col0 + bj * HALF) = v0; *(f32x4*)(st + col0 + bj * HALF + 4) = v1; } }
                asm volatile("" ::: "memory"); }
    }
};
struct EpiGlu {
    static constexpr bool PERM = true;
    const bf16_t* YS; bf16_t* CAT; const float* bias;
    __device__ __forceinline__ void operator()(const f32x4 (&acc)[2][2][4][2], const Unit& u, int wr, int wc, int fr, int fq) const {
        const int row0 = u.pm * BM + wr * 64 + fr; const int col0 = u.pn * BM + wc * 32 + 8 * fq;
        f32x4 bv[2][2];
#pragma unroll
        for (int bj = 0; bj < 2; ++bj)
#pragma unroll
            for (int n = 0; n < 2; ++n) bv[bj][n] = *(const f32x4*)(bias + col0 + bj * HALF + 4 * n);
#pragma unroll
        for (int ai = 0; ai < 2; ++ai)
#pragma unroll
            for (int m = 0; m < 4; ++m) { const int r = row0 + ai * HALF + m * 16;
#pragma unroll
                for (int bj = 0; bj < 2; ++bj) { const u32x4 yw = *(const u32x4*)(YS + (size_t)r * 1024 + col0 + bj * HALF);
                    const f32x4 g0 = acc[ai][bj][m][0] + bv[bj][0], g1 = acc[ai][bj][m][1] + bv[bj][1];
                    float o[8]; o[0] = bflo(yw.x) * sigmoidf_(g0[0]); o[1] = bfhi(yw.x) * sigmoidf_(g0[1]); o[2] = bflo(yw.y) * sigmoidf_(g0[2]); o[3] = bfhi(yw.y) * sigmoidf_(g0[3]);
                    o[4] = bflo(yw.z) * sigmoidf_(g1[0]); o[5] = bfhi(yw.z) * sigmoidf_(g1[1]); o[6] = bflo(yw.w) * sigmoidf_(g1[2]); o[7] = bfhi(yw.w) * sigmoidf_(g1[3]);
                    u32x4 w; w.x = cvt_pk_bf16(o[0], o[1]); w.y = cvt_pk_bf16(o[2], o[3]); w.z = cvt_pk_bf16(o[4], o[5]); w.w = cvt_pk_bf16(o[6], o[7]);
                    *(u32x4*)(CAT + (size_t)r * 2048 + 1024 + col0 + bj * HALF) = w; }
                asm volatile("" ::: "memory"); }
    }
};
struct EpiRes {
    static constexpr bool PERM = true;
    const float* resP; const float* resS; float* X; bf16_t* XB; float* SS; const float* bias;
    __device__ __forceinline__ void operator()(const f32x4 (&acc)[2][2][4][2], const Unit& u, int wr, int wc, int fr, int fq) const {
        const int row0 = u.pm * BM + wr * 64 + fr; const int col0 = u.pn * BM + wc * 32 + 8 * fq;
        f32x4 bv[2][2];
#pragma unroll
        for (int bj = 0; bj < 2; ++bj)
#pragma unroll
            for (int n = 0; n < 2; ++n) bv[bj][n] = bias ? *(const f32x4*)(bias + col0 + bj * HALF + 4 * n) : (f32x4){0.f, 0.f, 0.f, 0.f};
#pragma unroll
        for (int ai = 0; ai < 2; ++ai)
#pragma unroll
            for (int m = 0; m < 4; ++m) { const int r = row0 + ai * HALF + m * 16;
                const float* rp = (r < MP) ? resP + (size_t)r * 1024 : resS + (size_t)(r - MP) * 1024;
                float ssq = 0.f;
#pragma unroll
                for (int bj = 0; bj < 2; ++bj) { const int c = col0 + bj * HALF;
                    const f32x4 x0 = *(const f32x4*)(rp + c) + acc[ai][bj][m][0] + bv[bj][0], x1 = *(const f32x4*)(rp + c + 4) + acc[ai][bj][m][1] + bv[bj][1];
                    *(f32x4*)(X + (size_t)r * 1024 + c) = x0; *(f32x4*)(X + (size_t)r * 1024 + c + 4) = x1;
                    u32x4 w; w.x = cvt_pk_bf16(x0[0], x0[1]); w.y = cvt_pk_bf16(x0[2], x0[3]); w.z = cvt_pk_bf16(x1[0], x1[1]); w.w = cvt_pk_bf16(x1[2], x1[3]);
                    if (XB) *(u32x4*)(XB + (size_t)r * 1024 + c) = w;
                    ssq += (x0[0] * x0[0] + x0[1] * x0[1]) + (x0[2] * x0[2] + x0[3] * x0[3]) + (x1[0] * x1[0] + x1[1] * x1[1]) + (x1[2] * x1[2] + x1[3] * x1[3]); }
                ssq += __shfl_xor(ssq, 16); ssq += __shfl_xor(ssq, 32);
                if (fq == 0) SS[(size_t)r * 16 + u.pn * 4 + wc] = ssq;
                asm volatile("" ::: "memory"); }
    }
};
struct EpiFF1 {
    static constexpr bool PERM = true;
    bf16_t* H; const float* SS;
    __device__ __forceinline__ void operator()(const f32x4 (&acc)[2][2][4][2], const Unit& u, int wr, int wc, int fr, int fq) const {
        const int row0 = u.pm * BM + wr * 64 + fr; const int col0 = u.pn * BM + wc * 32 + 8 * fq;
#pragma unroll
        for (int ai = 0; ai < 2; ++ai)
#pragma unroll
            for (int m = 0; m < 4; ++m) { const int r = row0 + ai * HALF + m * 16; const float rs = row_rstd(SS, r);
#pragma unroll
                for (int bj = 0; bj < 2; ++bj) { f32x4 v0 = acc[ai][bj][m][0] * rs, v1 = acc[ai][bj][m][1] * rs;
#pragma unroll
                    for (int j = 0; j < 4; ++j) { const float a = fmaxf(v0[j], 0.f), b = fmaxf(v1[j], 0.f); v0[j] = a * a; v1[j] = b * b; }
                    u32x4 w; w.x = cvt_pk_bf16(v0[0], v0[1]); w.y = cvt_pk_bf16(v0[2], v0[3]); w.z = cvt_pk_bf16(v1[0], v1[1]); w.w = cvt_pk_bf16(v1[2], v1[3]);
                    *(u32x4*)(H + (size_t)r * FF + col0 + bj * HALF) = w; }
                asm volatile("" ::: "memory"); }
    }
};
struct EpiPw1 {
    static constexpr bool PERM = true;
    bf16_t* G; const float* SS; const float* bias; float* out;
    __device__ __forceinline__ void operator()(const f32x4 (&acc)[2][2][4][2], const Unit& u, int wr, int wc, int fr, int fq) const {
        const int row0 = u.pm * BM + wr * 64 + fr; const int col0 = u.pn * HALF + wc * 32 + 8 * fq;
        f32x4 bv[2][2];
#pragma unroll
        for (int bj = 0; bj < 2; ++bj)
#pragma unroll
            for (int n = 0; n < 2; ++n) bv[bj][n] = *(const f32x4*)(bias + bj * 1024 + col0 + 4 * n);
#pragma unroll
        for (int ai = 0; ai < 2; ++ai)
#pragma unroll
            for (int m = 0; m < 4; ++m) { const int r = row0 + ai * HALF + m * 16; const float rs = row_rstd(SS, r);
                f32x4 o0, o1;
#pragma unroll
                for (int j = 0; j < 4; ++j) { o0[j] = (acc[ai][0][m][0][j] * rs + bv[0][0][j]) * sigmoidf_(acc[ai][1][m][0][j] * rs + bv[1][0][j]);
                                              o1[j] = (acc[ai][0][m][1][j] * rs + bv[0][1][j]) * sigmoidf_(acc[ai][1][m][1][j] * rs + bv[1][1][j]); }
                u32x4 w; w.x = cvt_pk_bf16(o0[0], o0[1]); w.y = cvt_pk_bf16(o0[2], o0[3]); w.z = cvt_pk_bf16(o1[0], o1[1]); w.w = cvt_pk_bf16(o1[2], o1[3]);
                *(u32x4*)(G + (size_t)r * 1024 + col0) = w;
                float* st = nullptr;
                if (r < MP) { const int t = r & 2047; if (t >= 2018) st = out + O_PCC + ((size_t)(r >> 11) * 30 + (t - 2018)) * 1024; }
                else { const int rr = r - MP; st = out + O_SCC + ((size_t)(rr >> 3) * 30 + 22 + (rr & 7)) * 1024; }
                if (st) { *(f32x4*)(st + col0) = o0; *(f32x4*)(st + col0 + 4) = o1; }
                asm volatile("" ::: "memory"); }
    }
};
}
__device__ __forceinline__ void p0_transpose_item(const float* W, int ldw, int K, bf16* WT, int dst_row0, const float* kscale, LAS float* scr, int k0, int n0, int lane) {
#pragma unroll 8
    for (int i = 0; i < 32; ++i) { const int kk = 2 * i + (lane >> 5); float v = W[(size_t)(k0 + kk) * ldw + n0 + (lane & 31)]; if (kscale) v *= kscale[k0 + kk]; scr[kk * 33 + (lane & 31)] = v; }
    LDS_WAIT(); asm volatile("" ::: "memory");
    const int c = lane & 7;
#pragma unroll
    for (int j = 0; j < 4; ++j) { const int n = (lane >> 3) + 8 * j; const LAS float* s = scr + (8 * c) * 33 + n;
        v4u o; o.x = pk2(s[0 * 33], s[1 * 33]); o.y = pk2(s[2 * 33], s[3 * 33]); o.z = pk2(s[4 * 33], s[5 * 33]); o.w = pk2(s[6 * 33], s[7 * 33]);
        *(GAS v4u*)(WT + (size_t)(dst_row0 + n) * K + k0 + 8 * c) = o; }
    LDS_WAIT(); asm volatile("" ::: "memory");
}
__device__ __forceinline__ void p0_mat(const float* W, int ldw, int K, int ncols, bf16* WT, int row_off, const float* kscale, LAS float* scr, int item, int lane, int glu_map) {
    const int nblk = ncols / 32, kb = item / nblk, nb = item % nblk, n0 = 32 * nb;
    int dst = row_off + n0;
    if (glu_map) dst = (n0 < 1024) ? (256 * (n0 >> 7) + (n0 & 127)) : (256 * ((n0 - 1024) >> 7) + 128 + ((n0 - 1024) & 127));
    p0_transpose_item(W, ldw, K, WT, dst, kscale, scr, 64 * kb, n0, lane);
}
constexpr int P0_SCR_STRIDE = 8704;
constexpr int P0_WD_OFF = NWAVES * P0_SCR_STRIDE;
constexpr int P0_WD_LD = 1028;
static_assert(P0_WD_OFF + 16 * P0_WD_LD * 4 <= LDSCTL_OFF, "P0 LDS");

__device__ __forceinline__ void p0_prologue(Frame& F) {
    LAS float* scr = (LAS float*)(F.lds + F.wave * P0_SCR_STRIDE);
    LAS float* WD = (LAS float*)(F.lds + P0_WD_OFF);
    const int gw = F.vcu * NWAVES + F.wave, NGW = F.G * NWAVES;
    const float* w_in = F.in[10]; const float* nmix = F.in[7]; const float* nff = F.in[8];
    for (int idx = F.tid; idx < 16 * 1024; idx += NWAVES * 64) { const int k = idx >> 4, h = idx & 15; WD[h * P0_WD_LD + k] = w_in[(size_t)k * INC + 3072 + h] * nmix[k]; }
    { float* WT = (float*)(F.ws + (235u << 20)); const float* wd = F.in[30];
      for (int idx = (int)blockIdx.x * (NWAVES * 64) + F.tid; idx < 1024 * 32; idx += F.G * NWAVES * 64) { const int ch = idx >> 5, k = idx & 31; WT[idx] = (k < 31) ? wd[k * 1024 + ch] : 0.f; } }
    bf16* Win = (bf16*)(F.ws + WS_WIN); bf16* Wglu = (bf16*)(F.ws + WS_WGLU); bf16* Wout = (bf16*)(F.ws + WS_WOUT);
    bf16* Wff1 = (bf16*)(F.ws + WS_WFF1); bf16* Wff2 = (bf16*)(F.ws + WS_WFF2); bf16* Wpw1 = (bf16*)(F.ws + WS_WPW1); bf16* Wpw2 = (bf16*)(F.ws + WS_WPW2);
    constexpr int I1 = 16 * 96, I2 = 16 * 32, I3 = 16 * 32, I4 = 32 * 32, I5 = 16 * 128, I6 = 64 * 32, I7 = 16 * 64, I8 = 16 * 32;
    constexpr int NITEMS = I1 + I2 + I3 + I4 + 2 * I5 + 2 * I6 + I7 + I8;
    for (int it = gw; it < NITEMS; it += NGW) {
        int r = it;
        if (r < I1) { p0_mat(w_in, INC, 1024, 3072, Win, 0, nmix, scr, r, F.lane, 0); continue; } r -= I1;
        if (r < I2) { p0_mat(w_in + 3088, INC, 1024, 1024, Win, 3072, nmix, scr, r, F.lane, 0); continue; } r -= I2;
        if (r < I3) { p0_mat(F.in[25], 1024, 1024, 1024, Wglu, 0, nullptr, scr, r, F.lane, 0); continue; } r -= I3;
        if (r < I4) { p0_mat(F.in[27], 1024, 2048, 1024, Wout, 0, nullptr, scr, r, F.lane, 0); continue; } r -= I4;
        if (r < I5) { p0_mat(F.in[36], 4096, 1024, 4096, Wff1, 0, nff, scr, r, F.lane, 0); continue; } r -= I5;
        if (r < I5) { p0_mat(F.in[36] + (size_t)1024 * 4096, 4096, 1024, 4096, Wff1 + (size_t)4096 * 1024, 0, nff + 1024, scr, r, F.lane, 0); continue; } r -= I5;
        if (r < I6) { p0_mat(F.in[37], 1024, 4096, 1024, Wff2, 0, nullptr, scr, r, F.lane, 0); continue; } r -= I6;
        if (r < I6) { p0_mat(F.in[37] + (size_t)4096 * 1024, 1024, 4096, 1024, Wff2 + (size_t)1024 * 4096, 0, nullptr, scr, r, F.lane, 0); continue; } r -= I6;
        if (r < I7) { p0_mat(F.in[28], 2048, 1024, 2048, Wpw1, 0, nmix + 1024, scr, r, F.lane, 1); continue; } r -= I7;
        p0_mat(F.in[34], 1024, 1024, 1024, Wpw2, 0, nullptr, scr, r, F.lane, 0);
    }
    __syncthreads();
    bf16* CAT = (bf16*)(F.ws + WS_CAT); float* SS = (float*)(F.ws + WS_SS); float* DT = (float*)(F.ws + WS_DT); float* DA = (float*)(F.ws + WS_DA);
    const float dtb = F.lane < 16 ? F.in[13][F.lane] : 0.f;
    const float aneg = F.lane < 16 ? -__expf(F.in[14][F.lane]) : 0.f;
    for (int m = gw; m < MT; m += NGW) {
        const float* xrow = (m < MP) ? F.in[0] + (size_t)m * DM : F.in[1] + (size_t)(m - MP) * DM;
        const GAS f32x4* xr = (const GAS f32x4*)xrow + F.lane;
        f32x4 v[4]; float s = 0.f;
#pragma unroll
        for (int j = 0; j < 4; ++j) { v[j] = xr[64 * j]; s += (v[j].x * v[j].x + v[j].y * v[j].y) + (v[j].z * v[j].z + v[j].w * v[j].w); }
        s = wave_sum(s);
        const float rstd = 1.0f / sqrtf(s * (1.0f / DM) + EPS);
        GAS unsigned long long* o8 = (GAS unsigned long long*)(CAT + (size_t)m * 2048 + 1024) + F.lane;
#pragma unroll
        for (int j = 0; j < 4; ++j) o8[64 * j] = (unsigned long long)pk2(v[j].x, v[j].y) | ((unsigned long long)pk2(v[j].z, v[j].w) << 32);
        float mine = 0.f;
#pragma unroll
        for (int h = 0; h < 16; ++h) {
            float p = 0.f;
#pragma unroll
            for (int j = 0; j < 4; ++j) { const f32x4 w = *(const LAS f32x4*)(WD + h * P0_WD_LD + 4 * F.lane + 256 * j); p += (v[j].x * w.x + v[j].y * w.y) + (v[j].z * w.z + v[j].w * w.w); }
            p = wave_sum(p);
            mine = (F.lane == h) ? p : mine;
            asm volatile("" ::: "memory");
        }
        if (F.lane < 16) {
            const float xr_ = mine * rstd + dtb;
            const float dtv = xr_ > 20.f ? xr_ : log1pf(__expf(xr_));
            DT[(size_t)m * 16 + F.lane] = dtv; DA[(size_t)m * 16 + F.lane] = dtv * aneg;
            SS[(size_t)m * 16 + F.lane] = (F.lane == 0) ? s : 0.f;
        }
    }
}
typedef short s5_bf16x8 __attribute__((ext_vector_type(8)));
constexpr int S5_HB_ROW = 272;
constexpr int S5_HB_WAVE = 2 * 16 * S5_HB_ROW;
constexpr int S5_HE_OFF = NWAVES * S5_HB_WAVE;
constexpr int S5_LDS_END = S5_HE_OFF + NWAVES * 2 * 64 * 2 * 4;
static_assert(S5_LDS_END <= LDSCTL_OFF, "S5 LDS");
constexpr int S5_PROMPT_UNITS = 256, S5_SAMPLE_UNITS = 128, S5_UNITS = S5_PROMPT_UNITS + S5_SAMPLE_UNITS;

__device__ __forceinline__ float gelu_tanh(float x) {
    const float u = 0.7978845608028654f * (x + 0.044715f * x * x * x);
    const float e = __expf(2.0f * u);
    const float th = 1.0f - 2.0f / (e + 1.0f);
    return 0.5f * x * (1.0f + th);
}

struct S5Consts {
    float lr[2], li[2];
    s5_bf16x8 bfr[2][2];
    s5_bf16x8 cm[4];
    float dskip;
};
__device__ __forceinline__ void s5_setup(const Frame& F, int g, S5Consts& K) {
    const int lane = F.lane, r = lane & 31, hh = lane >> 5;
    const float step = expf(F.in[19][g]);
#pragma unroll
    for (int pt = 0; pt < 2; ++pt) {
        const int p = 32 * pt + r;
        const float lr = F.in[17][g * 64 + p], li = F.in[18][g * 64 + p];
        const float mag = expf(lr * step), ar = mag * cosf(li * step), ai = mag * sinf(li * step);
        const float den = lr * lr + li * li;
        const float kr = ((ar - 1.0f) * lr + ai * li) / den, ki = (ai * lr - (ar - 1.0f) * li) / den;
        K.lr[pt] = ar; K.li[pt] = ai;
        const float* br = F.in[20] + ((size_t)(g * 64 + p) * 16 + 8 * hh); const float* bi = F.in[21] + ((size_t)(g * 64 + p) * 16 + 8 * hh);
        unsigned wr_[4], wi_[4];
#pragma unroll
        for (int j = 0; j < 4; ++j) {
            const float b0r = br[2 * j], b0i = bi[2 * j], b1r = br[2 * j + 1], b1i = bi[2 * j + 1];
            wr_[j] = pk2(kr * b0r - ki * b0i, kr * b1r - ki * b1i);
            wi_[j] = pk2(kr * b0i + ki * b0r, kr * b1i + ki * b1r);
        }
        K.bfr[pt][0] = __builtin_bit_cast(s5_bf16x8, (v4u){wr_[0], wr_[1], wr_[2], wr_[3]});
        K.bfr[pt][1] = __builtin_bit_cast(s5_bf16x8, (v4u){wi_[0], wi_[1], wi_[2], wi_[3]});
    }
    const int c = lane & 15, q = lane >> 4;
#pragma unroll
    for (int s = 0; s < 4; ++s) {
        const int p0 = 16 * s + 4 * q;
        const float* cr = F.in[22] + ((size_t)(g * 16 + c) * 64 + p0); const float* ci = F.in[23] + ((size_t)(g * 16 + c) * 64 + p0);
        unsigned w[4];
#pragma unroll
        for (int j = 0; j < 4; ++j) w[j] = pk2(cr[j], -ci[j]);
        K.cm[s] = __builtin_bit_cast(s5_bf16x8, (v4u){w[0], w[1], w[2], w[3]});
    }
    K.dskip = F.in[24][g * 16 + c];
}

__device__ __forceinline__ s5_bf16x8 s5_load_a(const Frame& F, const bf16* U, int g, int base0, int base1) {
    const int r = F.lane & 31, hh = F.lane >> 5, h = (r >> 2) & 1, i = (r & 3) + 4 * (r >> 3);
    const int arow = (h ? base1 : base0) + i;
    return *(const GAS s5_bf16x8*)(U + (size_t)arow * 1024 + g * 16 + 8 * hh);
}

template <int SEGLEN, bool WITH_Y>
__device__ __forceinline__ void s5_step(const Frame& F, const S5Consts& K, bf16* U, int g, int base0, int base1, const s5_bf16x8 afrag,
                                        float (&hr)[2][2], float (&hi)[2][2]  , LAS unsigned char* hb) {
    const int lane = F.lane, hh = lane >> 5, r = lane & 31;
    f32x16 bu[2][2];
#pragma unroll
    for (int pt = 0; pt < 2; ++pt)
#pragma unroll
        for (int ri = 0; ri < 2; ++ri) {
            f32x16 z;
#pragma unroll
            for (int i = 0; i < 16; ++i) z[i] = 0.f;
            bu[pt][ri] = __builtin_amdgcn_mfma_f32_32x32x16_bf16(afrag, K.bfr[pt][ri], z, 0, 0, 0);
        }
#pragma unroll
    for (int i = 0; i < 16; ++i) {
        constexpr int dummy = 0; (void)dummy;
        const int cs = (SEGLEN == 8) ? (i >> 3) : 0;
#pragma unroll
        for (int pt = 0; pt < 2; ++pt) {
            const float nr = K.lr[pt] * hr[cs][pt] - K.li[pt] * hi[cs][pt] + bu[pt][0][i];
            const float ni = K.lr[pt] * hi[cs][pt] + K.li[pt] * hr[cs][pt] + bu[pt][1][i];
            hr[cs][pt] = nr; hi[cs][pt] = ni;
            if (WITH_Y) *(LAS unsigned*)(hb + (hh * 16 + i) * S5_HB_ROW + (2 * (32 * pt + r)) * 2) = pk2(nr, ni);
        }
    }
    if (WITH_Y) {
        LDS_WAIT(); asm volatile("" ::: "memory");
        const int c = lane & 15, q = lane >> 4;
#pragma unroll
        for (int hf = 0; hf < 2; ++hf) {
            f32x4 y = (f32x4){0.f, 0.f, 0.f, 0.f};
#pragma unroll
            for (int s = 0; s < 4; ++s) {
                const s5_bf16x8 a = *(const LAS s5_bf16x8*)(hb + (hf * 16 + c) * S5_HB_ROW + (32 * s + 8 * q) * 2);
                y = __builtin_amdgcn_mfma_f32_16x16x32_bf16(a, K.cm[s], y, 0, 0, 0);
            }
            const int rb = (hf ? base1 : base0) + 4 * q;
#pragma unroll
            for (int j = 0; j < 4; ++j) {
                GAS bf16* up = (GAS bf16*)(U + (size_t)(rb + j) * 1024 + g * 16 + c);
                const float uv = bf2f(*up);
                const float v = gelu_tanh(y[j] + K.dskip * uv);
                *up = (bf16)f2bf(v);
            }
        }
        LDS_WAIT(); asm volatile("" ::: "memory");
    }
}

__device__ __forceinline__ void s5_block_unit(Frame& F, int unit) {
    bf16* U = (bf16*)(F.ws + WS_U);
    LAS unsigned char* hb = F.lds + F.wave * S5_HB_WAVE;
    LAS float* HE = (LAS float*)(F.lds + S5_HE_OFF);
    const int lane = F.lane, hh = lane >> 5, r = lane & 31, w = F.wave;
    S5Consts K;
    if (unit < S5_PROMPT_UNITS) {
        const int g = unit & 63, bp = unit >> 6;
        s5_setup(F, g, K);
        const int rb0 = bp * SEQ + 256 * w, rb1 = (bp + 4) * SEQ + 256 * w;
        float hr[2][2], hi[2][2];
#pragma unroll
        for (int a = 0; a < 2; ++a)
#pragma unroll
            for (int b = 0; b < 2; ++b) { hr[a][b] = 0.f; hi[a][b] = 0.f; }
        if (w < 7) {
            s5_bf16x8 af = s5_load_a(F, U, g, rb0, rb1);
            for (int s = 0; s < 16; ++s) {
                const s5_bf16x8 afn = s5_load_a(F, U, g, rb0 + 16 * ((s + 1) & 15), rb1 + 16 * ((s + 1) & 15));
                s5_step<16, false>(F, K, U, g, rb0 + 16 * s, rb1 + 16 * s, af, hr, hi, hb);
                af = afn;
            }
        }
#pragma unroll
        for (int pt = 0; pt < 2; ++pt) { HE[((w * 2 + hh) * 64 + 32 * pt + r) * 2 + 0] = hr[0][pt]; HE[((w * 2 + hh) * 64 + 32 * pt + r) * 2 + 1] = hi[0][pt]; }
        __syncthreads();
        float l256r[2], l256i[2];
#pragma unroll
        for (int pt = 0; pt < 2; ++pt) { float ar = K.lr[pt], ai = K.li[pt];
#pragma unroll
            for (int k = 0; k < 8; ++k) { const float nr = ar * ar - ai * ai, ni = 2.0f * ar * ai; ar = nr; ai = ni; }
            l256r[pt] = ar; l256i[pt] = ai; hr[0][pt] = 0.f; hi[0][pt] = 0.f; }
        for (int cp = 0; cp < w; ++cp) {
#pragma unroll
            for (int pt = 0; pt < 2; ++pt) {
                const float er = HE[((cp * 2 + hh) * 64 + 32 * pt + r) * 2 + 0], ei = HE[((cp * 2 + hh) * 64 + 32 * pt + r) * 2 + 1];
                const float nr = l256r[pt] * hr[0][pt] - l256i[pt] * hi[0][pt] + er, ni = l256r[pt] * hi[0][pt] + l256i[pt] * hr[0][pt] + ei;
                hr[0][pt] = nr; hi[0][pt] = ni; }
        }
        {
            s5_bf16x8 af = s5_load_a(F, U, g, rb0, rb1);
            for (int s = 0; s < 16; ++s) {
                const s5_bf16x8 afn = s5_load_a(F, U, g, rb0 + 16 * ((s + 1) & 15), rb1 + 16 * ((s + 1) & 15));
                s5_step<16, true>(F, K, U, g, rb0 + 16 * s, rb1 + 16 * s, af, hr, hi, hb);
                af = afn;
            }
        }
        if (w == 7) {
            const int b = hh ? bp + 4 : bp;
#pragma unroll
            for (int pt = 0; pt < 2; ++pt) { F.out[O_PBR + (size_t)(b * 64 + g) * 64 + 32 * pt + r] = hr[0][pt]; F.out[O_PBI + (size_t)(b * 64 + g) * 64 + 32 * pt + r] = hi[0][pt]; }
        }
        __syncthreads();
    } else {
        const int su = unit - S5_PROMPT_UNITS, g = su >> 1, half = su & 1;
        s5_setup(F, g, K);
        for (int qq = 0; qq < 2; ++qq) {
            const int quad = half * 16 + w * 2 + qq, sb0 = 4 * quad;
            const int base0 = MP + sb0 * 8, base1 = base0 + 16;
            float hr[2][2], hi[2][2];
#pragma unroll
            for (int cs = 0; cs < 2; ++cs)
#pragma unroll
                for (int pt = 0; pt < 2; ++pt) { const int seq = sb0 + 2 * hh + cs; const size_t o = (size_t)(seq * 64 + g) * 64 + 32 * pt + r; hr[cs][pt] = F.in[4][o]; hi[cs][pt] = F.in[5][o]; }
            const s5_bf16x8 af = s5_load_a(F, U, g, base0, base1);
            s5_step<8, true>(F, K, U, g, base0, base1, af, hr, hi, hb);
#pragma unroll
            for (int cs = 0; cs < 2; ++cs)
#pragma unroll
                for (int pt = 0; pt < 2; ++pt) { const int seq = sb0 + 2 * hh + cs; const size_t o = (size_t)(seq * 64 + g) * 64 + 32 * pt + r; F.out[O_SBR + o] = hr[cs][pt]; F.out[O_SBI + o] = hi[cs][pt]; }
        }
    }
}
constexpr size_t WS_HALO = 230 * MiB;
constexpr size_t WS_CDEC = 234 * MiB;
typedef short ssd_bf16x8 __attribute__((ext_vector_type(8)));
constexpr int SSD_PITCH = 272;

constexpr int SSDS_XS = 0, SSDS_BS = SSDS_XS + 8 * 256 * 4, SSDS_CS = SSDS_BS + 8 * 128 * 4, SSDS_YS = SSDS_CS + 8 * 128 * 4, SSDS_END = SSDS_YS + 8 * 256 * 4;
__device__ __forceinline__ void ssd_sample_unit(Frame& F, int unit) {
    const int b = unit >> 2, g = unit & 3, tid = F.tid, lane = F.lane;
    const bf16* XBC = (const bf16*)(F.ws + WS_XBC); bf16* CAT = (bf16*)(F.ws + WS_CAT);
    const float* DT = (const float*)(F.ws + WS_DT); const float* DA = (const float*)(F.ws + WS_DA);
    LAS float* xs = (LAS float*)(F.lds + SSDS_XS); LAS float* Bs = (LAS float*)(F.lds + SSDS_BS); LAS float* Cs = (LAS float*)(F.lds + SSDS_CS); LAS float* ys = (LAS float*)(F.lds + SSDS_YS);
    const int row0 = MP + b * 8;
    {
        const int col = (tid < 256) ? (g * 256 + tid) : ((tid < 384) ? (1024 + g * 128 + (tid - 256)) : (1536 + g * 128 + (tid - 384)));
        const float* cw = F.in[11]; const float w0 = cw[col], w1 = cw[2048 + col], w2 = cw[4096 + col], w3 = cw[6144 + col], bias = F.in[12][col];
        const float* st = F.in[2] + (size_t)b * 3 * 2048 + col;
        float x0 = st[0], x1 = st[2048], x2 = st[4096];
#pragma unroll
        for (int t = 0; t < 8; ++t) {
            const float x3 = bf2f(XBC[(size_t)(row0 + t) * 2048 + col]);
            const float o = siluf_(bias + w0 * x0 + w1 * x1 + w2 * x2 + w3 * x3);
            if (tid < 256) xs[t * 256 + tid] = o; else if (tid < 384) Bs[t * 128 + (tid - 256)] = o; else Cs[t * 128 + (tid - 384)] = o;
            x0 = x1; x1 = x2; x2 = x3;
        }
    }
    __syncthreads();
    const int p = tid >> 3, ns = tid & 7;
    for (int e = 0; e < 4; ++e) {
        const int head = 4 * g + e;
        const size_t so = ((size_t)(b * 16 + head) * 64 + p) * 128 + ns * 16;
        f32x4 h[4];
#pragma unroll
        for (int k = 0; k < 4; ++k) h[k] = *(const f32x4*)(F.in[3] + so + 4 * k);
        const float dsk = F.in[15][head];
#pragma unroll
        for (int t = 0; t < 8; ++t) {
            const float dtv = DT[(size_t)(row0 + t) * 16 + head], dec = __expf(DA[(size_t)(row0 + t) * 16 + head]);
            const float xv = xs[t * 256 + e * 64 + p], dtx = dtv * xv;
            float yp = 0.f;
#pragma unroll
            for (int k = 0; k < 4; ++k) {
                const f32x4 bv = *(const LAS f32x4*)(Bs + t * 128 + ns * 16 + 4 * k), cv = *(const LAS f32x4*)(Cs + t * 128 + ns * 16 + 4 * k);
                h[k] = h[k] * dec + bv * dtx;
                yp += (cv.x * h[k].x + cv.y * h[k].y) + (cv.z * h[k].z + cv.w * h[k].w);
            }
            yp += __shfl_xor(yp, 1); yp += __shfl_xor(yp, 2); yp += __shfl_xor(yp, 4);
            if (ns == 0) ys[t * 256 + e * 64 + p] = yp + dsk * xv;
        }
#pragma unroll
        for (int k = 0; k < 4; ++k) *(f32x4*)(F.out + O_SAS + so + 4 * k) = h[k];
    }
    __syncthreads();
    {
        const int t = F.wave, ch = 4 * lane;
        const f32x4 yv = *(const LAS f32x4*)(ys + t * 256 + ch);
        bf16* zp = CAT + (size_t)(row0 + t) * 2048 + g * 256 + ch;
        const v2u zw = *(const v2u*)zp;
        f32x4 gv; gv.x = yv.x * siluf_(bflo(zw.x)); gv.y = yv.y * siluf_(bfhi(zw.x)); gv.z = yv.z * siluf_(bflo(zw.y)); gv.w = yv.w * siluf_(bfhi(zw.y));
        const float ssq = wave_sum((gv.x * gv.x + gv.y * gv.y) + (gv.z * gv.z + gv.w * gv.w));
        const float rs = 1.0f / sqrtf(ssq * (1.0f / 256.0f) + EPS);
        const f32x4 nw = *(const f32x4*)(F.in[16] + g * 256 + ch);
        v2u o; o.x = pk2(gv.x * rs * nw.x, gv.y * rs * nw.y); o.y = pk2(gv.z * rs * nw.z, gv.w * rs * nw.w);
        *(v2u*)zp = o;
    }
    __syncthreads();
}

__device__ __forceinline__ void ssd_cum(Frame& F, int rowc  , int g, LAS float* cum, LAS float* dtl) {
    if (F.wave < 4) {
        const int e = F.wave, l = F.lane; const float* DT = (const float*)(F.ws + WS_DT); const float* DA = (const float*)(F.ws + WS_DA);
        const float a0 = DA[(size_t)(rowc + 2 * l) * 16 + 4 * g + e], a1 = DA[(size_t)(rowc + 2 * l + 1) * 16 + 4 * g + e];
        dtl[e * 128 + 2 * l] = DT[(size_t)(rowc + 2 * l) * 16 + 4 * g + e]; dtl[e * 128 + 2 * l + 1] = DT[(size_t)(rowc + 2 * l + 1) * 16 + 4 * g + e];
        float s = a0 + a1;
#pragma unroll
        for (int o = 1; o < 64; o <<= 1) { const float t = __shfl_up(s, o); if (l >= o) s += t; }
        cum[e * 128 + 2 * l + 1] = s; cum[e * 128 + 2 * l] = s - a1;
    }
}

constexpr int SSD2_XT = 0, SSD2_BT = SSD2_XT + 256 * SSD_PITCH, SSD2_CUM = SSD2_BT + 128 * SSD_PITCH, SSD2_DT = SSD2_CUM + 4 * 128 * 4, SSD2_W = SSD2_DT + 4 * 128 * 4, SSD2_END = SSD2_W + 4 * 128 * 4;
static_assert(SSD2_END <= LDSCTL_OFF, "SSD2 LDS");
__device__ __forceinline__ void ssd_state_unit(Frame& F, int unit) {
    const int g = unit & 3, c = (unit >> 2) & 15, b = unit >> 6, tid = F.tid, lane = F.lane;
    bf16* XBC = (bf16*)(F.ws + WS_XBC); const bf16* HALO = (const bf16*)(F.ws + WS_HALO);
    float* SST = F.out + O_Y; float* CDEC = (float*)(F.ws + WS_CDEC);
    LAS unsigned char* XT = F.lds + SSD2_XT; LAS unsigned char* BT = F.lds + SSD2_BT;
    LAS float* cum = (LAS float*)(F.lds + SSD2_CUM); LAS float* dtl = (LAS float*)(F.lds + SSD2_DT); LAS float* wl = (LAS float*)(F.lds + SSD2_W);
    const int rowc = b * SEQ + c * 128;
    ssd_cum(F, rowc, g, cum, dtl);
    __syncthreads();
    if (tid < 512) { const int e = tid >> 7, j = tid & 127; wl[e * 128 + j] = __expf(cum[e * 128 + 127] - cum[e * 128 + j]) * dtl[e * 128 + j];
        if (j == 127) CDEC[(b * 16 + c) * 16 + 4 * g + e] = __expf(cum[e * 128 + 127]); }
    __syncthreads();
    {
        const int cp = tid & 255, th = tid >> 8;
        const int kind = (cp < 128) ? 0 : ((cp < 192) ? 1 : 2);
        const int lc = (kind == 0) ? 2 * cp : ((kind == 1) ? 2 * (cp - 128) : 2 * (cp - 192));
        const int col = (kind == 0) ? (g * 256 + lc) : ((kind == 1) ? (1024 + g * 128 + lc) : (1536 + g * 128 + lc));
        const float* cw = F.in[11];
        const float wa0 = cw[col], wa1 = cw[2048 + col], wa2 = cw[4096 + col], wa3 = cw[6144 + col], ba = F.in[12][col];
        const float wb0 = cw[col + 1], wb1 = cw[2048 + col + 1], wb2 = cw[4096 + col + 1], wb3 = cw[6144 + col + 1], bb = F.in[12][col + 1];
        const int seg = c * 2 + th;
        float xa0 = 0.f, xa1 = 0.f, xa2 = 0.f, xb0 = 0.f, xb1 = 0.f, xb2 = 0.f;
        if (seg > 0) { const bf16* hp = HALO + ((size_t)(b * 32 + seg - 1) * 3) * 2048 + col;
            const unsigned h0 = *(const unsigned*)hp, h1 = *(const unsigned*)(hp + 2048), h2 = *(const unsigned*)(hp + 4096);
            xa0 = bflo(h0); xb0 = bfhi(h0); xa1 = bflo(h1); xb1 = bfhi(h1); xa2 = bflo(h2); xb2 = bfhi(h2); }
        const int e = lc >> 6;
        bf16* xp = XBC + (size_t)(rowc + 64 * th) * 2048 + col;
        for (int t8 = 0; t8 < 8; ++t8) {
            unsigned raw[8];
#pragma unroll
            for (int k = 0; k < 8; ++k) raw[k] = *(const unsigned*)(xp + (size_t)(t8 * 8 + k) * 2048);
            unsigned oa[4], ob[4]; float pa = 0.f, pb = 0.f;
#pragma unroll
            for (int k = 0; k < 8; ++k) {
                const float xa3 = bflo(raw[k]), xb3 = bfhi(raw[k]);
                const float va = siluf_(ba + wa0 * xa0 + wa1 * xa1 + wa2 * xa2 + wa3 * xa3), vb = siluf_(bb + wb0 * xb0 + wb1 * xb1 + wb2 * xb2 + wb3 * xb3);
                xa0 = xa1; xa1 = xa2; xa2 = xa3; xb0 = xb1; xb1 = xb2; xb2 = xb3;
                *(unsigned*)(xp + (size_t)(t8 * 8 + k) * 2048) = pk2(va, vb);
                float sa = va, sb = vb;
                if (kind == 0) { const float ww = wl[e * 128 + 64 * th + t8 * 8 + k]; sa *= ww; sb *= ww; }
                if (k & 1) { oa[k >> 1] = pk2(pa, sa); ob[k >> 1] = pk2(pb, sb); } else { pa = sa; pb = sb; }
            }
            if (kind == 0) { *(LAS v4u*)(XT + lc * SSD_PITCH + (64 * th + t8 * 8) * 2) = (v4u){oa[0], oa[1], oa[2], oa[3]}; *(LAS v4u*)(XT + (lc + 1) * SSD_PITCH + (64 * th + t8 * 8) * 2) = (v4u){ob[0], ob[1], ob[2], ob[3]}; }
            else if (kind == 1) { *(LAS v4u*)(BT + lc * SSD_PITCH + (64 * th + t8 * 8) * 2) = (v4u){oa[0], oa[1], oa[2], oa[3]}; *(LAS v4u*)(BT + (lc + 1) * SSD_PITCH + (64 * th + t8 * 8) * 2) = (v4u){ob[0], ob[1], ob[2], ob[3]}; }
        }
    }
    __syncthreads();
    {
        const int e = F.wave >> 1, ph = F.wave & 1, r = lane & 31, hh = lane >> 5;
        f32x16 acc[4];
#pragma unroll
        for (int nt = 0; nt < 4; ++nt)
#pragma unroll
            for (int i = 0; i < 16; ++i) acc[nt][i] = 0.f;
#pragma unroll
        for (int s = 0; s < 8; ++s) {
            const ssd_bf16x8 a = *(const LAS ssd_bf16x8*)(XT + (e * 64 + 32 * ph + r) * SSD_PITCH + (16 * s + 8 * hh) * 2);
#pragma unroll
            for (int nt = 0; nt < 4; ++nt) {
                const ssd_bf16x8 bq = *(const LAS ssd_bf16x8*)(BT + (32 * nt + r) * SSD_PITCH + (16 * s + 8 * hh) * 2);
                acc[nt] = __builtin_amdgcn_mfma_f32_32x32x16_bf16(a, bq, acc[nt], 0, 0, 0);
            }
        }
        float* sp = SST + ((size_t)((b * 16 + c) * 16 + 4 * g + e) * 64 + 32 * ph) * 128;
#pragma unroll
        for (int nt = 0; nt < 4; ++nt)
#pragma unroll
            for (int i = 0; i < 16; ++i) { const int prow = (i & 3) + 8 * (i >> 2) + 4 * hh; sp[(size_t)prow * 128 + 32 * nt + r] = acc[nt][i]; }
    }
    __syncthreads();
}

__device__ __forceinline__ void ssd_carry(Frame& F) {
    float* SST = F.out + O_Y; const float* CDEC = (const float*)(F.ws + WS_CDEC);
    const int gt = (int)blockIdx.x * 512 + F.tid, NT = F.G * 512;
    for (int idx = gt; idx < 8 * 16 * 2048; idx += NT) {
        const int q4 = idx & 2047, head = (idx >> 11) & 15, b = idx >> 15;
        f32x4 h = (f32x4){0.f, 0.f, 0.f, 0.f};
        for (int c = 0; c < 16; ++c) {
            f32x4* sp = (f32x4*)(SST + ((size_t)((b * 16 + c) * 16 + head)) * 8192) + q4;
            const f32x4 s = *sp; *sp = h;
            h = h * CDEC[(b * 16 + c) * 16 + head] + s;
        }
        *((f32x4*)(F.out + O_PAS + (size_t)(b * 16 + head) * 8192) + q4) = h;
    }
}

constexpr int SSD4_CS = 0, SSD4_BS = SSD4_CS + 128 * SSD_PITCH, SSD4_L = SSD4_BS + 128 * SSD_PITCH, SSD4_XT = SSD4_L + 128 * SSD_PITCH, SSD4_HIN = SSD4_XT + 64 * SSD_PITCH,
              SSD4_CUM = SSD4_HIN + 64 * SSD_PITCH, SSD4_DT = SSD4_CUM + 4 * 128 * 4, SSD4_RED = SSD4_DT + 4 * 128 * 4, SSD4_END = SSD4_RED + 2 * 128 * 4;
static_assert(SSD4_END <= LDSCTL_OFF, "SSD4 LDS");
__device__ __forceinline__ void ssd_y_unit(Frame& F, int unit) {
    const int g = unit & 3, c = (unit >> 2) & 15, b = unit >> 6, tid = F.tid, lane = F.lane, wv = F.wave, r = lane & 31, hh = lane >> 5;
    const bf16* XBC = (const bf16*)(F.ws + WS_XBC); bf16* CAT = (bf16*)(F.ws + WS_CAT); const float* HIN = F.out + O_Y;
    LAS unsigned char* Cs = F.lds + SSD4_CS; LAS unsigned char* Bs = F.lds + SSD4_BS; LAS unsigned char* Lm = F.lds + SSD4_L; LAS unsigned char* XT = F.lds + SSD4_XT; LAS unsigned char* Hn = F.lds + SSD4_HIN;
    LAS float* cum = (LAS float*)(F.lds + SSD4_CUM); LAS float* dtl = (LAS float*)(F.lds + SSD4_DT); LAS float* red = (LAS float*)(F.lds + SSD4_RED);
    const int rowc = b * SEQ + c * 128;
    ssd_cum(F, rowc, g, cum, dtl);
#pragma unroll
    for (int k = 0; k < 4; ++k) { const int pc = tid + 512 * k, row = pc >> 4, q = pc & 15;
        *(LAS v4u*)(Bs + row * SSD_PITCH + q * 16) = *(const v4u*)(XBC + (size_t)(rowc + row) * 2048 + 1024 + g * 128 + q * 8);
        *(LAS v4u*)(Cs + row * SSD_PITCH + q * 16) = *(const v4u*)(XBC + (size_t)(rowc + row) * 2048 + 1536 + g * 128 + q * 8); }
    __syncthreads();
    f32x16 G[2];
#pragma unroll
    for (int tt = 0; tt < 2; ++tt) {
        const int idx = 2 * wv + tt, it = idx >> 2, jt = idx & 3;
#pragma unroll
        for (int i = 0; i < 16; ++i) G[tt][i] = 0.f;
        if (jt <= it) {
#pragma unroll
            for (int s = 0; s < 8; ++s) {
                const ssd_bf16x8 a = *(const LAS ssd_bf16x8*)(Cs + (32 * it + r) * SSD_PITCH + (16 * s + 8 * hh) * 2);
                const ssd_bf16x8 bq = *(const LAS ssd_bf16x8*)(Bs + (32 * jt + r) * SSD_PITCH + (16 * s + 8 * hh) * 2);
                G[tt] = __builtin_amdgcn_mfma_f32_32x32x16_bf16(a, bq, G[tt], 0, 0, 0);
            }
        }
    }
    const int yit = wv >> 1, ypt = wv & 1;
    f32x16 yv0, yv1, yv2, yv3;
    for (int e = 0; e < 4; ++e) {
        asm volatile("" ::: "memory");
#pragma unroll
        for (int tt = 0; tt < 2; ++tt) {
            const int idx = 2 * wv + tt, it = idx >> 2, jt = idx & 3;
            const int j = 32 * jt + r; const float cj = cum[e * 128 + j], dj = dtl[e * 128 + j];
#pragma unroll
            for (int i16 = 0; i16 < 16; ++i16) {
                const int i = 32 * it + (i16 & 3) + 8 * (i16 >> 2) + 4 * hh;
                float v = 0.f;
                if (j <= i) v = G[tt][i16] * __expf(cum[e * 128 + i] - cj) * dj;
                *(LAS unsigned short*)(Lm + i * SSD_PITCH + j * 2) = (unsigned short)f2bf(v);
            }
        }
        { const int cp = tid & 31, tb = tid >> 5; unsigned raw[8];
#pragma unroll
          for (int k = 0; k < 8; ++k) raw[k] = *(const unsigned*)(XBC + (size_t)(rowc + tb * 8 + k) * 2048 + g * 256 + e * 64 + 2 * cp);
          v4u oa, ob;
          oa.x = (raw[0] & 0xffffu) | (raw[1] << 16); oa.y = (raw[2] & 0xffffu) | (raw[3] << 16); oa.z = (raw[4] & 0xffffu) | (raw[5] << 16); oa.w = (raw[6] & 0xffffu) | (raw[7] << 16);
          ob.x = (raw[0] >> 16) | (raw[1] & 0xffff0000u); ob.y = (raw[2] >> 16) | (raw[3] & 0xffff0000u); ob.z = (raw[4] >> 16) | (raw[5] & 0xffff0000u); ob.w = (raw[6] >> 16) | (raw[7] & 0xffff0000u);
          *(LAS v4u*)(XT + (2 * cp) * SSD_PITCH + tb * 16) = oa; *(LAS v4u*)(XT + (2 * cp + 1) * SSD_PITCH + tb * 16) = ob; }
        { const int p = tid >> 3, n0 = (tid & 7) * 16; const f32x4* hp = (const f32x4*)(HIN + ((size_t)((b * 16 + c) * 16 + 4 * g + e) * 64 + p) * 128 + n0);
          const f32x4 h0 = hp[0], h1 = hp[1], h2 = hp[2], h3 = hp[3];
          *(LAS v4u*)(Hn + p * SSD_PITCH + n0 * 2) = (v4u){pk2(h0.x, h0.y), pk2(h0.z, h0.w), pk2(h1.x, h1.y), pk2(h1.z, h1.w)};
          *(LAS v4u*)(Hn + p * SSD_PITCH + n0 * 2 + 16) = (v4u){pk2(h2.x, h2.y), pk2(h2.z, h2.w), pk2(h3.x, h3.y), pk2(h3.z, h3.w)}; }
        __syncthreads();
        f32x16 yd;
#pragma unroll
        for (int i = 0; i < 16; ++i) yd[i] = 0.f;
#pragma unroll
        for (int s = 0; s < 8; ++s) {
            const ssd_bf16x8 ac = *(const LAS ssd_bf16x8*)(Cs + (32 * yit + r) * SSD_PITCH + (16 * s + 8 * hh) * 2);
            const ssd_bf16x8 bh = *(const LAS ssd_bf16x8*)(Hn + (32 * ypt + r) * SSD_PITCH + (16 * s + 8 * hh) * 2);
            yd = __builtin_amdgcn_mfma_f32_32x32x16_bf16(ac, bh, yd, 0, 0, 0);
        }
        const float dsk = F.in[15][4 * g + e];
#pragma unroll
        for (int i16 = 0; i16 < 16; ++i16) {
            const int i = 32 * yit + (i16 & 3) + 8 * (i16 >> 2) + 4 * hh;
            const float xv = bf2f(*(const LAS unsigned short*)(XT + (32 * ypt + r) * SSD_PITCH + i * 2));
            yd[i16] = __expf(cum[e * 128 + i]) * yd[i16] + dsk * xv;
        }
#pragma unroll
        for (int s = 0; s < 8; ++s) {
            const ssd_bf16x8 bx = *(const LAS ssd_bf16x8*)(XT + (32 * ypt + r) * SSD_PITCH + (16 * s + 8 * hh) * 2);
            const ssd_bf16x8 al = *(const LAS ssd_bf16x8*)(Lm + (32 * yit + r) * SSD_PITCH + (16 * s + 8 * hh) * 2);
            yd = __builtin_amdgcn_mfma_f32_32x32x16_bf16(al, bx, yd, 0, 0, 0);
        }
        if (e == 0) yv0 = yd; else if (e == 1) yv1 = yd; else if (e == 2) yv2 = yd; else yv3 = yd;
        __syncthreads();
    }
#pragma unroll
    for (int i16 = 0; i16 < 16; ++i16) {
        const int i = 32 * yit + (i16 & 3) + 8 * (i16 >> 2) + 4 * hh;
        float s = 0.f;
        const bf16* zp = CAT + (size_t)(rowc + i) * 2048 + g * 256 + 32 * ypt + r;
        { const float gv = yv0[i16] * siluf_(bf2f(zp[0])); yv0[i16] = gv; s += gv * gv; }
        { const float gv = yv1[i16] * siluf_(bf2f(zp[64])); yv1[i16] = gv; s += gv * gv; }
        { const float gv = yv2[i16] * siluf_(bf2f(zp[128])); yv2[i16] = gv; s += gv * gv; }
        { const float gv = yv3[i16] * siluf_(bf2f(zp[192])); yv3[i16] = gv; s += gv * gv; }
#pragma unroll
        for (int o = 1; o < 32; o <<= 1) s += __shfl_xor(s, o);
        if (r == 0) red[ypt * 128 + i] = s;
    }
    __syncthreads();
#pragma unroll
    for (int i16 = 0; i16 < 16; ++i16) {
        const int i = 32 * yit + (i16 & 3) + 8 * (i16 >> 2) + 4 * hh;
        const float tot = red[i] + red[128 + i];
        const float rs = 1.0f / sqrtf(tot * (1.0f / 256.0f) + EPS);
        const int ch = g * 256 + 32 * ypt + r; bf16* op = CAT + (size_t)(rowc + i) * 2048 + ch; const float* nw = F.in[16] + ch;
        op[0] = (bf16)f2bf(yv0[i16] * rs * nw[0]); op[64] = (bf16)f2bf(yv1[i16] * rs * nw[64]); op[128] = (bf16)f2bf(yv2[i16] * rs * nw[128]); op[192] = (bf16)f2bf(yv3[i16] * rs * nw[192]);
    }
    __syncthreads();
}
constexpr size_t WS_WDWT = 235 * MiB;
template <int T>
__device__ __forceinline__ void cconv_unit(Frame& F, int row0  , int hist_rows_avail  , const float* state  ) {
    const bf16* G = (const bf16*)(F.ws + WS_G); bf16* CV = (bf16*)(F.ws + WS_CV); const float* WT = (const float*)(F.ws + WS_WDWT);
    LAS unsigned char* tile = F.lds;
    const int tid = F.tid, lane = F.lane;
    constexpr int ROWS = T + 30;
    for (int pc = tid; pc < ROWS * 128; pc += NWAVES * 64) {
        const int rr = pc >> 7, q = pc & 127;
        v4u v = (v4u){0u, 0u, 0u, 0u};
        if (rr >= 30) v = *(const v4u*)(G + (size_t)(row0 + rr - 30) * 1024 + q * 8);
        else if (state) { const f32x4 a = *(const f32x4*)(state + (size_t)rr * 1024 + q * 8), b2 = *(const f32x4*)(state + (size_t)rr * 1024 + q * 8 + 4);
                          v = (v4u){pk2(a.x, a.y), pk2(a.z, a.w), pk2(b2.x, b2.y), pk2(b2.z, b2.w)}; }
        else if (30 - rr <= hist_rows_avail) v = *(const v4u*)(G + (size_t)(row0 + rr - 30) * 1024 + q * 8);
        *(LAS v4u*)(tile + rr * 2048 + q * 16) = v;
    }
    __syncthreads();
    float o0[T], o1[T];
    {
        const int ch = tid;
        float xw[ROWS], w[31];
#pragma unroll
        for (int k = 0; k < ROWS; ++k) xw[k] = bf2f(*(const LAS unsigned short*)(tile + k * 2048 + ch * 2));
        { const f32x4* wp = (const f32x4*)(WT + (size_t)ch * 32);
#pragma unroll
          for (int k4 = 0; k4 < 8; ++k4) { const f32x4 t4 = wp[k4]; w[4 * k4] = t4.x; w[4 * k4 + 1] = t4.y; w[4 * k4 + 2] = t4.z; if (k4 < 7) w[4 * k4 + 3] = t4.w; } }
        const float bias = F.in[31][ch];
#pragma unroll
        for (int t = 0; t < T; ++t) {
            float a0 = bias, a1 = 0.f;
#pragma unroll
            for (int k = 0; k < 30; k += 2) { a0 += w[k] * xw[t + k]; a1 += w[k + 1] * xw[t + k + 1]; }
            a0 += w[30] * xw[t + 30];
            o0[t] = a0 + a1;
        }
    }
    asm volatile("" ::: "memory");
    {
        const int ch = tid + 512;
        float xw[ROWS], w[31];
#pragma unroll
        for (int k = 0; k < ROWS; ++k) xw[k] = bf2f(*(const LAS unsigned short*)(tile + k * 2048 + ch * 2));
        { const f32x4* wp = (const f32x4*)(WT + (size_t)ch * 32);
#pragma unroll
          for (int k4 = 0; k4 < 8; ++k4) { const f32x4 t4 = wp[k4]; w[4 * k4] = t4.x; w[4 * k4 + 1] = t4.y; w[4 * k4 + 2] = t4.z; if (k4 < 7) w[4 * k4 + 3] = t4.w; } }
        const float bias = F.in[31][ch];
#pragma unroll
        for (int t = 0; t < T; ++t) {
            float a0 = bias, a1 = 0.f;
#pragma unroll
            for (int k = 0; k < 30; k += 2) { a0 += w[k] * xw[t + k]; a1 += w[k + 1] * xw[t + k + 1]; }
            a0 += w[30] * xw[t + 30];
            o1[t] = a0 + a1;
        }
    }
    LAS float* red = (LAS float*)(F.lds + ROWS * 2048);
    float mean[T], rstd[T];
#pragma unroll
    for (int t = 0; t < T; ++t) { const float s = wave_sum(o0[t] + o1[t]); if (lane == 0) red[F.wave * T + t] = s; }
    __syncthreads();
#pragma unroll
    for (int t = 0; t < T; ++t) { float s = 0.f;
#pragma unroll
        for (int wv = 0; wv < NWAVES; ++wv) s += red[wv * T + t];
        mean[t] = s * (1.0f / 1024.0f); asm volatile("" ::: "memory"); }
#pragma unroll
    for (int t = 0; t < T; ++t) { const float d0 = o0[t] - mean[t], d1 = o1[t] - mean[t]; const float s = wave_sum(d0 * d0 + d1 * d1); if (lane == 0) red[(NWAVES + F.wave) * T + t] = s; }
    __syncthreads();
#pragma unroll
    for (int t = 0; t < T; ++t) { float s = 0.f;
#pragma unroll
        for (int wv = 0; wv < NWAVES; ++wv) s += red[(NWAVES + wv) * T + t];
        rstd[t] = 1.0f / sqrtf(s * (1.0f / 1024.0f) + EPS); asm volatile("" ::: "memory"); }
    const float lw0 = F.in[32][tid], lb0 = F.in[33][tid], lw1 = F.in[32][tid + 512], lb1 = F.in[33][tid + 512];
#pragma unroll
    for (int t = 0; t < T; ++t) {
        CV[(size_t)(row0 + t) * 1024 + tid] = (bf16)f2bf(siluf_((o0[t] - mean[t]) * rstd[t] * lw0 + lb0));
        CV[(size_t)(row0 + t) * 1024 + tid + 512] = (bf16)f2bf(siluf_((o1[t] - mean[t]) * rstd[t] * lw1 + lb1));
    }
    __syncthreads();
}
constexpr int CCONV_PROMPT_UNITS = NBP * (SEQ / 16), CCONV_UNITS = CCONV_PROMPT_UNITS + NBS;
__device__ __forceinline__ void cconv_phase(Frame& F) {
    for (int u = (int)blockIdx.x; u < CCONV_UNITS; u += F.G) {
        if (u < CCONV_PROMPT_UNITS) { const int b = u >> 7, tt = u & 127; cconv_unit<16>(F, b * SEQ + 16 * tt, 16 * tt, nullptr); }
        else { const int b = u - CCONV_PROMPT_UNITS; const float* st = F.in[6] + (size_t)b * 30 * 1024;
            cconv_unit<8>(F, MP + 8 * b, 0, st);
            for (int i = F.tid; i < 22 * 256; i += NWAVES * 64) ((f32x4*)(F.out + O_SCC + (size_t)b * 30 * 1024))[i] = ((const f32x4*)(st + 8 * 1024))[i];
        }
    }
}
#define PHASE2_BODY { \
    for (int u = bx; u < S5_UNITS; u += F.G) s5_block_unit(F, u); \
    __syncthreads(); \
    for (int u = bx; u < 512; u += F.G) ssd_state_unit(F, u); \
    for (int u = bx; u < 512; u += F.G) ssd_sample_unit(F, u); }
#define PHASE3_BODY { ssd_carry(F); }
#define PHASE4_BODY { \
    for (int u = bx; u < 512; u += F.G) ssd_y_unit(F, u); \
    pg8::Gemm g{U, (const bf16*)(F.ws + WS_WGLU), MT, 1024, 1024, 1024}; pg8::StaticOrder S; S.init(MT, 1024, F.G, bx); \
    pg8::EpiGlu E{U, CAT, F.in[26]}; \
    pg8::gemm_phase<pg8::EpiGlu, pg8::StaticOrder, true, true>(F.lds + RING_OFF, g, S, E); }
#define PHASE9_BODY { cconv_phase(F); }
struct Args { const float* in[38]; float* out; unsigned char* ws; int ph_lo, ph_hi; };
constexpr int N_PHASES = 14;

__global__ void __launch_bounds__(NWAVES * 64, 2) hybrid_fwd(Args args) {
    extern __shared__ __attribute__((aligned(16))) unsigned char lds[];
    Frame F;
    F.lds = (LAS unsigned char*)lds;
    F.MISC = (volatile LAS unsigned*)(F.lds + MISC_OFF);
    F.tid = threadIdx.x; F.lane = F.tid & 63; F.wave = __builtin_amdgcn_readfirstlane(F.tid >> 6);
    F.G = gridDim.x; { const int bx = blockIdx.x; F.vcu = (F.G % 8 == 0) ? (bx % 8) * (F.G / 8) + bx / 8 : bx; }
    F.ws = args.ws; F.out = args.out; F.ctl = (gu32*)(args.ws + WS_CTL);
    F.in = args.in;
    for (int u = F.tid; u < (LDS_BYTES - LDSCTL_OFF) / 4; u += NWAVES * 64) ((LAS unsigned*)(F.lds + LDSCTL_OFF))[u] = 0u;
    __syncthreads();
    XcdBarrier bar = xcd_barrier_post((unsigned*)(F.ctl + CW_BAR), F.MISC + 8);
    const int lo = args.ph_lo, hi = args.ph_hi;
#define IN(k) (lo <= (k) && (k) < hi)
#define SEAM(k) do { if (IN(k) && IN((k) + 1)) xcd_barrier(bar); } while (0)

    bf16* CAT = (bf16*)(F.ws + WS_CAT); bf16* XBC = (bf16*)(F.ws + WS_XBC); bf16* U = (bf16*)(F.ws + WS_U); bf16* XB = (bf16*)(F.ws + WS_XB);
    bf16* H = (bf16*)(F.ws + WS_H); bf16* Gb = (bf16*)(F.ws + WS_G); bf16* CV = (bf16*)(F.ws + WS_CV);
    float* SS = (float*)(F.ws + WS_SS); float* X = F.out + O_Y;
    const int bx = (int)blockIdx.x;

    if (IN(0)) { p0_prologue(F); } SEAM(0);
    if (IN(1)) {
        pg8::Gemm g{CAT + 1024, (const bf16*)(F.ws + WS_WIN), MT, 4096, 1024, 2048}; pg8::StaticOrder S; S.init(MT, 4096, F.G, bx);
        pg8::EpiInProj E{CAT, XBC, U, SS, F.out, (bf16*)(F.ws + WS_HALO)};
        pg8::gemm_phase<pg8::EpiInProj, pg8::StaticOrder, true, true>(F.lds + RING_OFF, g, S, E);
    } SEAM(1);
    if (IN(2)) { PHASE2_BODY } SEAM(2);
    if (IN(3)) { PHASE3_BODY } SEAM(3);
    if (IN(4)) { PHASE4_BODY } SEAM(4);
    if (IN(5)) {
        pg8::Gemm g{CAT, (const bf16*)(F.ws + WS_WOUT), MT, 1024, 2048, 2048}; pg8::StaticOrder S; S.init(MT, 1024, F.G, bx);
        pg8::EpiRes E{F.in[0], F.in[1], X, XB, SS, nullptr};
        pg8::gemm_phase<pg8::EpiRes, pg8::StaticOrder, true, true>(F.lds + RING_OFF, g, S, E);
    } SEAM(5);
    if (IN(6)) {
        pg8::Gemm g{XB, (const bf16*)(F.ws + WS_WFF1), MT, FF, 1024, 1024}; pg8::StaticOrder S; S.init(MT, FF, F.G, bx);
        pg8::EpiFF1 E{H, SS};
        pg8::gemm_phase<pg8::EpiFF1, pg8::StaticOrder, true, true>(F.lds + RING_OFF, g, S, E);
    } SEAM(6);
    if (IN(7)) {
        pg8::Gemm g{H, (const bf16*)(F.ws + WS_WFF2), MT, 1024, FF, FF}; pg8::StaticOrder S; S.init(MT, 1024, F.G, bx);
        pg8::EpiRes E{X, X + (size_t)MP * 1024, X, XB, SS, nullptr};
        pg8::gemm_phase<pg8::EpiRes, pg8::StaticOrder, true, true>(F.lds + RING_OFF, g, S, E);
    } SEAM(7);
    if (IN(8)) {
        pg8::Gemm g{XB, (const bf16*)(F.ws + WS_WPW1), MT, 2048, 1024, 1024}; pg8::StaticOrder S; S.init(MT, 2048, F.G, bx);
        pg8::EpiPw1 E{Gb, SS, F.in[29], F.out};
        pg8::gemm_phase<pg8::EpiPw1, pg8::StaticOrder, true, true>(F.lds + RING_OFF, g, S, E);
    } SEAM(8);
    if (IN(9)) { PHASE9_BODY } SEAM(9);
    if (IN(10)) {
        pg8::Gemm g{CV, (const bf16*)(F.ws + WS_WPW2), MT, 1024, 1024, 1024}; pg8::StaticOrder S; S.init(MT, 1024, F.G, bx);
        pg8::EpiRes E{X, X + (size_t)MP * 1024, X, XB, SS, F.in[35]};
        pg8::gemm_phase<pg8::EpiRes, pg8::StaticOrder, true, true>(F.lds + RING_OFF, g, S, E);
    } SEAM(10);
    if (IN(11)) {
        pg8::Gemm g{XB, (const bf16*)(F.ws + WS_WFF1) + (size_t)FF * 1024, MT, FF, 1024, 1024}; pg8::StaticOrder S; S.init(MT, FF, F.G, bx);
        pg8::EpiFF1 E{H, SS};
        pg8::gemm_phase<pg8::EpiFF1, pg8::StaticOrder, true, true>(F.lds + RING_OFF, g, S, E);
    } SEAM(11);
    if (IN(12)) {
        pg8::Gemm g{H, (const bf16*)(F.ws + WS_WFF2) + (size_t)1024 * FF, MT, 1024, FF, FF}; pg8::StaticOrder S; S.init(MT, 1024, F.G, bx);
        pg8::EpiRes E{X, X + (size_t)MP * 1024, X, nullptr, SS, nullptr};
        pg8::gemm_phase<pg8::EpiRes, pg8::StaticOrder, true, true>(F.lds + RING_OFF, g, S, E);
    } SEAM(12);
    if (IN(13)) {
        const int gw = F.vcu * NWAVES + F.wave, NGW = F.G * NWAVES; const float* nf = F.in[9];
        f32x4 wv[4];
#pragma unroll
        for (int j = 0; j < 4; ++j) wv[j] = ((const f32x4*)nf)[F.lane + 64 * j];
        for (int m = gw; m < MT; m += NGW) {
            const float rs = row_rstd(SS, m);
            f32x4* xr = (f32x4*)(X + (size_t)m * DM) + F.lane;
#pragma unroll
            for (int j = 0; j < 4; ++j) { f32x4 v = xr[64 * j]; v = v * rs * wv[j]; xr[64 * j] = v; }
        }
    }
#undef IN
#undef SEAM
}

extern "C" void kernel_launch(void* const* d_in, const int* in_sizes, int n_in, void* d_out, int out_size, void* d_ws, size_t ws_size, hipStream_t stream) {
    static int grid = 0;
    if (grid == 0) {
        if (n_in != 38 || out_size != (int)O_END || ws_size < WS_END) { fprintf(stderr, "kernel_launch: unexpected shapes: n_in %d out %d ws %zu\n", n_in, out_size, ws_size); grid = -1; return; }
        int dev = 0, cus = 0, per_cu = 0;
        if (hipGetDevice(&dev) != hipSuccess || hipDeviceGetAttribute(&cus, hipDeviceAttributeMultiprocessorCount, dev) != hipSuccess) { grid = -1; return; }
        if (hipFuncSetAttribute((const void*)hybrid_fwd, hipFuncAttributeMaxDynamicSharedMemorySize, LDS_BYTES) != hipSuccess) { fprintf(stderr, "kernel_launch: hipFuncSetAttribute failed\n"); grid = -1; return; }
        if (hipOccupancyMaxActiveBlocksPerMultiprocessor(&per_cu, (const void*)hybrid_fwd, NWAVES * 64, LDS_BYTES) != hipSuccess || per_cu < 1)
            fprintf(stderr, "kernel_launch: note: occupancy query reports %d blocks per CU\n", per_cu);
        (void)hipGetLastError();
        grid = cus;
    }
    if (grid < 0) return;
    if (hipMemsetAsync((char*)d_ws + WS_CTL, 0, CTL_ZERO_BYTES, stream) != hipSuccess) { fprintf(stderr, "kernel_launch: memset failed\n"); return; }
    Args a{};
    for (int i = 0; i < 38; ++i) a.in[i] = (const float*)d_in[i];
    a.out = (float*)d_out; a.ws = (unsigned char*)d_ws;
#if MK_N_LAUNCHES == 1
    a.ph_lo = 0; a.ph_hi = N_PHASES;
    hipLaunchKernelGGL(hybrid_fwd, dim3(grid), dim3(NWAVES * 64), LDS_BYTES, stream, a);
#else
    for (int p = 0; p < N_PHASES; ++p) { a.ph_lo = p; a.ph_hi = p + 1; hipLaunchKernelGGL(hybrid_fwd, dim3(grid), dim3(NWAVES * 64), LDS_BYTES, stream, a); }
#endif
    const hipError_t le = hipPeekAtLastError();
    if (le != hipSuccess) fprintf(stderr, "kernel_launch: launch failed: %s\n", hipGetErrorName(le));
}
```

```cpp
#include <hip/hip_runtime.h>
#include <cstdio>
#include <cstdint>
#ifndef MK_N_LAUNCHES
#define MK_N_LAUNCHES 1
#endif
__device__ __forceinline__ float row_rstd(const float* SS, int r);
namespace pg8 {
#define PG8_LAS __attribute__((address_space(3)))
typedef unsigned short bf16_t;
typedef short bf16x8 __attribute__((ext_vector_type(8)));
typedef float f32x4 __attribute__((ext_vector_type(4)));
typedef unsigned u32x4 __attribute__((ext_vector_type(4)));
typedef unsigned u32x2 __attribute__((ext_vector_type(2)));
constexpr int BM = 256, BK = 64, HALF = 128, HTB = HALF * BK * 2  , STAGE_BYTES = 8 * HTB, NXCD = 8, WGM = 8;

__host__ __device__ __forceinline__ int lds_byte(int r, int c) { const int st = (r >> 4) * 2 + (c >> 5), rr = r & 15, cc = c & 31, ob = rr * 64 + cc * 2; return st * 1024 + (ob ^ (((ob >> 9) & 1) << 5)); }
__host__ __device__ __forceinline__ void stage_rc(int b, int& R, int& C) { const int st = b / 1024, sb = b % 1024, swz = sb ^ (((sb >> 9) & 1) << 5); R = (st >> 1) * 16 + swz / 64; C = (st & 1) * 32 + (swz % 64) / 2; }
__host__ __device__ __forceinline__ int perm32(int rho) { const int n = rho >> 4, i = rho & 15; return 8 * (i >> 2) + 4 * n + (i & 3); }

struct Unit { int pm, pn; };
struct Gemm { const bf16_t* A; const bf16_t* Bt; int M, N, K, lda; };

struct StaticOrder {
    int nM, nN, nwg, G, c;
    __host__ __device__ void init(int M, int N, int G_, int c_) { nM = M / BM; nN = N / BM; nwg = nM * nN; G = G_; c = c_; }
    __host__ __device__ bool next(int i, Unit& u) const {
        const long L = (long)i * G + c; if (L >= nwg) return false;
        int wgid = (int)L; { const int q = nwg / NXCD, r = nwg % NXCD, xcd = wgid % NXCD, off = wgid / NXCD; wgid = (xcd < r ? xcd * (q + 1) : r * (q + 1) + (xcd - r) * q) + off; }
        const int nig = WGM * nN, gid = wgid / nig, fm = gid * WGM, gsz = (nM - fm) < WGM ? (nM - fm) : WGM;
        u.pm = fm + ((wgid % nig) % gsz); u.pn = (wgid % nig) / gsz; return true;
    }
};

__device__ __forceinline__ unsigned cvt_pk_bf16(float lo, float hi) { unsigned r; asm volatile("v_cvt_pk_bf16_f32 %0, %1, %2" : "=v"(r) : "v"(lo), "v"(hi)); return r; }

template <class Epi, class Sched, bool ALIGN_EPI = false, bool SP2 = false>
__device__ __forceinline__ void gemm_phase(PG8_LAS unsigned char* lds, const Gemm g, const Sched& S, const Epi& E, const float* SSp = nullptr) {
    const int tid = threadIdx.x, wid = __builtin_amdgcn_readfirstlane(tid >> 6), lane = tid & 63, wr = wid >> 2, wc = wid & 3, fr = lane & 15, fq = lane >> 4;
    const int K = g.K, nt = K / BK, lda = g.lda;
    unsigned voffA[2], voffB[2];
#pragma unroll
    for (int i = 0; i < 2; ++i) { int R, C; stage_rc(tid * 16 + i * 8192, R, C); const int Rb = (R >> 5) * 64 + perm32(R & 31);
        voffA[i] = (unsigned)(R * lda + C) * 2u; voffB[i] = (unsigned)(Rb * K + C) * 2u; }
    static_assert(Epi::PERM, "the column map assumes PERM epilogues");
    const size_t kstep = (size_t)(BK * 2);
    const size_t hA = (size_t)HALF * lda * 2, hB = (size_t)32 * K * 2;
    const size_t tA = 2 * hA, tB = (size_t)BM * K * 2;
    const unsigned ldsw = (unsigned)wid * 1024u;
    const int aoff = lds_byte(wr * 64 + fr, fq * 8), boff = lds_byte(wc * 32 + fr, fq * 8);
#define PG8_SA(b, h) (((b) * 2 + (h)) * HTB)
#define PG8_SB(b, h) ((4 + (b) * 2 + (h)) * HTB)
#define PG8_STAGE(bufoff, gbase, voff) do { _Pragma("unroll") for (int _i = 0; _i < 2; ++_i) \
        __builtin_amdgcn_global_load_lds((const unsigned*)((const char*)(gbase) + (voff)[_i]), (PG8_LAS unsigned*)(lds + (bufoff) + ldsw + _i * 8192), 16, 0, 0); } while (0)
#define PG8_LDA(dst, b, h) do { _Pragma("unroll") for (int m = 0; m < 4; ++m) _Pragma("unroll") for (int k = 0; k < 2; ++k) dst[m][k] = *(const PG8_LAS bf16x8*)(lds + PG8_SA(b, h) + aoff + m * 2048 + k * 1024); } while (0)
#define PG8_LDB(dst, b, h) do { _Pragma("unroll") for (int n = 0; n < 2; ++n) _Pragma("unroll") for (int k = 0; k < 2; ++k) dst[n][k] = *(const PG8_LAS bf16x8*)(lds + PG8_SB(b, h) + boff + n * 2048 + k * 1024); } while (0)
#define PG8_MMA(ai, bj, At, Bt) do { __builtin_amdgcn_s_setprio(1); _Pragma("unroll") for (int m = 0; m < 4; ++m) _Pragma("unroll") for (int n = 0; n < 2; ++n) _Pragma("unroll") for (int k = 0; k < 2; ++k) \
        acc[ai][bj][m][n] = __builtin_amdgcn_mfma_f32_16x16x32_bf16(Bt[n][k], At[m][k], acc[ai][bj][m][n], 0, 0, 0); __builtin_amdgcn_s_setprio(0); } while (0)
#define PG8_WAIT_V(n) asm volatile("s_waitcnt vmcnt(" #n ")" ::: "memory")
#define PG8_WAIT_L(n) asm volatile("s_waitcnt lgkmcnt(" #n ")" ::: "memory")
#define PG8_BAR __builtin_amdgcn_s_barrier()
#define PG8_SCHED __builtin_amdgcn_sched_barrier(0)
    Unit cur, nxt; int ui = 0;
    if (!S.next(0, cur)) return;
    PG8_LAS float* RS = (PG8_LAS float*)(lds + STAGE_BYTES);
    if (SSp) {
#pragma unroll
        for (int j = 0; j < 2; ++j) { const int uj = (tid >> 8) + 2 * j; Unit uu;
            if (S.next(uj, uu)) RS[uj * 256 + (tid & 255)] = row_rstd(SSp, uu.pm * BM + (tid & 255)); }
        asm volatile("s_waitcnt vmcnt(0) lgkmcnt(0)" ::: "memory"); __builtin_amdgcn_s_barrier(); asm volatile("" ::: "memory");
    }
    f32x4 acc[2][2][4][2];
#pragma unroll
    for (int a = 0; a < 2; ++a)
#pragma unroll
        for (int b = 0; b < 2; ++b)
#pragma unroll
            for (int m = 0; m < 4; ++m)
#pragma unroll
                for (int n = 0; n < 2; ++n) acc[a][b][m][n] = (f32x4){0.f, 0.f, 0.f, 0.f};
    bf16x8 At[4][2], B0[2][2], B1[2][2];
    const char* cA = (const char*)g.A + (size_t)cur.pm * tA; const char* cB = (const char*)g.Bt + (size_t)cur.pn * tB;
    if constexpr (SP2) {
        PG8_STAGE(PG8_SB(0, 0), cB, voffB); PG8_STAGE(PG8_SB(0, 1), cB + hB, voffB); PG8_STAGE(PG8_SA(0, 0), cA, voffA); PG8_STAGE(PG8_SA(0, 1), cA + hA, voffA);
        if (wr == 1) PG8_BAR;
        PG8_WAIT_V(2); PG8_BAR;
        PG8_STAGE(PG8_SB(1, 0), cB + kstep, voffB); PG8_STAGE(PG8_SA(1, 0), cA + kstep, voffA); PG8_STAGE(PG8_SB(1, 1), cB + hB + kstep, voffB);
        PG8_WAIT_V(6); PG8_BAR;
    } else {
        PG8_STAGE(PG8_SB(0, 0), cB, voffB); PG8_STAGE(PG8_SA(0, 0), cA, voffA); PG8_STAGE(PG8_SB(0, 1), cB + hB, voffB); PG8_STAGE(PG8_SA(0, 1), cA + hA, voffA);
        if (wr == 1) PG8_BAR;
        PG8_WAIT_V(4); PG8_BAR;
        PG8_STAGE(PG8_SB(1, 0), cB + kstep, voffB); PG8_STAGE(PG8_SA(1, 0), cA + kstep, voffA); PG8_STAGE(PG8_SB(1, 1), cB + hB + kstep, voffB);
        PG8_WAIT_V(6); PG8_BAR;
    }
    for (;;) {
        const bool has_next = S.next(ui + 1, nxt);
        const char* nA = has_next ? (const char*)g.A + (size_t)nxt.pm * tA : cA; const char* nB = has_next ? (const char*)g.Bt + (size_t)nxt.pn * tB : cB;
        for (int t = 0; t < nt; t += 2) {
            const bool last = (t == nt - 2);
            const char* a1 = cA + (size_t)(t + 1) * kstep;
            const char* a2 = last ? nA : cA + (size_t)(t + 2) * kstep; const char* b2 = last ? nB : cB + (size_t)(t + 2) * kstep;
            const char* a3 = a2 + kstep; const char* b3 = b2 + kstep;
            if constexpr (SP2) {
            PG8_LDB(B0, 0, 0); PG8_LDB(B1, 0, 1); PG8_SCHED; PG8_LDA(At, 0, 0); PG8_STAGE(PG8_SA(1, 1), a1 + hA, voffA);
            PG8_WAIT_V(8); PG8_WAIT_L(0); PG8_BAR; PG8_MMA(0, 0, At, B0); PG8_MMA(0, 1, At, B1); PG8_BAR; PG8_SCHED;
            PG8_LDA(At, 0, 1); PG8_STAGE(PG8_SB(0, 0), b2, voffB); PG8_STAGE(PG8_SB(0, 1), b2 + hB, voffB); PG8_STAGE(PG8_SA(0, 0), a2, voffA);
            PG8_WAIT_V(8); PG8_WAIT_L(0); PG8_BAR; PG8_MMA(1, 0, At, B0); PG8_MMA(1, 1, At, B1); PG8_BAR; PG8_SCHED;
            PG8_LDB(B0, 1, 0); PG8_LDB(B1, 1, 1); PG8_SCHED; PG8_LDA(At, 1, 0); PG8_STAGE(PG8_SA(0, 1), a2 + hA, voffA);
            PG8_WAIT_V(8); PG8_WAIT_L(0); PG8_BAR; PG8_MMA(0, 0, At, B0); PG8_MMA(0, 1, At, B1); PG8_BAR; PG8_SCHED;
            PG8_LDA(At, 1, 1); PG8_STAGE(PG8_SB(1, 0), b3, voffB); PG8_STAGE(PG8_SB(1, 1), b3 + hB, voffB); PG8_STAGE(PG8_SA(1, 0), a3, voffA);
            PG8_WAIT_V(8); PG8_WAIT_L(0); PG8_BAR; PG8_MMA(1, 0, At, B0); PG8_MMA(1, 1, At, B1); PG8_BAR; PG8_SCHED;
            } else {
            PG8_LDB(B0, 0, 0); PG8_SCHED; PG8_LDA(At, 0, 0); PG8_STAGE(PG8_SA(1, 1), a1 + hA, voffA);
            PG8_WAIT_L(8); PG8_BAR; PG8_WAIT_L(0); PG8_MMA(0, 0, At, B0); PG8_BAR; PG8_SCHED;
            PG8_LDB(B1, 0, 1); PG8_STAGE(PG8_SB(0, 0), b2, voffB);
            PG8_BAR; PG8_WAIT_L(0); PG8_MMA(0, 1, At, B1); PG8_BAR;
            PG8_LDA(At, 0, 1); PG8_STAGE(PG8_SA(0, 0), a2, voffA);
            PG8_BAR; PG8_WAIT_L(0); PG8_MMA(1, 0, At, B0); PG8_BAR; PG8_SCHED;
            PG8_STAGE(PG8_SB(0, 1), b2 + hB, voffB);
            PG8_WAIT_V(6); PG8_BAR; PG8_MMA(1, 1, At, B1); PG8_BAR;
            PG8_LDB(B0, 1, 0); PG8_SCHED; PG8_LDA(At, 1, 0); PG8_STAGE(PG8_SA(0, 1), a2 + hA, voffA);
            PG8_WAIT_L(8); PG8_BAR; PG8_WAIT_L(0); PG8_MMA(0, 0, At, B0); PG8_BAR; PG8_SCHED;
            PG8_LDB(B1, 1, 1); PG8_STAGE(PG8_SB(1, 0), b3, voffB);
            PG8_BAR; PG8_WAIT_L(0); PG8_MMA(0, 1, At, B1); PG8_BAR;
            PG8_LDA(At, 1, 1); PG8_STAGE(PG8_SA(1, 0), a3, voffA);
            PG8_BAR; PG8_WAIT_L(0); PG8_MMA(1, 0, At, B0); PG8_BAR; PG8_SCHED;
            PG8_STAGE(PG8_SB(1, 1), b3 + hB, voffB);
            PG8_WAIT_V(6); PG8_BAR; PG8_MMA(1, 1, At, B1); PG8_BAR;
            }
        }
        if constexpr (ALIGN_EPI) { if (wr == 0) PG8_BAR; }
        E(acc, cur, wr, wc, fr, fq, RS + (ui & 3) * 256);
        if (!has_next) break;
#pragma unroll
        for (int a = 0; a < 2; ++a)
#pragma unroll
            for (int b = 0; b < 2; ++b)
#pragma unroll
                for (int m = 0; m < 4; ++m)
#pragma unroll
                    for (int n = 0; n < 2; ++n) acc[a][b][m][n] = (f32x4){0.f, 0.f, 0.f, 0.f};
        cur = nxt; cA = nA; cB = nB; ++ui;
        if constexpr (ALIGN_EPI) { if (wr == 1) PG8_BAR; }
    }
    PG8_WAIT_V(0);
    if constexpr (!ALIGN_EPI) { if (wr == 0) PG8_BAR; }
    PG8_BAR;
#undef PG8_SA
#undef PG8_SB
#undef PG8_STAGE
#undef PG8_LDA
#undef PG8_LDB
#undef PG8_MMA
#undef PG8_WAIT_V
#undef PG8_WAIT_L
#undef PG8_BAR
#undef PG8_SCHED
}
}
constexpr int NWAVES = 8;
constexpr int DM = 1024, NBP = 8, SEQ = 2048, MP = NBP * SEQ, NBS = 128, DSEQ = 8, MS = NBS * DSEQ, MT = MP + MS;
constexpr int AH = 16, AP = 64, AG = 4, AN = 128, ACD = 2048, INC = 4112, FF = 4096, CWID = 31;
constexpr float EPS = 1e-6f;
constexpr size_t O_Y = 0, O_PAC = 17825792, O_PAS = 17874944, O_PBR = 18923520, O_PBI = 18956288, O_PCC = 18989056,
                 O_SAC = 19234816, O_SAS = 20021248, O_SBR = 36798464, O_SBI = 37322752, O_SCC = 37847040, O_END = 41779200;
constexpr size_t MiB = 1u << 20;
constexpr size_t WS_CTL = 0, CTL_ZERO_BYTES = 64 * 1024;
constexpr size_t WS_SS = 1 * MiB;
constexpr size_t WS_DT = 3 * MiB;
constexpr size_t WS_DA = 5 * MiB;
constexpr size_t WS_WDT = 7 * MiB;
constexpr size_t WS_W = 8 * MiB;
constexpr size_t WS_WIN = WS_W, WS_WGLU = WS_WIN + 8 * MiB, WS_WOUT = WS_WGLU + 2 * MiB, WS_WFF1 = WS_WOUT + 4 * MiB, WS_WFF2 = WS_WFF1 + 16 * MiB,
                 WS_WPW1 = WS_WFF2 + 16 * MiB, WS_WPW2 = WS_WPW1 + 4 * MiB, WS_WEND = WS_WPW2 + 2 * MiB;
constexpr size_t WS_CAT = 60 * MiB;
constexpr size_t WS_XBC = 128 * MiB;
constexpr size_t WS_U = 196 * MiB;
constexpr size_t WS_XB = WS_U;
constexpr size_t WS_H = 60 * MiB;
constexpr size_t WS_G = 60 * MiB;
constexpr size_t WS_CV = 94 * MiB;
constexpr size_t WS_END = 256 * MiB;
static_assert(WS_WEND == 60 * MiB, "weights end");
constexpr int CW_BAR = 4096;

constexpr int RING_OFF = 0, RING_BYTES = 131072;
constexpr int LDS_BYTES = 155648;
constexpr int LDSCTL_OFF = LDS_BYTES - 1024, MISC_OFF = LDSCTL_OFF + 320, PTRTAB_OFF = LDSCTL_OFF + 512;

#define GAS __attribute__((address_space(1)))
#define LAS __attribute__((address_space(3)))
typedef unsigned short bf16;
typedef unsigned v4u __attribute__((ext_vector_type(4)));
typedef unsigned v2u __attribute__((ext_vector_type(2)));
typedef float f32x4 __attribute__((ext_vector_type(4)));
typedef float f32x16 __attribute__((ext_vector_type(16)));
typedef short bf16x8 __attribute__((ext_vector_type(8)));
typedef GAS unsigned gu32;
#define RLX_AGENT __ATOMIC_RELAXED, __HIP_MEMORY_SCOPE_AGENT
#define LDS_WAIT() asm volatile("s_waitcnt lgkmcnt(0)" ::: "memory")
#define VM_WAIT() asm volatile("s_waitcnt vmcnt(0)" ::: "memory")
__device__ __forceinline__ unsigned f2bf(float f) { unsigned r; asm("v_cvt_pk_bf16_f32 %0, %1, %1" : "=v"(r) : "v"(f)); return r & 0xffffu; }
__device__ __forceinline__ unsigned pk2(float lo, float hi) { unsigned r; asm("v_cvt_pk_bf16_f32 %0, %1, %2" : "=v"(r) : "v"(lo), "v"(hi)); return r; }
__device__ __forceinline__ unsigned f2bf_int(float f) { const unsigned u = __builtin_bit_cast(unsigned, f); return (u + 0x7fffu + ((u >> 16) & 1u)) >> 16; }
__device__ __forceinline__ float bf2f(unsigned short b) { return __builtin_bit_cast(float, ((unsigned)b) << 16); }
__device__ __forceinline__ float bflo(unsigned w) { return __builtin_bit_cast(float, w << 16); }
__device__ __forceinline__ float bfhi(unsigned w) { return __builtin_bit_cast(float, w & 0xffff0000u); }
__device__ __forceinline__ float frcp_(float x) { return __builtin_amdgcn_rcpf(x); }
__device__ __forceinline__ float sigmoidf_(float x) { return frcp_(1.0f + __builtin_amdgcn_exp2f(-1.4426950408889634f * x)); }
__device__ __forceinline__ float siluf_(float x) { return x * frcp_(1.0f + __builtin_amdgcn_exp2f(-1.4426950408889634f * x)); }

#define XB_TMO      128
#define XB_XCNT(j)  (256  + 64 * (j))
#define XB_XSUB(j)  (1280 + 64 * (j))
#define XB_XGEN(j)  (2304 + 64 * (j))
#define XB_TOP      3328
#define XB_TOPGEN   3392
#define XCD_BAR_WORDS 3456
#define XB_SPIN_CAP (1u << 20)
__device__ __forceinline__ unsigned xb_ld(unsigned* p)              { return __hip_atomic_load(p, __ATOMIC_RELAXED, __HIP_MEMORY_SCOPE_AGENT); }
__device__ __forceinline__ unsigned xb_add(unsigned* p, unsigned v) { return __hip_atomic_fetch_add(p, v, __ATOMIC_RELAXED, __HIP_MEMORY_SCOPE_AGENT); }
__device__ __forceinline__ unsigned xb_xcc_id() { return (unsigned)__builtin_amdgcn_s_getreg((3 << 11) | 20) & 0xFu; }
#define XB_SPIN(cond, bar) do { unsigned _sp = 0; while (cond) { __builtin_amdgcn_s_sleep(1); \
    if ((++_sp & 255u) == 0u) { if (xb_ld(&(bar)[XB_TMO])) break; if (_sp > XB_SPIN_CAP) { atomicAdd(&(bar)[XB_TMO], 1u); break; } } } } while (0)
struct XcdBarrier { unsigned* bar; unsigned x; volatile LAS unsigned* st; };
__device__ __forceinline__ XcdBarrier xcd_barrier_post(unsigned* bar, volatile LAS unsigned* st) {
    XcdBarrier b; b.bar = bar; b.x = xb_xcc_id(); b.st = st;
    if (threadIdx.x == 0) (void)xb_add(&bar[XB_XCNT(b.x)], 1u);
    return b;
}
__device__ __forceinline__ void xcd_barrier_complete(unsigned* bar, unsigned x, unsigned& nloc, unsigned& nx) {
    const unsigned G = gridDim.x * gridDim.y * gridDim.z;
    unsigned sum, cnt, mine, sp = 0u;
    for (;;) {
        sum = 0u; cnt = 0u; mine = 0u;
#pragma unroll
        for (unsigned j = 0; j < 16; ++j) { const unsigned c = xb_ld(&bar[XB_XCNT(j)]); sum += c; cnt += (c > 0u) ? 1u : 0u; mine = (j == x) ? c : mine; }
        if (sum == G) break;
        __builtin_amdgcn_s_sleep(1);
        if ((++sp & 255u) == 0u) { if (xb_ld(&bar[XB_TMO])) break; if (sp > XB_SPIN_CAP) { atomicAdd(&bar[XB_TMO], 1u); break; } }
    }
    nloc = mine > 0u ? mine : 1u; nx = cnt > 0u ? cnt : 1u;
}
__device__ __forceinline__ void xcd_barrier(const XcdBarrier& b) {
    asm volatile("s_waitcnt vmcnt(0)" ::: "memory");
    __syncthreads();
    if (threadIdx.x == 0) {
        unsigned* bar = b.bar;
        __builtin_amdgcn_s_waitcnt(0);
        unsigned nloc = b.st[0], nx = b.st[1];
        if (nloc == 0u) { xcd_barrier_complete(bar, b.x, nloc, nx); b.st[0] = nloc; b.st[1] = nx; }
        const unsigned old = xb_add(&bar[XB_XSUB(b.x)], 1u);
        const unsigned gen = old / nloc;
        if (old + 1u == (gen + 1u) * nloc) {
            __builtin_amdgcn_fence(__ATOMIC_RELEASE, "agent");
            asm volatile("s_waitcnt vmcnt(0)" ::: "memory");
            const unsigned og = xb_add(&bar[XB_TOP], 1u);
            const unsigned tg = og / nx;
            if (og + 1u == (tg + 1u) * nx) xb_add(&bar[XB_TOPGEN], 1u);
            else XB_SPIN(xb_ld(&bar[XB_TOPGEN]) == tg, bar);
            __builtin_amdgcn_fence(__ATOMIC_ACQUIRE, "agent");
            xb_add(&bar[XB_XGEN(b.x)], 1u);
            asm volatile("s_waitcnt vmcnt(0)" ::: "memory");
        } else {
            XB_SPIN(xb_ld(&bar[XB_XGEN(b.x)]) == gen, bar);
            __builtin_amdgcn_fence(__ATOMIC_ACQUIRE, "agent");
            asm volatile("s_waitcnt vmcnt(0)" ::: "memory");
        }
    }
    __syncthreads();
}

typedef const float* cfp;
struct Frame {
    LAS unsigned char* lds;
    volatile LAS unsigned* MISC;
    gu32* ctl;
    int tid, lane, wave;
    int vcu, G;
    LAS cfp* in;
    float* out;
    unsigned char* ws;
    int nts;
    __device__ __forceinline__ const float* inp(int k) const { return (const float*)(const GAS float*)in[k]; }
};
#if defined(MK_DEBUGCNT)
#define DBG_COUNT(F, k) do { __hip_atomic_fetch_add((unsigned*)((F).ws + WS_CTL) + 2048 + (k), 1u, __ATOMIC_RELAXED, __HIP_MEMORY_SCOPE_AGENT); } while (0)
#else
#define DBG_COUNT(F, k) do {} while (0)
#endif
#if defined(MK_TIMING)
#define FSTAMP(F) do { if (blockIdx.x == 0 && (F).tid == 0 && (F).nts < 62) ((volatile LAS unsigned*)((F).lds + LDSCTL_OFF))[(F).nts] = (unsigned)__builtin_amdgcn_s_memrealtime(); ++(F).nts; } while (0)
#else
#define FSTAMP(F) do {} while (0)
#endif
template <int CTRL, int ROWMASK> __device__ __forceinline__ float dpp_get(float v) {
    return __builtin_bit_cast(float, __builtin_amdgcn_update_dpp(0, __builtin_bit_cast(int, v), CTRL, ROWMASK, 0xF, false));
}
__device__ __forceinline__ float dpp_sum8(float v) { v += dpp_get<0xB1, 0xF>(v); v += dpp_get<0x4E, 0xF>(v); v += dpp_get<0x141, 0xF>(v); return v; }
__device__ __forceinline__ float dpp_sum16(float v) { v = dpp_sum8(v); v += dpp_get<0x140, 0xF>(v); return v; }
__device__ __forceinline__ float dpp_sum32_hi(float v) { v = dpp_sum16(v); v += dpp_get<0x142, 0xA>(v); return v; }
__device__ __forceinline__ float wave_sum(float v) {
    v = dpp_sum32_hi(v); v += dpp_get<0x143, 0xC>(v);
    return __builtin_bit_cast(float, __builtin_amdgcn_readlane(__builtin_bit_cast(int, v), 63));
}
__device__ __forceinline__ float row16_reduce_scatter(const float (&d)[16], int lane) {
    const bool s3 = (lane & 8) != 0, s2 = (lane & 4) != 0, s1 = (lane & 2) != 0, s0 = (lane & 1) != 0;
    float a[8], b[4], c[2];
#pragma unroll
    for (int h = 0; h < 8; ++h) { const float keep = s3 ? d[h + 8] : d[h], give = s3 ? d[h] : d[h + 8]; a[h] = keep + dpp_get<0x140, 0xF>(give); }
#pragma unroll
    for (int h = 0; h < 4; ++h) { const float keep = s2 ? a[h + 4] : a[h], give = s2 ? a[h] : a[h + 4]; b[h] = keep + dpp_get<0x141, 0xF>(give); }
#pragma unroll
    for (int h = 0; h < 2; ++h) { const float keep = s1 ? b[h + 2] : b[h], give = s1 ? b[h] : b[h + 2]; c[h] = keep + dpp_get<0x4E, 0xF>(give); }
    const float keep = s0 ? c[1] : c[0], give = s0 ? c[0] : c[1];
    return keep + dpp_get<0xB1, 0xF>(give);
}
__device__ __forceinline__ float row_rstd(const float* SS, int r) {
    const f32x4* p = (const f32x4*)(SS + (size_t)r * 16);
    const f32x4 a = p[0], b = p[1], c = p[2], d = p[3];
    const float s = ((a.x + a.y) + (a.z + a.w)) + ((b.x + b.y) + (b.z + b.w)) + ((c.x + c.y) + (c.z + c.w)) + ((d.x + d.y) + (d.z + d.w));
    return __builtin_amdgcn_rsqf(s * (1.0f / DM) + EPS);
}
namespace pg8 {
struct EpiInProj {
    static constexpr bool PERM = true;
    bf16_t* CAT; bf16_t* XBC; bf16_t* U; const float* SS; float* out; bf16_t* HALO;
    __device__ __forceinline__ void operator()(const f32x4 (&acc)[2][2][4][2], const Unit& u, int wr, int wc, int fr, int fq, const PG8_LAS float* rs) const {
        const int row0 = u.pm * BM + wr * 64 + fr; const int colt = u.pn * BM;
        bf16_t* base; int ldc, c0; const bool isx = (colt >= 1024 && colt < 3072);
        if (colt < 1024) { base = CAT; ldc = 2048; c0 = colt; } else if (colt < 3072) { base = XBC; ldc = 2048; c0 = colt - 1024; } else { base = U; ldc = 1024; c0 = colt - 3072; }
        const int col0 = c0 + wc * 64 + 8 * fq;
#pragma unroll
        for (int ai = 0; ai < 2; ++ai)
#pragma unroll
            for (int m = 0; m < 4; ++m) {
                const int r = row0 + ai * HALF + m * 16; const float rsv = rs[wr * 64 + ai * HALF + m * 16 + fr];
                bf16_t* rowp = base + (size_t)r * ldc + col0;
                float* st = nullptr; bf16_t* hl = nullptr;
                if (isx) { if (r < MP) { const int t = r & 2047; if (t >= 2045) st = out + O_PAC + ((size_t)(r >> 11) * 3 + (t - 2045)) * 2048;
                                         if ((t & 63) >= 61) hl = HALO + ((size_t)((r >> 11) * 32 + (t >> 6)) * 3 + ((t & 63) - 61)) * 2048; }
                           else { const int rr = r - MP, t = rr & 7; if (t >= 5) st = out + O_SAC + ((size_t)(rr >> 3) * 3 + (t - 5)) * 2048; } }
#pragma unroll
                for (int bj = 0; bj < 2; ++bj) { const f32x4 v0 = acc[ai][bj][m][0] * rsv, v1 = acc[ai][bj][m][1] * rsv;
                    u32x4 w; w.x = cvt_pk_bf16(v0[0], v0[1]); w.y = cvt_pk_bf16(v0[2], v0[3]); w.z = cvt_pk_bf16(v1[0], v1[1]); w.w = cvt_pk_bf16(v1[2], v1[3]);
                    if (colt < 1024) __builtin_nontemporal_store(w, (u32x4*)(rowp + bj * 32));
                    else *(u32x4*)(rowp + bj * 32) = w;
                    if (hl) *(u32x4*)(hl + col0 + bj * 32) = w;
                    if (st) { __builtin_nontemporal_store(v0, (f32x4*)(st + col0 + bj * 32)); __builtin_nontemporal_store(v1, (f32x4*)(st + col0 + bj * 32 + 4)); } } }
    }
    __device__ __forceinline__ void tail_cols(int cb, int& w0, int& w1) const { w0 = 64 * cb; w1 = w0 + 32; }
    __device__ __forceinline__ void tail(const f32x4& a0, const f32x4& a1, int row, int cb, int coff, int wm, int wn, int fr, int fq, PG8_LAS unsigned char* red) const {
        const float rs = row_rstd(SS, row); const int rr = row - MP, t = rr & 7;
#pragma unroll
        for (int sg = 0; sg < 2; ++sg) { const int col = 64 * cb + 32 * sg + coff; const f32x4 v = (sg ? a1 : a0) * rs;
            u32x2 w; w.x = cvt_pk_bf16(v[0], v[1]); w.y = cvt_pk_bf16(v[2], v[3]);
            if (col < 1024) *(u32x2*)(CAT + (size_t)row * 2048 + col) = w;
            else if (col < 3072) { *(u32x2*)(XBC + (size_t)row * 2048 + (col - 1024)) = w; if (t >= 5) *(f32x4*)(out + O_SAC + ((size_t)(rr >> 3) * 3 + (t - 5)) * 2048 + (col - 1024)) = v; }
            else *(u32x2*)(U + (size_t)row * 1024 + (col - 3072)) = w; }
    }
};
struct EpiGlu {
    static constexpr bool PERM = true;
    const bf16_t* YS; bf16_t* CAT; const float* bias;
    __device__ __forceinline__ void operator()(const f32x4 (&acc)[2][2][4][2], const Unit& u, int wr, int wc, int fr, int fq, const PG8_LAS float* rs) const {
        const int row0 = u.pm * BM + wr * 64 + fr; const int col0 = u.pn * BM + wc * 64 + 8 * fq;
        f32x4 bv[2][2];
#pragma unroll
        for (int bj = 0; bj < 2; ++bj)
#pragma unroll
            for (int n = 0; n < 2; ++n) bv[bj][n] = *(const f32x4*)(bias + col0 + bj * 32 + 4 * n);
#pragma unroll
        for (int ai = 0; ai < 2; ++ai)
#pragma unroll
            for (int m = 0; m < 4; ++m) { const int r = row0 + ai * HALF + m * 16;
#pragma unroll
                for (int bj = 0; bj < 2; ++bj) { const u32x4 yw = *(const u32x4*)(YS + (size_t)r * 1024 + col0 + bj * 32);
                    const f32x4 g0 = acc[ai][bj][m][0] + bv[bj][0], g1 = acc[ai][bj][m][1] + bv[bj][1];
                    float o[8]; o[0] = bflo(yw.x) * sigmoidf_(g0[0]); o[1] = bfhi(yw.x) * sigmoidf_(g0[1]); o[2] = bflo(yw.y) * sigmoidf_(g0[2]); o[3] = bfhi(yw.y) * sigmoidf_(g0[3]);
                    o[4] = bflo(yw.z) * sigmoidf_(g1[0]); o[5] = bfhi(yw.z) * sigmoidf_(g1[1]); o[6] = bflo(yw.w) * sigmoidf_(g1[2]); o[7] = bfhi(yw.w) * sigmoidf_(g1[3]);
                    u32x4 w; w.x = cvt_pk_bf16(o[0], o[1]); w.y = cvt_pk_bf16(o[2], o[3]); w.z = cvt_pk_bf16(o[4], o[5]); w.w = cvt_pk_bf16(o[6], o[7]);
                    *(u32x4*)(CAT + (size_t)r * 2048 + 1024 + col0 + bj * 32) = w; }
                asm volatile("" ::: "memory"); }
    }
    __device__ __forceinline__ void tail_cols(int cb, int& w0, int& w1) const { w0 = 64 * cb; w1 = w0 + 32; }
    __device__ __forceinline__ void tail(const f32x4& a0, const f32x4& a1, int row, int cb, int coff, int wm, int wn, int fr, int fq, PG8_LAS unsigned char* red) const {
#pragma unroll
        for (int sg = 0; sg < 2; ++sg) { const int col = 64 * cb + 32 * sg + coff; const f32x4 g = (sg ? a1 : a0) + *(const f32x4*)(bias + col);
            const u32x2 yw = *(const u32x2*)(YS + (size_t)row * 1024 + col);
            u32x2 w; w.x = cvt_pk_bf16(bflo(yw.x) * sigmoidf_(g[0]), bfhi(yw.x) * sigmoidf_(g[1])); w.y = cvt_pk_bf16(bflo(yw.y) * sigmoidf_(g[2]), bfhi(yw.y) * sigmoidf_(g[3]));
            *(u32x2*)(CAT + (size_t)row * 2048 + 1024 + col) = w; }
    }
};
struct EpiRes {
    static constexpr bool PERM = true;
    const float* resP; const float* resS; const bf16_t* RB; float* X; bf16_t* XB; float* SS; const float* bias;
    __device__ __forceinline__ void operator()(const f32x4 (&acc)[2][2][4][2], const Unit& u, int wr, int wc, int fr, int fq, const PG8_LAS float* rs) const {
        const int row0 = u.pm * BM + wr * 64 + fr; const int col0 = u.pn * BM + wc * 64 + 8 * fq;
        f32x4 bv[2][2];
#pragma unroll
        for (int bj = 0; bj < 2; ++bj)
#pragma unroll
            for (int n = 0; n < 2; ++n) bv[bj][n] = bias ? *(const f32x4*)(bias + col0 + bj * 32 + 4 * n) : (f32x4){0.f, 0.f, 0.f, 0.f};
#pragma unroll
        for (int ai = 0; ai < 2; ++ai)
#pragma unroll
            for (int m = 0; m < 4; ++m) { const int r = row0 + ai * HALF + m * 16;
                float ssq = 0.f;
#pragma unroll
                for (int bj = 0; bj < 2; ++bj) { const int c = col0 + bj * 32;
                    f32x4 x0, x1;
                    if (RB) { const u32x4 rw = *(const u32x4*)(RB + (size_t)r * 1024 + c); x0 = (f32x4){bflo(rw.x), bfhi(rw.x), bflo(rw.y), bfhi(rw.y)}; x1 = (f32x4){bflo(rw.z), bfhi(rw.z), bflo(rw.w), bfhi(rw.w)}; }
                    else { const float* rp = resP + (size_t)r * 1024; x0 = __builtin_nontemporal_load((const f32x4*)(rp + c)); x1 = __builtin_nontemporal_load((const f32x4*)(rp + c + 4)); }
                    x0 = x0 + acc[ai][bj][m][0] + bv[bj][0]; x1 = x1 + acc[ai][bj][m][1] + bv[bj][1];
                    if (X) { *(f32x4*)(X + (size_t)r * 1024 + c) = x0; *(f32x4*)(X + (size_t)r * 1024 + c + 4) = x1; }
                    if (XB) { u32x4 w; w.x = cvt_pk_bf16(x0[0], x0[1]); w.y = cvt_pk_bf16(x0[2], x0[3]); w.z = cvt_pk_bf16(x1[0], x1[1]); w.w = cvt_pk_bf16(x1[2], x1[3]); *(u32x4*)(XB + (size_t)r * 1024 + c) = w; }
                    ssq += (x0[0] * x0[0] + x0[1] * x0[1]) + (x0[2] * x0[2] + x0[3] * x0[3]) + (x1[0] * x1[0] + x1[1] * x1[1]) + (x1[2] * x1[2] + x1[3] * x1[3]); }
                ssq += __shfl_xor(ssq, 16); ssq += __shfl_xor(ssq, 32);
                if (fq == 0) SS[(size_t)r * 16 + u.pn * 4 + wc] = ssq;
                asm volatile("" ::: "memory"); }
    }
    __device__ __forceinline__ void tail_cols(int cb, int& w0, int& w1) const { w0 = 64 * cb; w1 = w0 + 32; }
    __device__ __forceinline__ void tail(const f32x4& a0, const f32x4& a1, int row, int cb, int coff, int wm, int wn, int fr, int fq, PG8_LAS unsigned char* red) const {
        float ssq = 0.f;
#pragma unroll
        for (int sg = 0; sg < 2; ++sg) { const int col = 64 * cb + 32 * sg + coff;
            f32x4 x;
            if (RB) { const u32x2 rw = *(const u32x2*)(RB + (size_t)row * 1024 + col); x = (f32x4){bflo(rw.x), bfhi(rw.x), bflo(rw.y), bfhi(rw.y)}; }
            else x = __builtin_nontemporal_load((const f32x4*)(resS + (size_t)(row - MP) * 1024 + col));
            x = x + (sg ? a1 : a0); if (bias) x = x + *(const f32x4*)(bias + col);
            if (X) *(f32x4*)(X + (size_t)row * 1024 + col) = x;
            if (XB) { u32x2 w; w.x = cvt_pk_bf16(x[0], x[1]); w.y = cvt_pk_bf16(x[2], x[3]); *(u32x2*)(XB + (size_t)row * 1024 + col) = w; }
            ssq += (x[0] * x[0] + x[1] * x[1]) + (x[2] * x[2] + x[3] * x[3]); }
        ssq += __shfl_xor(ssq, 16); ssq += __shfl_xor(ssq, 32);
        PG8_LAS float* rd = (PG8_LAS float*)red;
        if (fq == 0) rd[wn * 64 + 16 * wm + fr] = ssq;
        asm volatile("s_waitcnt lgkmcnt(0)" ::: "memory"); __builtin_amdgcn_s_barrier(); asm volatile("" ::: "memory");
        if (wn == 0 && fq == 0) SS[(size_t)row * 16 + cb] = rd[16 * wm + fr] + rd[64 + 16 * wm + fr];
    }
};
struct EpiFF1 {
    static constexpr bool PERM = true;
    bf16_t* H; const float* SS;
    __device__ __forceinline__ void operator()(const f32x4 (&acc)[2][2][4][2], const Unit& u, int wr, int wc, int fr, int fq, const PG8_LAS float* rs) const {
        const int row0 = u.pm * BM + wr * 64 + fr; const int col0 = u.pn * BM + wc * 64 + 8 * fq;
#pragma unroll
        for (int ai = 0; ai < 2; ++ai)
#pragma unroll
            for (int m = 0; m < 4; ++m) { const int r = row0 + ai * HALF + m * 16; const float rsv = rs[wr * 64 + ai * HALF + m * 16 + fr];
#pragma unroll
                for (int bj = 0; bj < 2; ++bj) { f32x4 v0 = acc[ai][bj][m][0] * rsv, v1 = acc[ai][bj][m][1] * rsv;
#pragma unroll
                    for (int j = 0; j < 4; ++j) { const float a = fmaxf(v0[j], 0.f), b = fmaxf(v1[j], 0.f); v0[j] = a * a; v1[j] = b * b; }
                    u32x4 w; w.x = cvt_pk_bf16(v0[0], v0[1]); w.y = cvt_pk_bf16(v0[2], v0[3]); w.z = cvt_pk_bf16(v1[0], v1[1]); w.w = cvt_pk_bf16(v1[2], v1[3]);
                    *(u32x4*)(H + (size_t)r * FF + col0 + bj * 32) = w; } }
    }
    __device__ __forceinline__ void tail_cols(int cb, int& w0, int& w1) const { w0 = 64 * cb; w1 = w0 + 32; }
    __device__ __forceinline__ void tail(const f32x4& a0, const f32x4& a1, int row, int cb, int coff, int wm, int wn, int fr, int fq, PG8_LAS unsigned char* red) const {
        const float rs = row_rstd(SS, row);
#pragma unroll
        for (int sg = 0; sg < 2; ++sg) { const int col = 64 * cb + 32 * sg + coff; f32x4 v = (sg ? a1 : a0) * rs;
#pragma unroll
            for (int j = 0; j < 4; ++j) { const float a = fmaxf(v[j], 0.f); v[j] = a * a; }
            u32x2 w; w.x = cvt_pk_bf16(v[0], v[1]); w.y = cvt_pk_bf16(v[2], v[3]);
            *(u32x2*)(H + (size_t)row * FF + col) = w; }
    }
};
struct EpiPw1 {
    static constexpr bool PERM = true;
    bf16_t* G; const float* SS; const float* bias; float* out;
    __device__ __forceinline__ void operator()(const f32x4 (&acc)[2][2][4][2], const Unit& u, int wr, int wc, int fr, int fq, const PG8_LAS float* rs) const {
        const int row0 = u.pm * BM + wr * 64 + fr; const int col0 = u.pn * HALF + wc * 32 + 8 * fq;
        f32x4 bv[2][2];
#pragma unroll
        for (int bj = 0; bj < 2; ++bj)
#pragma unroll
            for (int n = 0; n < 2; ++n) bv[bj][n] = *(const f32x4*)(bias + bj * 1024 + col0 + 4 * n);
#pragma unroll
        for (int ai = 0; ai < 2; ++ai)
#pragma unroll
            for (int m = 0; m < 4; ++m) { const int r = row0 + ai * HALF + m * 16; const float rsv = rs[wr * 64 + ai * HALF + m * 16 + fr];
                f32x4 o0, o1;
#pragma unroll
                for (int j = 0; j < 4; ++j) { o0[j] = (acc[ai][0][m][0][j] * rsv + bv[0][0][j]) * sigmoidf_(acc[ai][1][m][0][j] * rsv + bv[1][0][j]);
                                              o1[j] = (acc[ai][0][m][1][j] * rsv + bv[0][1][j]) * sigmoidf_(acc[ai][1][m][1][j] * rsv + bv[1][1][j]); }
                u32x4 w; w.x = cvt_pk_bf16(o0[0], o0[1]); w.y = cvt_pk_bf16(o0[2], o0[3]); w.z = cvt_pk_bf16(o1[0], o1[1]); w.w = cvt_pk_bf16(o1[2], o1[3]);
                *(u32x4*)(G + (size_t)r * 1024 + col0) = w;
                float* st = nullptr;
                if (r < MP) { const int t = r & 2047; if (t >= 2018) st = out + O_PCC + ((size_t)(r >> 11) * 30 + (t - 2018)) * 1024; }
                else { const int rr = r - MP; st = out + O_SCC + ((size_t)(rr >> 3) * 30 + 22 + (rr & 7)) * 1024; }
                if (st) { __builtin_nontemporal_store(o0, (f32x4*)(st + col0)); __builtin_nontemporal_store(o1, (f32x4*)(st + col0 + 4)); } }
    }
    __device__ __forceinline__ void tail_cols(int cb, int& w0, int& w1) const { w0 = 256 * (cb >> 2) + 64 * (cb & 3); w1 = w0 + 32; }
    __device__ __forceinline__ void tail(const f32x4& a0, const f32x4& a1, int row, int cb, int coff, int wm, int wn, int fr, int fq, PG8_LAS unsigned char* red) const {
        const float rs = row_rstd(SS, row); const int oc = 32 * cb + coff, rr = row - MP;
        const f32x4 bv = *(const f32x4*)(bias + oc), bg = *(const f32x4*)(bias + 1024 + oc);
        f32x4 o;
#pragma unroll
        for (int j = 0; j < 4; ++j) o[j] = (a0[j] * rs + bv[j]) * sigmoidf_(a1[j] * rs + bg[j]);
        u32x2 w; w.x = cvt_pk_bf16(o[0], o[1]); w.y = cvt_pk_bf16(o[2], o[3]);
        *(u32x2*)(G + (size_t)row * 1024 + oc) = w;
        *(f32x4*)(out + O_SCC + ((size_t)(rr >> 3) * 30 + 22 + (rr & 7)) * 1024 + oc) = o;
    }
};
}
namespace pg8 {
constexpr int TL_STAGE = 32768, TL_RED = 3 * TL_STAGE;
template <class Epi>
__device__ __forceinline__ void gemm_tail(PG8_LAS unsigned char* lds, const bf16_t* A  , int lda, const bf16_t* Bt, int K, int ntiles_n  , const Epi& E, int bx, int G, int i_begin, int i_end) {
    const int tid = threadIdx.x, wid = __builtin_amdgcn_readfirstlane(tid >> 6), lane = tid & 63, wm = wid >> 1, wn = wid & 1, fr = lane & 15, fq = lane >> 4;
    const int nk = K / 128, ntiles = 16 * ntiles_n;
    const int lrow = lane >> 4, lch = lane & 15;
    for (int ii = i_begin; ii < i_end; ++ii) { const int ti = bx + G * ii; if (ti >= ntiles) break;
        const int rb = ti & 15, cb = ti >> 4;
        int wrow0, wrow1; E.tail_cols(cb, wrow0, wrow1);
        const char* srcA[2]; const char* srcB[2];
#pragma unroll
        for (int i = 0; i < 2; ++i) {
            const int r = 8 * wid + 4 * i + lrow;
            srcA[i] = (const char*)(A + (size_t)(rb * 64 + r) * lda) + ((lch ^ (r & 15)) << 4);
            const int wr_ = (r < 32) ? (wrow0 + r) : (wrow1 + r - 32);
            srcB[i] = (const char*)(Bt + (size_t)wr_ * K) + ((lch ^ (r & 15)) << 4);
        }
#define TL_ISSUE(kt, st) do { _Pragma("unroll") for (int _i = 0; _i < 2; ++_i) { \
            __builtin_amdgcn_global_load_lds((const unsigned*)(srcA[_i] + (size_t)(kt) * 256), (PG8_LAS unsigned*)(lds + (st) * TL_STAGE + (8 * wid + 4 * _i) * 256), 16, 0, 0); \
            __builtin_amdgcn_global_load_lds((const unsigned*)(srcB[_i] + (size_t)(kt) * 256), (PG8_LAS unsigned*)(lds + (st) * TL_STAGE + 16384 + (8 * wid + 4 * _i) * 256), 16, 0, 0); } } while (0)
        f32x4 acc[2] = {(f32x4){0.f, 0.f, 0.f, 0.f}, (f32x4){0.f, 0.f, 0.f, 0.f}};
        TL_ISSUE(0, 0); TL_ISSUE(1, 1);
        for (int kt = 0; kt < nk; ++kt) {
            const int st = kt % 3;
            if (kt + 1 < nk) asm volatile("s_waitcnt vmcnt(4)" ::: "memory"); else asm volatile("s_waitcnt vmcnt(0)" ::: "memory");
            asm volatile("s_waitcnt lgkmcnt(0)" ::: "memory"); __builtin_amdgcn_s_barrier(); asm volatile("" ::: "memory");
            if (kt + 2 < nk) TL_ISSUE(kt + 2, (kt + 2) % 3);
            const PG8_LAS unsigned char* sa = lds + st * TL_STAGE + (16 * wm + fr) * 256;
            const PG8_LAS unsigned char* sb0 = lds + st * TL_STAGE + 16384 + (16 * wn + fr) * 256;
            const PG8_LAS unsigned char* sb1 = sb0 + 32 * 256;
#pragma unroll
            for (int ks = 0; ks < 4; ++ks) {
                const int co = ((4 * ks + fq) ^ fr) << 4;
                const bf16x8 a = *(const PG8_LAS bf16x8*)(sa + co), b0 = *(const PG8_LAS bf16x8*)(sb0 + co), b1 = *(const PG8_LAS bf16x8*)(sb1 + co);
                acc[0] = __builtin_amdgcn_mfma_f32_16x16x32_bf16(b0, a, acc[0], 0, 0, 0);
                acc[1] = __builtin_amdgcn_mfma_f32_16x16x32_bf16(b1, a, acc[1], 0, 0, 0);
            }
        }
#undef TL_ISSUE
        E.tail(acc[0], acc[1], MP + rb * 64 + 16 * wm + fr, cb, 16 * wn + 4 * fq, wm, wn, fr, fq, lds + TL_RED);
        asm volatile("s_waitcnt lgkmcnt(0)" ::: "memory"); __builtin_amdgcn_s_barrier(); asm volatile("" ::: "memory");
    }
}
template <int NCB, class Epi>
__device__ __forceinline__ void gemm_tail_wide(PG8_LAS unsigned char* lds, const bf16_t* A  , int lda, const bf16_t* Bt, int K, const Epi& E, int bx, int G) {
    static_assert(NCB == 2 || NCB == 4, "NCB");
    constexpr int STAGE = 8192 * (1 + NCB), CJ = (NCB == 4) ? 4 : 2;
    const int tid = threadIdx.x, wid = __builtin_amdgcn_readfirstlane(tid >> 6), lane = tid & 63, wm2 = wid >> 2, wn4 = wid & 3, fr = lane & 15, fq = lane >> 4;
    const int nk = K / 64;
    const int lrow = lane >> 3, lch = lane & 7;
    for (int s = bx; s < 256; s += G) {
        const int rb = s & 15, cb0 = s >> 4;
        const char* srcA = (const char*)(A + (size_t)(rb * 64 + 8 * wid + lrow) * lda) + ((lch ^ lrow) << 4);
        const char* srcB[NCB];
#pragma unroll
        for (int i = 0; i < NCB; ++i) { int w0, w1; E.tail_cols(cb0 + 16 * i, w0, w1);
            const int wr_ = ((wid >> 2) ? w1 : w0) + ((8 * wid + lrow) & 31);
            srcB[i] = (const char*)(Bt + (size_t)wr_ * K) + ((lch ^ lrow) << 4); }
#define TW_ISSUE(kt, st) do { \
            __builtin_amdgcn_global_load_lds((const unsigned*)(srcA + (size_t)(kt) * 128), (PG8_LAS unsigned*)(lds + (st) * STAGE + (8 * wid) * 128), 16, 0, 0); \
            _Pragma("unroll") for (int _i = 0; _i < NCB; ++_i) \
                __builtin_amdgcn_global_load_lds((const unsigned*)(srcB[_i] + (size_t)(kt) * 128), (PG8_LAS unsigned*)(lds + (st) * STAGE + 8192 + (64 * _i + 8 * wid) * 128), 16, 0, 0); } while (0)
        f32x4 acc[2][CJ];
#pragma unroll
        for (int ri = 0; ri < 2; ++ri)
#pragma unroll
            for (int j = 0; j < CJ; ++j) acc[ri][j] = (f32x4){0.f, 0.f, 0.f, 0.f};
        const int brow0 = (NCB == 4) ? 64 * wn4 : (64 * (wn4 >> 1) + 16 * (wn4 & 1));
        TW_ISSUE(0, 0); TW_ISSUE(1, 1);
        for (int kt = 0; kt < nk; ++kt) {
            const int st = kt % 3;
            if (kt + 1 < nk) { if (NCB == 4) asm volatile("s_waitcnt vmcnt(5)" ::: "memory"); else asm volatile("s_waitcnt vmcnt(3)" ::: "memory"); }
            else asm volatile("s_waitcnt vmcnt(0)" ::: "memory");
            asm volatile("s_waitcnt lgkmcnt(0)" ::: "memory"); __builtin_amdgcn_s_barrier(); asm volatile("" ::: "memory");
            if (kt + 2 < nk) TW_ISSUE(kt + 2, (kt + 2) % 3);
            const PG8_LAS unsigned char* sa = lds + st * STAGE + (32 * wm2 + fr) * 128;
            const PG8_LAS unsigned char* sb = lds + st * STAGE + 8192 + (brow0 + fr) * 128;
#pragma unroll
            for (int ks = 0; ks < 2; ++ks) {
                const int co = ((4 * ks + fq) ^ (fr & 7)) << 4;
                const bf16x8 a0 = *(const PG8_LAS bf16x8*)(sa + co), a1 = *(const PG8_LAS bf16x8*)(sa + 16 * 128 + co);
#pragma unroll
                for (int j = 0; j < CJ; ++j) {
                    const bf16x8 b = *(const PG8_LAS bf16x8*)(sb + ((NCB == 4) ? 16 : 32) * j * 128 + co);
                    acc[0][j] = __builtin_amdgcn_mfma_f32_16x16x32_bf16(b, a0, acc[0][j], 0, 0, 0);
                    acc[1][j] = __builtin_amdgcn_mfma_f32_16x16x32_bf16(b, a1, acc[1][j], 0, 0, 0);
                }
            }
        }
#undef TW_ISSUE
#pragma unroll
        for (int ri = 0; ri < 2; ++ri) {
            const int row = MP + rb * 64 + 32 * wm2 + 16 * ri + fr;
            if (NCB == 4) {
#pragma unroll
                for (int wn = 0; wn < 2; ++wn) E.tail(acc[ri][wn], acc[ri][2 + wn], row, cb0 + 16 * wn4, 16 * wn + 4 * fq, 2 * wm2 + ri, wn, fr, fq, nullptr);
            } else {
                const int wn = wn4 & 1;
                E.tail(acc[ri][0], acc[ri][1], row, cb0 + 16 * (wn4 >> 1), 16 * wn + 4 * fq, 2 * wm2 + ri, wn, fr, fq, nullptr);
            }
        }
        asm volatile("s_waitcnt lgkmcnt(0)" ::: "memory"); __builtin_amdgcn_s_barrier(); asm volatile("" ::: "memory");
    }
}
}
__device__ __forceinline__ void p0_transpose_item(const float* W, int ldw, int K, bf16* WT, int dst_row0, const float* kscale, LAS float* scr, int k0, int n0, int lane) {
    float tv[32];
#pragma unroll
    for (int i = 0; i < 32; ++i) { const int kk = 2 * i + (lane >> 5); tv[i] = W[(size_t)(k0 + kk) * ldw + n0 + (lane & 31)]; }
    if (kscale) {
#pragma unroll
        for (int i = 0; i < 32; ++i) tv[i] *= kscale[k0 + 2 * i + (lane >> 5)];
    }
#pragma unroll
    for (int i = 0; i < 32; ++i) { const int kk = 2 * i + (lane >> 5); scr[kk * 33 + (lane & 31)] = tv[i]; }
    LDS_WAIT(); asm volatile("" ::: "memory");
    const int c = lane & 7;
#pragma unroll
    for (int j = 0; j < 4; ++j) { const int n = (lane >> 3) + 8 * j; const LAS float* s = scr + (8 * c) * 33 + n;
        v4u o; o.x = pk2(s[0 * 33], s[1 * 33]); o.y = pk2(s[2 * 33], s[3 * 33]); o.z = pk2(s[4 * 33], s[5 * 33]); o.w = pk2(s[6 * 33], s[7 * 33]);
        *(GAS v4u*)(WT + (size_t)(dst_row0 + n) * K + k0 + 8 * c) = o; }
    LDS_WAIT(); asm volatile("" ::: "memory");
}
__device__ __forceinline__ void p0_mat(const float* W, int ldw, int K, int ncols, bf16* WT, int row_off, const float* kscale, LAS float* scr, int item, int lane, int glu_map) {
    const int nblk = ncols / 32, kb = item / nblk, nb = item % nblk, n0 = 32 * nb;
    int dst = row_off + n0;
    if (glu_map) dst = (n0 < 1024) ? (256 * (n0 >> 7) + 64 * ((n0 & 127) >> 5)) : (256 * ((n0 - 1024) >> 7) + 64 * (((n0 - 1024) & 127) >> 5) + 32);
    p0_transpose_item(W, ldw, K, WT, dst, kscale, scr, 64 * kb, n0, lane);
}
constexpr int P0_SCR_STRIDE = 8704;
constexpr int P0_WD_OFF = NWAVES * P0_SCR_STRIDE;
constexpr int P0_WD_LD = 1028, P0_WDB_PITCH = 2064;
static_assert(P0_WD_OFF + 16 * P0_WD_LD * 4 <= LDSCTL_OFF, "P0 LDS");

constexpr int P0_WIN_ITEMS = 16 * 96 + 16 * 32, P0_GO_ITEMS = P0_WIN_ITEMS + 16 * 32 + 32 * 32  , P0_FF10_ITEMS = P0_GO_ITEMS + 16 * 128  , P0_L0_ITEMS = P0_WIN_ITEMS + 16 * 32 + 32 * 32 + 16 * 128 + 64 * 32  , P0_PW1_ITEMS = P0_L0_ITEMS + 16 * 64  , P0_ALL_ITEMS = 16 * 96 + 16 * 32 + 16 * 32 + 32 * 32 + 2 * 16 * 128 + 2 * 64 * 32 + 16 * 64 + 16 * 32;
__device__ __forceinline__ void p0_weights(Frame& F, int lo, int hi, int gw_ = -1  , int NGW_ = 0) {
    LAS float* scr = (LAS float*)(F.lds + F.wave * P0_SCR_STRIDE);
    const int gw = gw_ >= 0 ? gw_ : F.vcu * NWAVES + F.wave, NGW = gw_ >= 0 ? NGW_ : F.G * NWAVES;
    const float* w_in = F.inp(10); const float* nmix = F.inp(7); const float* nff = F.inp(8);
    bf16* Win = (bf16*)(F.ws + WS_WIN); bf16* Wglu = (bf16*)(F.ws + WS_WGLU); bf16* Wout = (bf16*)(F.ws + WS_WOUT);
    bf16* Wff1 = (bf16*)(F.ws + WS_WFF1); bf16* Wff2 = (bf16*)(F.ws + WS_WFF2); bf16* Wpw1 = (bf16*)(F.ws + WS_WPW1); bf16* Wpw2 = (bf16*)(F.ws + WS_WPW2);
    constexpr int I1 = 16 * 96, I2 = 16 * 32, I3 = 16 * 32, I4 = 32 * 32, I5 = 16 * 128, I6 = 64 * 32, I7 = 16 * 64, I8 = 16 * 32;
    constexpr int NITEMS = I1 + I2 + I3 + I4 + 2 * I5 + 2 * I6 + I7 + I8;
#define P0_DECODE(it_, src_, ldw_, dst_, K_, ks_) do { \
        const float* W_; int ncols_, roff_ = 0, glu_ = 0; bf16* WT_; const float* ksc_ = nullptr; int r_ = (it_); \
        if (r_ < I1) { W_ = w_in; ldw_ = INC; K_ = 1024; ncols_ = 3072; WT_ = Win; ksc_ = nmix; } \
        else if ((r_ -= I1) < I2) { W_ = w_in + 3088; ldw_ = INC; K_ = 1024; ncols_ = 1024; WT_ = Win; roff_ = 3072; ksc_ = nmix; } \
        else if ((r_ -= I2) < I3) { W_ = F.inp(25); ldw_ = 1024; K_ = 1024; ncols_ = 1024; WT_ = Wglu; } \
        else if ((r_ -= I3) < I4) { W_ = F.inp(27); ldw_ = 1024; K_ = 2048; ncols_ = 1024; WT_ = Wout; } \
        else if ((r_ -= I4) < I5) { W_ = F.inp(36); ldw_ = 4096; K_ = 1024; ncols_ = 4096; WT_ = Wff1; ksc_ = nff; } \
        else if ((r_ -= I5) < I6) { W_ = F.inp(37); ldw_ = 1024; K_ = 4096; ncols_ = 1024; WT_ = Wff2; } \
        else if ((r_ -= I6) < I7) { W_ = F.inp(28); ldw_ = 2048; K_ = 1024; ncols_ = 2048; WT_ = Wpw1; ksc_ = nmix + 1024; glu_ = 1; } \
        else if ((r_ -= I7) < I5) { W_ = F.inp(36) + (size_t)1024 * 4096; ldw_ = 4096; K_ = 1024; ncols_ = 4096; WT_ = Wff1 + (size_t)4096 * 1024; ksc_ = nff + 1024; } \
        else if ((r_ -= I5) < I6) { W_ = F.inp(37) + (size_t)4096 * 1024; ldw_ = 1024; K_ = 4096; ncols_ = 1024; WT_ = Wff2 + (size_t)1024 * 4096; } \
        else { r_ -= I6; W_ = F.inp(34); ldw_ = 1024; K_ = 1024; ncols_ = 1024; WT_ = Wpw2; } \
        const int nblk_ = ncols_ >> 5, kb_ = r_ / nblk_, n0_ = 32 * (r_ - kb_ * nblk_); \
        int drow_ = roff_ + n0_; \
        if (glu_) drow_ = (n0_ < 1024) ? (256 * (n0_ >> 7) + 64 * ((n0_ & 127) >> 5)) : (256 * ((n0_ - 1024) >> 7) + 64 * (((n0_ - 1024) & 127) >> 5) + 32); \
        src_ = W_ + (size_t)(64 * kb_ + (F.lane >> 5)) * ldw_ + n0_ + (F.lane & 31); \
        dst_ = WT_ + (size_t)drow_ * K_ + 64 * kb_; ks_ = ksc_ ? ksc_ + 64 * kb_ : nullptr; } while (0)
    {
        float tv[32];
        const float* src; int ldw = 0, K = 0; bf16* dst; const float* ks;
        if (lo + gw < hi) { P0_DECODE(lo + gw, src, ldw, dst, K, ks);
#pragma unroll
            for (int i = 0; i < 32; ++i) tv[i] = __builtin_nontemporal_load(&src[(size_t)(2 * i) * ldw]); }
        for (int it = lo + gw; it < hi; it += NGW) {
            float nv_[32]; const float* nsrc; int nldw = 0, nK = 0; bf16* ndst = nullptr; const float* nks = nullptr;
            const bool more = it + NGW < hi;
            if (more) { P0_DECODE(it + NGW, nsrc, nldw, ndst, nK, nks);
#pragma unroll
                for (int i = 0; i < 32; ++i) nv_[i] = __builtin_nontemporal_load(&nsrc[(size_t)(2 * i) * nldw]); }
            const int c = F.lane & 7;
            f32x4 k0v = (f32x4){1.f, 1.f, 1.f, 1.f}, k1v = k0v;
            if (ks) { k0v = *(const f32x4*)(ks + 8 * c); k1v = *(const f32x4*)(ks + 8 * c + 4); }
#pragma unroll
            for (int i = 0; i < 32; ++i) { const int kk = 2 * i + (F.lane >> 5); scr[kk * 33 + (F.lane & 31)] = tv[i]; }
            LDS_WAIT(); asm volatile("" ::: "memory");
#pragma unroll
            for (int j = 0; j < 4; ++j) { const int n = (F.lane >> 3) + 8 * j; const LAS float* sp = scr + (8 * c) * 33 + n;
                v4u o; o.x = pk2(sp[0 * 33] * k0v.x, sp[1 * 33] * k0v.y); o.y = pk2(sp[2 * 33] * k0v.z, sp[3 * 33] * k0v.w); o.z = pk2(sp[4 * 33] * k1v.x, sp[5 * 33] * k1v.y); o.w = pk2(sp[6 * 33] * k1v.z, sp[7 * 33] * k1v.w);
                if (lo >= P0_WIN_ITEMS) __builtin_nontemporal_store(o, (GAS v4u*)(dst + (size_t)n * K + 8 * c));
                else *(GAS v4u*)(dst + (size_t)n * K + 8 * c) = o; }
            LDS_WAIT(); asm volatile("" ::: "memory");
            if (more) {
#pragma unroll
                for (int i = 0; i < 32; ++i) tv[i] = nv_[i];
                dst = ndst; K = nK; ks = nks; }
        }
    }
#undef P0_DECODE
}
__device__ __forceinline__ void p0_prologue(Frame& F) {
    LAS float* scr = (LAS float*)(F.lds + F.wave * P0_SCR_STRIDE);
    const int gw = F.vcu * NWAVES + F.wave, NGW = F.G * NWAVES;
    const float* w_in = F.inp(10); const float* nmix = F.inp(7); const float* nff = F.inp(8);
    { LAS unsigned char* WD = F.lds + P0_WD_OFF;
      for (int k = F.tid; k < 1024; k += NWAVES * 64) { const float nk = nmix[k]; const f32x4* wp = (const f32x4*)(w_in + (size_t)k * INC + 3072);
#pragma unroll
          for (int q = 0; q < 4; ++q) { const f32x4 w4 = wp[q];
              *(LAS unsigned short*)(WD + (4 * q) * P0_WDB_PITCH + k * 2) = (unsigned short)f2bf(w4.x * nk); *(LAS unsigned short*)(WD + (4 * q + 1) * P0_WDB_PITCH + k * 2) = (unsigned short)f2bf(w4.y * nk);
              *(LAS unsigned short*)(WD + (4 * q + 2) * P0_WDB_PITCH + k * 2) = (unsigned short)f2bf(w4.z * nk); *(LAS unsigned short*)(WD + (4 * q + 3) * P0_WDB_PITCH + k * 2) = (unsigned short)f2bf(w4.w * nk); } } }
    { float* WT = (float*)(F.ws + (235u << 20)); const float* wd = F.inp(30);
      for (int idx = (int)blockIdx.x * (NWAVES * 64) + F.tid; idx < 1024 * 32; idx += F.G * NWAVES * 64) { const int ch = idx >> 5, k = idx & 31; WT[idx] = (k < 31) ? wd[k * 1024 + ch] : 0.f; } }
    p0_weights(F, 0, P0_WIN_ITEMS);
    FSTAMP(F);
    bf16* CAT = (bf16*)(F.ws + WS_CAT); float* SS = (float*)(F.ws + WS_SS); float* DT = (float*)(F.ws + WS_DT); float* DA = (float*)(F.ws + WS_DA);
    typedef __bf16 p0_bf2 __attribute__((ext_vector_type(2)));
    __syncthreads();
    unsigned wdt[16][8];
#pragma unroll
    for (int h = 0; h < 16; ++h)
#pragma unroll
        for (int j = 0; j < 4; ++j) { const v2u w2 = *(const LAS v2u*)(F.lds + P0_WD_OFF + h * P0_WDB_PITCH + (4 * F.lane + 256 * j) * 2); wdt[h][2 * j] = w2.x; wdt[h][2 * j + 1] = w2.y; }
    const float dt_bias = F.inp(13)[F.lane & 15], dt_a = -__expf(F.inp(14)[F.lane & 15]);
    f32x4 nv[4];
    { const int m0 = gw < MT ? gw : 0; const float* xrow = (m0 < MP) ? F.inp(0) + (size_t)m0 * DM : F.inp(1) + (size_t)(m0 - MP) * DM; const GAS f32x4* xr = (const GAS f32x4*)xrow + F.lane;
#pragma unroll
      for (int j = 0; j < 4; ++j) nv[j] = __builtin_nontemporal_load(&xr[64 * j]); }
    for (int m = gw; m < MT; m += NGW) {
        f32x4 v[4]; float s = 0.f;
#pragma unroll
        for (int j = 0; j < 4; ++j) { v[j] = nv[j]; s += (v[j].x * v[j].x + v[j].y * v[j].y) + (v[j].z * v[j].z + v[j].w * v[j].w); }
        { const int mn = (m + NGW < MT) ? m + NGW : m; const float* xrow = (mn < MP) ? F.inp(0) + (size_t)mn * DM : F.inp(1) + (size_t)(mn - MP) * DM; const GAS f32x4* xr = (const GAS f32x4*)xrow + F.lane;
#pragma unroll
          for (int j = 0; j < 4; ++j) nv[j] = __builtin_nontemporal_load(&xr[64 * j]); }
        s = wave_sum(s);
        GAS unsigned long long* o8 = (GAS unsigned long long*)(CAT + (size_t)m * 2048 + 1024) + F.lane;
        unsigned xp[8];
#pragma unroll
        for (int j = 0; j < 4; ++j) { xp[2 * j] = pk2(v[j].x, v[j].y); xp[2 * j + 1] = pk2(v[j].z, v[j].w); o8[64 * j] = (unsigned long long)xp[2 * j] | ((unsigned long long)xp[2 * j + 1] << 32); }
        if (F.lane < 16) SS[(size_t)m * 16 + F.lane] = (F.lane == 0) ? s : 0.f;
        float dd[16];
#pragma unroll
        for (int h = 0; h < 16; ++h) {
            float d = 0.f;
#pragma unroll
            for (int q = 0; q < 8; ++q) d = __builtin_amdgcn_fdot2_f32_bf16(__builtin_bit_cast(p0_bf2, xp[q]), __builtin_bit_cast(p0_bf2, wdt[h][q]), d, false);
            dd[h] = d;
        }
        float dsel = row16_reduce_scatter(dd, F.lane);
        dsel += __shfl_xor(dsel, 16); dsel += __shfl_xor(dsel, 32);
        if (F.lane < 16) {
            const float xr_ = dsel * __builtin_amdgcn_rsqf(s * (1.0f / 1024.0f) + EPS) + dt_bias;
            const float dtv = xr_ > 20.f ? xr_ : log1pf(__expf(xr_));
            DT[(size_t)m * 16 + F.lane] = dtv; DA[(size_t)m * 16 + F.lane] = dtv * dt_a;
        }
    }
}
constexpr int DT_WPITCH = 2064;
__device__ __forceinline__ void dt_phase(Frame& F) {
    typedef short dt_bf16x8 __attribute__((ext_vector_type(8)));
    const bf16* WDT = (const bf16*)(F.ws + WS_WDT); const bf16* CAT = (const bf16*)(F.ws + WS_CAT); const float* SS = (const float*)(F.ws + WS_SS);
    float* DT = (float*)(F.ws + WS_DT); float* DA = (float*)(F.ws + WS_DA);
    LAS unsigned char* WL = F.lds;
    for (int pc = F.tid; pc < 16 * 128; pc += NWAVES * 64) { const int h = pc >> 7, q = pc & 127; *(LAS v4u*)(WL + h * DT_WPITCH + q * 16) = *(const v4u*)(WDT + (size_t)h * 1024 + q * 8); }
    __syncthreads();
    const int fr = F.lane & 15, fq = F.lane >> 4;
    const int gw = F.vcu * NWAVES + F.wave;
    if (gw < MT / 16) {
        const int row = gw * 16 + fr;
        const bf16* xp = CAT + (size_t)row * 2048 + 1024 + 8 * fq;
        f32x4 acc = (f32x4){0.f, 0.f, 0.f, 0.f};
#pragma unroll
        for (int s8 = 0; s8 < 4; ++s8) {
            dt_bf16x8 xf[8];
#pragma unroll
            for (int k = 0; k < 8; ++k) xf[k] = *(const dt_bf16x8*)(xp + 32 * (8 * s8 + k));
#pragma unroll
            for (int k = 0; k < 8; ++k) { const dt_bf16x8 wf = *(const LAS dt_bf16x8*)(WL + fr * DT_WPITCH + (32 * (8 * s8 + k) + 8 * fq) * 2);
                acc = __builtin_amdgcn_mfma_f32_16x16x32_bf16(wf, xf[k], acc, 0, 0, 0); }
        }
        const float rstd = row_rstd(SS, row);
        const f32x4 bias = *(const f32x4*)(F.inp(13) + 4 * fq), al = *(const f32x4*)(F.inp(14) + 4 * fq);
        f32x4 dtv, dav;
#pragma unroll
        for (int j = 0; j < 4; ++j) { const float xr_ = acc[j] * rstd + bias[j]; dtv[j] = xr_ > 20.f ? xr_ : log1pf(__expf(xr_)); dav[j] = -dtv[j] * __expf(al[j]); }
        *(f32x4*)(DT + (size_t)row * 16 + 4 * fq) = dtv; *(f32x4*)(DA + (size_t)row * 16 + 4 * fq) = dav;
    }
    __syncthreads();
}
typedef short s5_bf16x8 __attribute__((ext_vector_type(8)));
constexpr int S5_HB_ROW = 272;
constexpr int S5_HB_WAVE = 2 * 16 * S5_HB_ROW;
constexpr int S5_HE_OFF = NWAVES * S5_HB_WAVE;
constexpr int S5_YT_OFF = S5_HE_OFF + NWAVES * 2 * 64 * 2 * 4;
constexpr int S5_LDS_END = S5_YT_OFF + NWAVES * 1024;
static_assert(S5_LDS_END <= LDSCTL_OFF, "S5 LDS");
constexpr int S5_PROMPT_UNITS = 256, S5_SAMPLE_UNITS = 256, S5_UNITS = S5_PROMPT_UNITS + S5_SAMPLE_UNITS;

__device__ __forceinline__ float gelu_tanh(float x) {
    const float arg = x * __builtin_fmaf(x * x, 0.10294324f, 2.3022082f);
    const float r = frcp_(__builtin_amdgcn_exp2f(arg) + 1.0f);
    return __builtin_fmaf(-x, r, x);
}

struct S5Consts {
    float lr[2], li[2];
    s5_bf16x8 bfr[2][2];
    s5_bf16x8 cm[4];
    s5_bf16x8 dm;
};
__device__ __forceinline__ void s5_setup(const Frame& F, int g, S5Consts& K) {
    const int lane = F.lane, r = lane & 31, hh = lane >> 5;
    const float step = expf(F.inp(19)[g]);
#pragma unroll
    for (int pt = 0; pt < 2; ++pt) {
        const int p = 32 * pt + r;
        const float lr = F.inp(17)[g * 64 + p], li = F.inp(18)[g * 64 + p];
        const float mag = expf(lr * step), ar = mag * cosf(li * step), ai = mag * sinf(li * step);
        const float den = lr * lr + li * li;
        const float kr = ((ar - 1.0f) * lr + ai * li) / den, ki = (ai * lr - (ar - 1.0f) * li) / den;
        K.lr[pt] = ar; K.li[pt] = ai;
        const float* br = F.inp(20) + ((size_t)(g * 64 + p) * 16 + 8 * hh); const float* bi = F.inp(21) + ((size_t)(g * 64 + p) * 16 + 8 * hh);
        unsigned wr_[4], wi_[4];
#pragma unroll
        for (int j = 0; j < 4; ++j) {
            const float b0r = br[2 * j], b0i = bi[2 * j], b1r = br[2 * j + 1], b1i = bi[2 * j + 1];
            wr_[j] = pk2(kr * b0r - ki * b0i, kr * b1r - ki * b1i);
            wi_[j] = pk2(kr * b0i + ki * b0r, kr * b1i + ki * b1r);
        }
        K.bfr[pt][0] = __builtin_bit_cast(s5_bf16x8, (v4u){wr_[0], wr_[1], wr_[2], wr_[3]});
        K.bfr[pt][1] = __builtin_bit_cast(s5_bf16x8, (v4u){wi_[0], wi_[1], wi_[2], wi_[3]});
    }
    const int c = lane & 15, q = lane >> 4;
#pragma unroll
    for (int s = 0; s < 4; ++s) {
        const int p0 = 16 * s + 4 * q;
        const float* cr = F.inp(22) + ((size_t)(g * 16 + c) * 64 + p0); const float* ci = F.inp(23) + ((size_t)(g * 16 + c) * 64 + p0);
        unsigned w[4];
#pragma unroll
        for (int j = 0; j < 4; ++j) w[j] = pk2(cr[j], -ci[j]);
        K.cm[s] = __builtin_bit_cast(s5_bf16x8, (v4u){w[0], w[1], w[2], w[3]});
    }
    { const float dv = F.inp(24)[g * 16 + c]; unsigned w[4];
#pragma unroll
      for (int j = 0; j < 4; ++j) { const int k0 = 8 * q + 2 * j; w[j] = pk2((q < 2 && k0 == c) ? dv : 0.f, (q < 2 && k0 + 1 == c) ? dv : 0.f); }
      K.dm = __builtin_bit_cast(s5_bf16x8, (v4u){w[0], w[1], w[2], w[3]}); }
}

struct S5Frags { s5_bf16x8 a, u0, u1; };
template <bool WITH_Y>
__device__ __forceinline__ S5Frags s5_load_a(const Frame& F, const bf16* U, int g, int base0, int base1) {
    S5Frags fr;
    const int r = F.lane & 31, hh = F.lane >> 5, h = (r >> 2) & 1, i = (r & 3) + 4 * (r >> 3);
    const int arow = (h ? base1 : base0) + i;
    fr.a = *(const GAS s5_bf16x8*)(U + (size_t)arow * 1024 + g * 16 + 8 * hh);
    const s5_bf16x8 zz = (s5_bf16x8){0, 0, 0, 0, 0, 0, 0, 0};
    fr.u0 = zz; fr.u1 = zz;
    if (WITH_Y) {
        const int t = F.lane & 15, q = F.lane >> 4;
        if (q < 2) { fr.u0 = *(const GAS s5_bf16x8*)(U + (size_t)(base0 + t) * 1024 + g * 16 + 8 * q); fr.u1 = *(const GAS s5_bf16x8*)(U + (size_t)(base1 + t) * 1024 + g * 16 + 8 * q); }
    }
    return fr;
}

template <int SEGLEN, bool WITH_Y>
__device__ __forceinline__ void s5_step(const Frame& F, const S5Consts& K, bf16* U, int g, int base0, int base1, const S5Frags& fg,
                                        float (&hr)[2][2], float (&hi)[2][2]  , LAS unsigned char* hb, LAS unsigned char* yt) {
    const s5_bf16x8 afrag = fg.a;
    const int lane = F.lane, hh = lane >> 5, r = lane & 31;
    f32x16 bu[2][2];
#pragma unroll
    for (int pt = 0; pt < 2; ++pt)
#pragma unroll
        for (int ri = 0; ri < 2; ++ri) {
            f32x16 z;
#pragma unroll
            for (int i = 0; i < 16; ++i) z[i] = 0.f;
            bu[pt][ri] = __builtin_amdgcn_mfma_f32_32x32x16_bf16(afrag, K.bfr[pt][ri], z, 0, 0, 0);
        }
#pragma unroll
    for (int i = 0; i < 16; ++i) {
        constexpr int dummy = 0; (void)dummy;
        const int cs = (SEGLEN == 8) ? (i >> 3) : 0;
#pragma unroll
        for (int pt = 0; pt < 2; ++pt) {
            const float nr = __builtin_fmaf(K.lr[pt], hr[cs][pt], __builtin_fmaf(-K.li[pt], hi[cs][pt], bu[pt][0][i]));
            const float ni = __builtin_fmaf(K.lr[pt], hi[cs][pt], __builtin_fmaf(K.li[pt], hr[cs][pt], bu[pt][1][i]));
            hr[cs][pt] = nr; hi[cs][pt] = ni;
            if (WITH_Y) *(LAS unsigned*)(hb + (hh * 16 + i) * S5_HB_ROW + (2 * (32 * pt + r)) * 2) = pk2(nr, ni);
        }
    }
    if (WITH_Y) {
        LDS_WAIT(); asm volatile("" ::: "memory");
        const int c = lane & 15, q = lane >> 4;
#pragma unroll
        for (int hf = 0; hf < 2; ++hf) {
            f32x4 y = (f32x4){0.f, 0.f, 0.f, 0.f};
#pragma unroll
            for (int s = 0; s < 4; ++s) {
                const s5_bf16x8 a = *(const LAS s5_bf16x8*)(hb + (hf * 16 + c) * S5_HB_ROW + (32 * s + 8 * q) * 2);
                y = __builtin_amdgcn_mfma_f32_16x16x32_bf16(a, K.cm[s], y, 0, 0, 0);
            }
            y = __builtin_amdgcn_mfma_f32_16x16x32_bf16(hf ? fg.u1 : fg.u0, K.dm, y, 0, 0, 0);
#pragma unroll
            for (int j = 0; j < 4; ++j) *(LAS unsigned short*)(yt + ((hf * 16 + 4 * q + j) * 16 + c) * 2) = (unsigned short)f2bf(gelu_tanh(y[j]));
        }
        {
            const int hf2 = lane >> 5, t = (lane & 31) >> 1, ck = lane & 1;
            const v4u o = *(const LAS v4u*)(yt + ((hf2 * 16 + t) * 16 + 8 * ck) * 2);
            *(GAS v4u*)(U + (size_t)((hf2 ? base1 : base0) + t) * 1024 + g * 16 + 8 * ck) = o;
        }
        LDS_WAIT(); asm volatile("" ::: "memory");
    }
}

__device__ __forceinline__ void s5_block_unit(Frame& F, int unit, S5Consts& K, int& kg  ) {
    bf16* U = (bf16*)(F.ws + WS_U);
    LAS unsigned char* hb = F.lds + F.wave * S5_HB_WAVE;
    LAS unsigned char* yt = F.lds + S5_YT_OFF + F.wave * 1024;
    LAS float* HE = (LAS float*)(F.lds + S5_HE_OFF);
    const int lane = F.lane, hh = lane >> 5, r = lane & 31, w = F.wave;
    if (unit < S5_PROMPT_UNITS) {
        const int g = unit & 63, bp = unit >> 6;
        FSTAMP(F);
        const int rb0 = bp * SEQ + 256 * w, rb1 = (bp + 4) * SEQ + 256 * w;
        S5Frags pf0 = s5_load_a<false>(F, U, g, rb0, rb1), pf1 = s5_load_a<false>(F, U, g, rb0 + 16, rb1 + 16);
        if (kg != g) { s5_setup(F, g, K); kg = g; }
        FSTAMP(F);
        float hr[2][2], hi[2][2];
#pragma unroll
        for (int a = 0; a < 2; ++a)
#pragma unroll
            for (int b = 0; b < 2; ++b) { hr[a][b] = 0.f; hi[a][b] = 0.f; }
        if (w < 7) {
            S5Frags af = pf0, af1 = pf1;
            for (int s = 0; s < 16; ++s) {
                const int s2 = (s + 2) & 15;
                const S5Frags af2 = s5_load_a<false>(F, U, g, rb0 + 16 * s2, rb1 + 16 * s2);
                s5_step<16, false>(F, K, U, g, rb0 + 16 * s, rb1 + 16 * s, af, hr, hi, hb, yt);
                af = af1; af1 = af2;
            }
        }
        S5Frags qf0 = s5_load_a<true>(F, U, g, rb0, rb1), qf1 = s5_load_a<true>(F, U, g, rb0 + 16, rb1 + 16);
#pragma unroll
        for (int pt = 0; pt < 2; ++pt) { HE[((w * 2 + hh) * 64 + 32 * pt + r) * 2 + 0] = hr[0][pt]; HE[((w * 2 + hh) * 64 + 32 * pt + r) * 2 + 1] = hi[0][pt]; }
        FSTAMP(F);
        __syncthreads();
        FSTAMP(F);
        float l256r[2], l256i[2];
#pragma unroll
        for (int pt = 0; pt < 2; ++pt) { float ar = K.lr[pt], ai = K.li[pt];
#pragma unroll
            for (int k = 0; k < 8; ++k) { const float nr = ar * ar - ai * ai, ni = 2.0f * ar * ai; ar = nr; ai = ni; }
            l256r[pt] = ar; l256i[pt] = ai; hr[0][pt] = 0.f; hi[0][pt] = 0.f; }
        for (int cp = 0; cp < w; ++cp) {
#pragma unroll
            for (int pt = 0; pt < 2; ++pt) {
                const float er = HE[((cp * 2 + hh) * 64 + 32 * pt + r) * 2 + 0], ei = HE[((cp * 2 + hh) * 64 + 32 * pt + r) * 2 + 1];
                const float nr = l256r[pt] * hr[0][pt] - l256i[pt] * hi[0][pt] + er, ni = l256r[pt] * hi[0][pt] + l256i[pt] * hr[0][pt] + ei;
                hr[0][pt] = nr; hi[0][pt] = ni; }
        }
        FSTAMP(F);
        {
            S5Frags af = qf0, af1 = qf1;
            for (int s = 0; s < 16; ++s) {
                const int s2 = (s + 2 < 16) ? s + 2 : 15;
                const S5Frags af2 = s5_load_a<true>(F, U, g, rb0 + 16 * s2, rb1 + 16 * s2);
                s5_step<16, true>(F, K, U, g, rb0 + 16 * s, rb1 + 16 * s, af, hr, hi, hb, yt);
                af = af1; af1 = af2;
            }
        }
        FSTAMP(F);
        if (w == 7) {
            const int b = hh ? bp + 4 : bp;
#pragma unroll
            for (int pt = 0; pt < 2; ++pt) { F.out[O_PBR + (size_t)(b * 64 + g) * 64 + 32 * pt + r] = hr[0][pt]; F.out[O_PBI + (size_t)(b * 64 + g) * 64 + 32 * pt + r] = hi[0][pt]; }
        }
        __syncthreads();
    } else {
        const int su = unit - S5_PROMPT_UNITS, g = su & 63, quarter = su >> 6;
        if (kg != g) { s5_setup(F, g, K); kg = g; }
        for (int qq = 0; qq < 1; ++qq) {
            const int quad = quarter * 8 + w, sb0 = 4 * quad;
            const int base0 = MP + sb0 * 8, base1 = base0 + 16;
            float hr[2][2], hi[2][2];
#pragma unroll
            for (int cs = 0; cs < 2; ++cs)
#pragma unroll
                for (int pt = 0; pt < 2; ++pt) { const int seq = sb0 + 2 * hh + cs; const size_t o = (size_t)(seq * 64 + g) * 64 + 32 * pt + r; hr[cs][pt] = F.inp(4)[o]; hi[cs][pt] = F.inp(5)[o]; }
            const S5Frags af = s5_load_a<true>(F, U, g, base0, base1);
            s5_step<8, true>(F, K, U, g, base0, base1, af, hr, hi, hb, yt);
#pragma unroll
            for (int cs = 0; cs < 2; ++cs)
#pragma unroll
                for (int pt = 0; pt < 2; ++pt) { const int seq = sb0 + 2 * hh + cs; const size_t o = (size_t)(seq * 64 + g) * 64 + 32 * pt + r; F.out[O_SBR + o] = hr[cs][pt]; F.out[O_SBI + o] = hi[cs][pt]; }
        }
    }
}
constexpr size_t WS_HALO = 230 * MiB;
constexpr size_t WS_CDEC = 234 * MiB;
typedef short ssd_bf16x8 __attribute__((ext_vector_type(8)));
constexpr int SSD_PITCH = 272;

constexpr int SSDS_XS = 0, SSDS_BS = SSDS_XS + 8 * 256 * 4, SSDS_CS = SSDS_BS + 8 * 128 * 4, SSDS_YS = SSDS_CS + 8 * 128 * 4, SSDS_END = SSDS_YS + 8 * 256 * 4;
__device__ __forceinline__ void ssd_sample_unit(Frame& F, int unit) {
    const int b = unit >> 2, g = unit & 3, tid = F.tid, lane = F.lane;
    const bf16* XBC = (const bf16*)(F.ws + WS_XBC); bf16* CAT = (bf16*)(F.ws + WS_CAT);
    const float* DT = (const float*)(F.ws + WS_DT); const float* DA = (const float*)(F.ws + WS_DA);
    LAS float* xs = (LAS float*)(F.lds + SSDS_XS); LAS float* Bs = (LAS float*)(F.lds + SSDS_BS); LAS float* Cs = (LAS float*)(F.lds + SSDS_CS); LAS float* ys = (LAS float*)(F.lds + SSDS_YS);
    const int row0 = MP + b * 8;
    const int p = tid >> 3, ns = tid & 7;
    f32x4 hst[4][4];
#pragma unroll
    for (int e = 0; e < 4; ++e) { const float* sp = F.inp(3) + ((size_t)(b * 16 + 4 * g + e) * 64 + p) * 128 + ns * 4;
#pragma unroll
        for (int k = 0; k < 4; ++k) hst[e][k] = __builtin_nontemporal_load((const f32x4*)(sp + 32 * k)); }
    f32x4 dt4[8], da4[8];
#pragma unroll
    for (int t = 0; t < 8; ++t) { dt4[t] = *(const f32x4*)(DT + (size_t)(row0 + t) * 16 + 4 * g); da4[t] = *(const f32x4*)(DA + (size_t)(row0 + t) * 16 + 4 * g); }
    bf16* zp = CAT + (size_t)(row0 + F.wave) * 2048 + g * 256 + 4 * lane;
    const v2u zw = *(const v2u*)zp;
    {
        const int col = (tid < 256) ? (g * 256 + tid) : ((tid < 384) ? (1024 + g * 128 + (tid - 256)) : (1536 + g * 128 + (tid - 384)));
        const float* cw = F.inp(11); const float w0 = cw[col], w1 = cw[2048 + col], w2 = cw[4096 + col], w3 = cw[6144 + col], bias = F.inp(12)[col];
        const float* st = F.inp(2) + (size_t)b * 3 * 2048 + col;
        float x0 = st[0], x1 = st[2048], x2 = st[4096];
        float xr[8];
#pragma unroll
        for (int t = 0; t < 8; ++t) xr[t] = bf2f(XBC[(size_t)(row0 + t) * 2048 + col]);
#pragma unroll
        for (int t = 0; t < 8; ++t) {
            const float x3 = xr[t];
            const float o = siluf_(bias + w0 * x0 + w1 * x1 + w2 * x2 + w3 * x3);
            if (tid < 256) xs[t * 256 + tid] = o; else if (tid < 384) Bs[t * 128 + (tid - 256)] = o; else Cs[t * 128 + (tid - 384)] = o;
            x0 = x1; x1 = x2; x2 = x3;
        }
    }
    __syncthreads();
#pragma unroll
    for (int e = 0; e < 4; ++e) {
        const int head = 4 * g + e;
        const size_t so = ((size_t)(b * 16 + head) * 64 + p) * 128 + ns * 4;
        const float dsk = F.inp(15)[head];
#pragma unroll
        for (int t = 0; t < 8; ++t) {
            const float dec = __expf(da4[t][e]);
            const float xv = xs[t * 256 + e * 64 + p], dtx = dt4[t][e] * xv;
            float yp = 0.f, yq = 0.f;
#pragma unroll
            for (int k = 0; k < 4; ++k) {
                const f32x4 bv = *(const LAS f32x4*)(Bs + t * 128 + ns * 4 + 32 * k), cv = *(const LAS f32x4*)(Cs + t * 128 + ns * 4 + 32 * k);
                hst[e][k] = hst[e][k] * dec + bv * dtx;
                yp = __builtin_fmaf(cv.x, hst[e][k].x, yp); yq = __builtin_fmaf(cv.y, hst[e][k].y, yq);
                yp = __builtin_fmaf(cv.z, hst[e][k].z, yp); yq = __builtin_fmaf(cv.w, hst[e][k].w, yq);
            }
            yp = dpp_sum8(yp + yq);
            if (ns == 0) ys[t * 256 + e * 64 + p] = yp + dsk * xv;
            asm volatile("" ::: "memory");
        }
#pragma unroll
        for (int k = 0; k < 4; ++k) __builtin_nontemporal_store(hst[e][k], (f32x4*)(F.out + O_SAS + so + 32 * k));
    }
    __syncthreads();
    {
        const int t = F.wave, ch = 4 * lane;
        const f32x4 yv = *(const LAS f32x4*)(ys + t * 256 + ch);
        f32x4 gv; gv.x = yv.x * siluf_(bflo(zw.x)); gv.y = yv.y * siluf_(bfhi(zw.x)); gv.z = yv.z * siluf_(bflo(zw.y)); gv.w = yv.w * siluf_(bfhi(zw.y));
        const float ssq = wave_sum((gv.x * gv.x + gv.y * gv.y) + (gv.z * gv.z + gv.w * gv.w));
        const float rs = __builtin_amdgcn_rsqf(ssq * (1.0f / 256.0f) + EPS);
        const f32x4 nw = *(const f32x4*)(F.inp(16) + g * 256 + ch);
        v2u o; o.x = pk2(gv.x * rs * nw.x, gv.y * rs * nw.y); o.y = pk2(gv.z * rs * nw.z, gv.w * rs * nw.w);
        *(v2u*)zp = o;
    }
    __syncthreads();
}

__device__ __forceinline__ void ssd_cum(Frame& F, int rowc  , int g, LAS float* cum, LAS float* dtl) {
    if (F.wave < 4) {
        const int e = F.wave, l = F.lane; const float* DT = (const float*)(F.ws + WS_DT); const float* DA = (const float*)(F.ws + WS_DA);
        const float a0 = DA[(size_t)(rowc + 2 * l) * 16 + 4 * g + e], a1 = DA[(size_t)(rowc + 2 * l + 1) * 16 + 4 * g + e];
        dtl[e * 128 + 2 * l] = DT[(size_t)(rowc + 2 * l) * 16 + 4 * g + e]; dtl[e * 128 + 2 * l + 1] = DT[(size_t)(rowc + 2 * l + 1) * 16 + 4 * g + e];
        float s = a0 + a1;
#pragma unroll
        for (int o = 1; o < 64; o <<= 1) { const float t = __shfl_up(s, o); if (l >= o) s += t; }
        cum[e * 128 + 2 * l + 1] = s * 1.4426950408889634f; cum[e * 128 + 2 * l] = (s - a1) * 1.4426950408889634f;
    }
}

constexpr int SSD2_XT = 0, SSD2_BT = SSD2_XT + 256 * SSD_PITCH, SSD2_CUM = SSD2_BT + 128 * SSD_PITCH, SSD2_DT = SSD2_CUM + 4 * 128 * 4, SSD2_W = SSD2_DT + 4 * 128 * 4, SSD2_END = SSD2_W + 4 * 128 * 4;
static_assert(SSD2_END <= LDSCTL_OFF, "SSD2 LDS");
__device__ __forceinline__ void ssd_state_unit(Frame& F, int unit) {
    const int g = unit & 3, c = (unit >> 2) & 15, b = unit >> 6, tid = F.tid, lane = F.lane;
    bf16* XBC = (bf16*)(F.ws + WS_XBC); const bf16* HALO = (const bf16*)(F.ws + WS_HALO);
    bf16* SSTB = (bf16*)(F.out + O_Y); float* CDEC = (float*)(F.ws + WS_CDEC);
    LAS unsigned char* XT = F.lds + SSD2_XT; LAS unsigned char* BT = F.lds + SSD2_BT;
    LAS float* cum = (LAS float*)(F.lds + SSD2_CUM); LAS float* dtl = (LAS float*)(F.lds + SSD2_DT); LAS float* wl = (LAS float*)(F.lds + SSD2_W);
    const int rowc = b * SEQ + c * 128;
    {
        const int cp = tid & 255, th = tid >> 8;
        const int kind = (cp < 128) ? 0 : ((cp < 192) ? 1 : 2);
        const int lc = (kind == 0) ? 2 * cp : ((kind == 1) ? 2 * (cp - 128) : 2 * (cp - 192));
        const int col = (kind == 0) ? (g * 256 + lc) : ((kind == 1) ? (1024 + g * 128 + lc) : (1536 + g * 128 + lc));
        const float* cw = F.inp(11);
        const float wa0 = cw[col], wa1 = cw[2048 + col], wa2 = cw[4096 + col], wa3 = cw[6144 + col], ba = F.inp(12)[col];
        const float wb0 = cw[col + 1], wb1 = cw[2048 + col + 1], wb2 = cw[4096 + col + 1], wb3 = cw[6144 + col + 1], bb = F.inp(12)[col + 1];
        const int seg = c * 2 + th;
        float xa0 = 0.f, xa1 = 0.f, xa2 = 0.f, xb0 = 0.f, xb1 = 0.f, xb2 = 0.f;
        if (seg > 0) { const bf16* hp = HALO + ((size_t)(b * 32 + seg - 1) * 3) * 2048 + col;
            const unsigned h0 = *(const unsigned*)hp, h1 = *(const unsigned*)(hp + 2048), h2 = *(const unsigned*)(hp + 4096);
            xa0 = bflo(h0); xb0 = bfhi(h0); xa1 = bflo(h1); xb1 = bfhi(h1); xa2 = bflo(h2); xb2 = bfhi(h2); }
        const int e = lc >> 6;
        bf16* xp = XBC + (size_t)(rowc + 64 * th) * 2048 + col;
        unsigned nxt[8], nx2[8];
#pragma unroll
        for (int k = 0; k < 8; ++k) { nxt[k] = __builtin_nontemporal_load((const unsigned*)(xp + (size_t)k * 2048)); nx2[k] = __builtin_nontemporal_load((const unsigned*)(xp + (size_t)(8 + k) * 2048)); }
        ssd_cum(F, rowc, g, cum, dtl);
        __syncthreads();
        { const int e2 = tid >> 7, j = tid & 127; wl[e2 * 128 + j] = __builtin_amdgcn_exp2f(cum[e2 * 128 + 127] - cum[e2 * 128 + j]) * dtl[e2 * 128 + j];
          if (j == 127) CDEC[(b * 16 + c) * 16 + 4 * g + e2] = __builtin_amdgcn_exp2f(cum[e2 * 128 + 127]); }
        __syncthreads();
        for (int t8 = 0; t8 < 8; ++t8) {
            unsigned raw[8];
#pragma unroll
            for (int k = 0; k < 8; ++k) { raw[k] = nxt[k]; nxt[k] = nx2[k]; }
            if (t8 < 6) {
#pragma unroll
                for (int k = 0; k < 8; ++k) nx2[k] = __builtin_nontemporal_load((const unsigned*)(xp + (size_t)(t8 * 8 + 16 + k) * 2048));
            }
            unsigned oa[4], ob[4]; float pa = 0.f, pb = 0.f;
#pragma unroll
            for (int k = 0; k < 8; ++k) {
                const float xa3 = bflo(raw[k]), xb3 = bfhi(raw[k]);
                const float va = siluf_(ba + wa0 * xa0 + wa1 * xa1 + wa2 * xa2 + wa3 * xa3), vb = siluf_(bb + wb0 * xb0 + wb1 * xb1 + wb2 * xb2 + wb3 * xb3);
                xa0 = xa1; xa1 = xa2; xa2 = xa3; xb0 = xb1; xb1 = xb2; xb2 = xb3;
                *(unsigned*)(xp + (size_t)(t8 * 8 + k) * 2048) = pk2(va, vb);
                float sa = va, sb = vb;
                if (kind == 0) { const float ww = wl[e * 128 + 64 * th + t8 * 8 + k]; sa *= ww; sb *= ww; }
                if (k & 1) { oa[k >> 1] = pk2(pa, sa); ob[k >> 1] = pk2(pb, sb); } else { pa = sa; pb = sb; }
            }
            if (kind == 0) { *(LAS v4u*)(XT + lc * SSD_PITCH + (64 * th + t8 * 8) * 2) = (v4u){oa[0], oa[1], oa[2], oa[3]}; *(LAS v4u*)(XT + (lc + 1) * SSD_PITCH + (64 * th + t8 * 8) * 2) = (v4u){ob[0], ob[1], ob[2], ob[3]}; }
            else if (kind == 1) { *(LAS v4u*)(BT + lc * SSD_PITCH + (64 * th + t8 * 8) * 2) = (v4u){oa[0], oa[1], oa[2], oa[3]}; *(LAS v4u*)(BT + (lc + 1) * SSD_PITCH + (64 * th + t8 * 8) * 2) = (v4u){ob[0], ob[1], ob[2], ob[3]}; }
        }
    }
    __syncthreads();
    {
        const int e = F.wave >> 1, ph = F.wave & 1, r = lane & 31, hh = lane >> 5;
        f32x16 acc[4];
#pragma unroll
        for (int nt = 0; nt < 4; ++nt)
#pragma unroll
            for (int i = 0; i < 16; ++i) acc[nt][i] = 0.f;
#pragma unroll
        for (int s = 0; s < 8; ++s) {
            const ssd_bf16x8 a = *(const LAS ssd_bf16x8*)(XT + (e * 64 + 32 * ph + r) * SSD_PITCH + (16 * s + 8 * hh) * 2);
#pragma unroll
            for (int nt = 0; nt < 4; ++nt) {
                const ssd_bf16x8 bq = *(const LAS ssd_bf16x8*)(BT + (32 * nt + r) * SSD_PITCH + (16 * s + 8 * hh) * 2);
                acc[nt] = __builtin_amdgcn_mfma_f32_32x32x16_bf16(a, bq, acc[nt], 0, 0, 0);
            }
        }
        bf16* sp = SSTB + ((size_t)((b * 16 + c) * 16 + 4 * g + e) * 64 + 32 * ph) * 128;
#pragma unroll
        for (int nt = 0; nt < 4; ++nt)
#pragma unroll
            for (int i = 0; i < 16; ++i) { const int prow = (i & 3) + 8 * (i >> 2) + 4 * hh; sp[(size_t)prow * 128 + 32 * nt + r] = (bf16)f2bf_int(acc[nt][i]); }
    }
    __syncthreads();
}

__device__ __forceinline__ void ssd_carry(Frame& F) {
    bf16* SSTB = (bf16*)(F.out + O_Y); const float* CDEC = (const float*)(F.ws + WS_CDEC);
    const int gt = (int)blockIdx.x * 512 + F.tid, NT = F.G * 512;
    for (int idx = gt; idx < 8 * 16 * 1024; idx += NT) {
        const int q8 = idx & 1023, head = (idx >> 10) & 15, b = idx >> 14;
        float h[8];
#pragma unroll
        for (int k = 0; k < 8; ++k) h[k] = 0.f;
        v4u cur = __builtin_nontemporal_load((const v4u*)(SSTB + ((size_t)((b * 16 + 0) * 16 + head)) * 8192) + q8);
        for (int c = 0; c < 16; ++c) {
            v4u* sp = (v4u*)(SSTB + ((size_t)((b * 16 + c) * 16 + head)) * 8192) + q8;
            const v4u sv = cur;
            if (c < 15) cur = __builtin_nontemporal_load((const v4u*)(SSTB + ((size_t)((b * 16 + c + 1) * 16 + head)) * 8192) + q8);
            *sp = (v4u){pk2(h[0], h[1]), pk2(h[2], h[3]), pk2(h[4], h[5]), pk2(h[6], h[7])};
            const float d = CDEC[(b * 16 + c) * 16 + head];
            h[0] = h[0] * d + bflo(sv.x); h[1] = h[1] * d + bfhi(sv.x); h[2] = h[2] * d + bflo(sv.y); h[3] = h[3] * d + bfhi(sv.y);
            h[4] = h[4] * d + bflo(sv.z); h[5] = h[5] * d + bfhi(sv.z); h[6] = h[6] * d + bflo(sv.w); h[7] = h[7] * d + bfhi(sv.w);
        }
        f32x4* op = (f32x4*)(F.out + O_PAS + (size_t)(b * 16 + head) * 8192) + 2 * q8;
        __builtin_nontemporal_store((f32x4){h[0], h[1], h[2], h[3]}, &op[0]); __builtin_nontemporal_store((f32x4){h[4], h[5], h[6], h[7]}, &op[1]);
    }
}

constexpr int SSD4_ZP = 144, SSD4_OP = 528;
constexpr int SSD4_CS = 0, SSD4_BS = SSD4_CS + 128 * SSD_PITCH, SSD4_L = SSD4_BS + 128 * SSD_PITCH, SSD4_XT = SSD4_L + 128 * SSD_PITCH, SSD4_HIN = SSD4_XT + 64 * SSD_PITCH,
              SSD4_CUM = SSD4_HIN + 64 * SSD_PITCH, SSD4_DT = SSD4_CUM + 4 * 128 * 4, SSD4_RED = SSD4_DT + 4 * 128 * 4, SSD4_END = SSD4_RED + 2 * 128 * 4;
static_assert(SSD4_END <= LDSCTL_OFF && 128 * SSD4_ZP <= 128 * SSD_PITCH && 128 * SSD4_OP <= SSD4_XT, "SSD4 LDS");
__device__ __forceinline__ void ssd_y_unit(Frame& F, int unit) {
    const int g = unit & 3, c = (unit >> 2) & 15, b = unit >> 6, tid = F.tid, lane = F.lane, wv = F.wave, r = lane & 31, hh = lane >> 5;
    const bf16* XBC = (const bf16*)(F.ws + WS_XBC); bf16* CAT = (bf16*)(F.ws + WS_CAT); const bf16* HINB = (const bf16*)(F.out + O_Y);
    LAS unsigned char* Cs = F.lds + SSD4_CS; LAS unsigned char* Bs = F.lds + SSD4_BS; LAS unsigned char* Lm = F.lds + SSD4_L; LAS unsigned char* XT = F.lds + SSD4_XT; LAS unsigned char* Hn = F.lds + SSD4_HIN;
    LAS float* cum = (LAS float*)(F.lds + SSD4_CUM); LAS float* dtl = (LAS float*)(F.lds + SSD4_DT); LAS float* red = (LAS float*)(F.lds + SSD4_RED);
    const int rowc = b * SEQ + c * 128;
    const bool stp = unit < 256;
    if (stp) FSTAMP(F);
    unsigned pre_raw[8]; v4u pre_z[2]; v4u pre_h[2];
#define SSD4_PREFETCH(EE) do { const int _e = (EE); \
        { const int cp = tid & 31, tb = tid >> 5; _Pragma("unroll") for (int k = 0; k < 8; ++k) pre_raw[k] = __builtin_nontemporal_load((const unsigned*)(XBC + (size_t)(rowc + tb * 8 + k) * 2048 + g * 256 + _e * 64 + 2 * cp)); } \
        _Pragma("unroll") for (int k = 0; k < 2; ++k) { const int pc = tid + 512 * k, row = pc >> 3, q = pc & 7; pre_z[k] = __builtin_nontemporal_load((const v4u*)(CAT + (size_t)(rowc + row) * 2048 + g * 256 + _e * 64 + q * 8)); } \
        { const int p = tid >> 3, n0 = (tid & 7) * 16; const v4u* hp = (const v4u*)(HINB + ((size_t)((b * 16 + c) * 16 + 4 * g + _e) * 64 + p) * 128 + n0); \
          pre_h[0] = __builtin_nontemporal_load(&hp[0]); pre_h[1] = __builtin_nontemporal_load(&hp[1]); } } while (0)
    v4u bcb[4], bcc[4];
#pragma unroll
    for (int k = 0; k < 4; ++k) { const int pc = tid + 512 * k, row = pc >> 4, q = pc & 15;
        bcb[k] = __builtin_nontemporal_load((const v4u*)(XBC + (size_t)(rowc + row) * 2048 + 1024 + g * 128 + q * 8)); bcc[k] = __builtin_nontemporal_load((const v4u*)(XBC + (size_t)(rowc + row) * 2048 + 1536 + g * 128 + q * 8)); }
    SSD4_PREFETCH(0);
    ssd_cum(F, rowc, g, cum, dtl);
#pragma unroll
    for (int k = 0; k < 4; ++k) { const int pc = tid + 512 * k, row = pc >> 4, q = pc & 15;
        *(LAS v4u*)(Bs + row * SSD_PITCH + q * 16) = bcb[k]; *(LAS v4u*)(Cs + row * SSD_PITCH + q * 16) = bcc[k]; }
    __syncthreads();
    if (stp) FSTAMP(F);
    const int pw = (0x50317642 >> (4 * wv)) & 7;
    f32x16 G[2];
#pragma unroll
    for (int tt = 0; tt < 2; ++tt) {
        const int idx = 2 * pw + tt, it = idx >> 2, jt = idx & 3;
#pragma unroll
        for (int i = 0; i < 16; ++i) G[tt][i] = 0.f;
        if (jt <= it) {
#pragma unroll
            for (int s = 0; s < 8; ++s) {
                const ssd_bf16x8 a = *(const LAS ssd_bf16x8*)(Cs + (32 * it + r) * SSD_PITCH + (16 * s + 8 * hh) * 2);
                const ssd_bf16x8 bq = *(const LAS ssd_bf16x8*)(Bs + (32 * jt + r) * SSD_PITCH + (16 * s + 8 * hh) * 2);
                G[tt] = __builtin_amdgcn_mfma_f32_32x32x16_bf16(a, bq, G[tt], 0, 0, 0);
            }
        }
    }
    __syncthreads();
    if (stp) FSTAMP(F);
    const int yit = wv >> 1, ypt = wv & 1;
    v4u ya0, yb0, ya1, yb1, ya2, yb2, ya3, yb3;
    float ssq_acc = 0.f;
    for (int e = 0; e < 4; ++e) {
        asm volatile("" ::: "memory");
#pragma unroll
        for (int tt = 0; tt < 2; ++tt) {
            const int idx = 2 * pw + tt, it = idx >> 2, jt = idx & 3;
            const int j = 32 * jt + r;
            if (jt > it) {
                if (e == 0) {
#pragma unroll
                    for (int i16 = 0; i16 < 16; ++i16) { const int i = 32 * it + (i16 & 3) + 8 * (i16 >> 2) + 4 * hh; *(LAS unsigned short*)(Lm + i * SSD_PITCH + j * 2) = (unsigned short)0; }
                }
                continue;
            }
            const float cj = cum[e * 128 + j], dj = dtl[e * 128 + j];
#pragma unroll
            for (int a4 = 0; a4 < 4; ++a4) {
                const f32x4 ci = *(const LAS f32x4*)(cum + e * 128 + 32 * it + 8 * a4 + 4 * hh);
#pragma unroll
                for (int b4 = 0; b4 < 4; ++b4) {
                    const int i16 = 4 * a4 + b4, i = 32 * it + b4 + 8 * a4 + 4 * hh;
                    float v = 0.f;
                    if (j <= i) v = G[tt][i16] * __builtin_amdgcn_exp2f(ci[b4] - cj) * dj;
                    *(LAS unsigned short*)(Lm + i * SSD_PITCH + j * 2) = (unsigned short)f2bf(v);
                }
            }
        }
        { const int cp = tid & 31, tb = tid >> 5;
          v4u oa, ob;
          oa.x = (pre_raw[0] & 0xffffu) | (pre_raw[1] << 16); oa.y = (pre_raw[2] & 0xffffu) | (pre_raw[3] << 16); oa.z = (pre_raw[4] & 0xffffu) | (pre_raw[5] << 16); oa.w = (pre_raw[6] & 0xffffu) | (pre_raw[7] << 16);
          ob.x = (pre_raw[0] >> 16) | (pre_raw[1] & 0xffff0000u); ob.y = (pre_raw[2] >> 16) | (pre_raw[3] & 0xffff0000u); ob.z = (pre_raw[4] >> 16) | (pre_raw[5] & 0xffff0000u); ob.w = (pre_raw[6] >> 16) | (pre_raw[7] & 0xffff0000u);
          *(LAS v4u*)(XT + (2 * cp) * SSD_PITCH + tb * 16) = oa; *(LAS v4u*)(XT + (2 * cp + 1) * SSD_PITCH + tb * 16) = ob; }
#pragma unroll
        for (int k = 0; k < 2; ++k) { const int pc = tid + 512 * k, row = pc >> 3, q = pc & 7; *(LAS v4u*)(Bs + row * SSD4_ZP + q * 16) = pre_z[k]; }
        { const int p = tid >> 3, n0 = (tid & 7) * 16;
          *(LAS v4u*)(Hn + p * SSD_PITCH + n0 * 2) = pre_h[0]; *(LAS v4u*)(Hn + p * SSD_PITCH + n0 * 2 + 16) = pre_h[1]; }
        if (stp && e == 0) FSTAMP(F);
        __syncthreads();
        if (stp && e == 0) FSTAMP(F);
        if (e < 3) SSD4_PREFETCH(e + 1);
        f32x16 yd;
#pragma unroll
        for (int i = 0; i < 16; ++i) yd[i] = 0.f;
#pragma unroll
        for (int s = 0; s < 8; ++s) {
            const ssd_bf16x8 ah = *(const LAS ssd_bf16x8*)(Hn + (32 * ypt + r) * SSD_PITCH + (16 * s + 8 * hh) * 2);
            const ssd_bf16x8 bc = *(const LAS ssd_bf16x8*)(Cs + (32 * yit + r) * SSD_PITCH + (16 * s + 8 * hh) * 2);
            yd = __builtin_amdgcn_mfma_f32_32x32x16_bf16(ah, bc, yd, 0, 0, 0);
        }
        const float dsk = F.inp(15)[4 * g + e];
        const int ti = 32 * yit + r;
        const float ec = __builtin_amdgcn_exp2f(cum[e * 128 + ti]);
#pragma unroll
        for (int i16 = 0; i16 < 16; ++i16) {
            const int pl = 32 * ypt + (i16 & 3) + 8 * (i16 >> 2) + 4 * hh;
            const float xv = bf2f(*(const LAS unsigned short*)(XT + pl * SSD_PITCH + ti * 2));
            yd[i16] = ec * yd[i16] + dsk * xv;
        }
#pragma unroll
        for (int s = 0; s < 8; ++s) {
            const ssd_bf16x8 ax = *(const LAS ssd_bf16x8*)(XT + (32 * ypt + r) * SSD_PITCH + (16 * s + 8 * hh) * 2);
            const ssd_bf16x8 bl = *(const LAS ssd_bf16x8*)(Lm + (32 * yit + r) * SSD_PITCH + (16 * s + 8 * hh) * 2);
            yd = __builtin_amdgcn_mfma_f32_32x32x16_bf16(ax, bl, yd, 0, 0, 0);
        }
#pragma unroll
        for (int g4 = 0; g4 < 4; ++g4) {
            const v2u zw = *(const LAS v2u*)(Bs + ti * SSD4_ZP + (32 * ypt + 8 * g4 + 4 * hh) * 2);
            const float g0 = yd[4 * g4] * siluf_(bflo(zw.x)), g1 = yd[4 * g4 + 1] * siluf_(bfhi(zw.x)), g2 = yd[4 * g4 + 2] * siluf_(bflo(zw.y)), g3 = yd[4 * g4 + 3] * siluf_(bfhi(zw.y));
            yd[4 * g4] = g0; yd[4 * g4 + 1] = g1; yd[4 * g4 + 2] = g2; yd[4 * g4 + 3] = g3;
            ssq_acc += (g0 * g0 + g1 * g1) + (g2 * g2 + g3 * g3);
        }
        { const v4u pa = (v4u){pk2(yd[0], yd[1]), pk2(yd[2], yd[3]), pk2(yd[4], yd[5]), pk2(yd[6], yd[7])}, pb = (v4u){pk2(yd[8], yd[9]), pk2(yd[10], yd[11]), pk2(yd[12], yd[13]), pk2(yd[14], yd[15])};
          if (e == 0) { ya0 = pa; yb0 = pb; } else if (e == 1) { ya1 = pa; yb1 = pb; } else if (e == 2) { ya2 = pa; yb2 = pb; } else { ya3 = pa; yb3 = pb; } }
        __syncthreads();
    }
#undef SSD4_PREFETCH
    const int ti = 32 * yit + r;
    ssq_acc += __shfl_xor(ssq_acc, 32);
    if (hh == 0) red[ypt * 128 + ti] = ssq_acc;
    __syncthreads();
    LAS unsigned char* Ot = F.lds;
    {
        const float rs = __builtin_amdgcn_rsqf((red[ti] + red[128 + ti]) * (1.0f / 256.0f) + EPS);
        const float* nwp = F.inp(16) + g * 256 + 32 * ypt + 4 * hh;
#pragma unroll
        for (int g4 = 0; g4 < 4; ++g4) {
            const unsigned w00 = (g4 == 0) ? ya0.x : (g4 == 1) ? ya0.z : (g4 == 2) ? yb0.x : yb0.z, w01 = (g4 == 0) ? ya0.y : (g4 == 1) ? ya0.w : (g4 == 2) ? yb0.y : yb0.w;
            const unsigned w10 = (g4 == 0) ? ya1.x : (g4 == 1) ? ya1.z : (g4 == 2) ? yb1.x : yb1.z, w11 = (g4 == 0) ? ya1.y : (g4 == 1) ? ya1.w : (g4 == 2) ? yb1.y : yb1.w;
            const unsigned w20 = (g4 == 0) ? ya2.x : (g4 == 1) ? ya2.z : (g4 == 2) ? yb2.x : yb2.z, w21 = (g4 == 0) ? ya2.y : (g4 == 1) ? ya2.w : (g4 == 2) ? yb2.y : yb2.w;
            const unsigned w30 = (g4 == 0) ? ya3.x : (g4 == 1) ? ya3.z : (g4 == 2) ? yb3.x : yb3.z, w31 = (g4 == 0) ? ya3.y : (g4 == 1) ? ya3.w : (g4 == 2) ? yb3.y : yb3.w;
            const f32x4 n0 = *(const f32x4*)(nwp + 8 * g4), n1 = *(const f32x4*)(nwp + 64 + 8 * g4), n2 = *(const f32x4*)(nwp + 128 + 8 * g4), n3 = *(const f32x4*)(nwp + 192 + 8 * g4);
            LAS unsigned char* op = Ot + ti * SSD4_OP + (32 * ypt + 8 * g4 + 4 * hh) * 2;
            *(LAS v2u*)(op)       = (v2u){pk2(bflo(w00) * rs * n0.x, bfhi(w00) * rs * n0.y), pk2(bflo(w01) * rs * n0.z, bfhi(w01) * rs * n0.w)};
            *(LAS v2u*)(op + 128) = (v2u){pk2(bflo(w10) * rs * n1.x, bfhi(w10) * rs * n1.y), pk2(bflo(w11) * rs * n1.z, bfhi(w11) * rs * n1.w)};
            *(LAS v2u*)(op + 256) = (v2u){pk2(bflo(w20) * rs * n2.x, bfhi(w20) * rs * n2.y), pk2(bflo(w21) * rs * n2.z, bfhi(w21) * rs * n2.w)};
            *(LAS v2u*)(op + 384) = (v2u){pk2(bflo(w30) * rs * n3.x, bfhi(w30) * rs * n3.y), pk2(bflo(w31) * rs * n3.z, bfhi(w31) * rs * n3.w)};
        }
    }
    __syncthreads();
#pragma unroll
    for (int k = 0; k < 8; ++k) { const int pc = tid + 512 * k, row = pc >> 5, q = pc & 31;
        *(v4u*)(CAT + (size_t)(rowc + row) * 2048 + g * 256 + q * 8) = *(const LAS v4u*)(Ot + row * SSD4_OP + q * 16); }
    __syncthreads();
}
constexpr size_t WS_WDWT = 235 * MiB;
typedef float cf32x2 __attribute__((ext_vector_type(2)));
template <int T, int NT, bool SAMPLE>
__device__ __forceinline__ void cconv_run(Frame& F, int row0  , bool has_hist  , const float* state  ) {
    const bf16* G = (const bf16*)(F.ws + WS_G); bf16* CV = (bf16*)(F.ws + WS_CV); const float* WT = (const float*)(F.ws + WS_WDWT);
    const int tid = F.tid, lane = F.lane;
    constexpr int ROWS = T + 30;
    const unsigned* gp = (const unsigned*)(G + (size_t)row0 * 1024) + tid;
    cf32x2 xv[ROWS], wv[31];
    {
        unsigned cur[T];
        if (SAMPLE) {
            cf32x2 sv[30];
#pragma unroll
            for (int k = 0; k < 30; ++k) sv[k] = *(const cf32x2*)(state + (size_t)k * 1024 + 2 * tid);
#pragma unroll
            for (int k = 0; k < T; ++k) cur[k] = __builtin_nontemporal_load(&gp[k * 512]);
#pragma unroll
            for (int k = 0; k < 30; ++k) xv[k] = sv[k];
        } else {
            unsigned xr[30];
#pragma unroll
            for (int k = 0; k < 30; ++k) xr[k] = 0u;
            if (has_hist) {
#pragma unroll
                for (int k = 0; k < 30; ++k) xr[k] = __builtin_nontemporal_load(&gp[(k - 30) * 512]);
            }
#pragma unroll
            for (int k = 0; k < T; ++k) cur[k] = __builtin_nontemporal_load(&gp[k * 512]);
#pragma unroll
            for (int k = 0; k < 30; ++k) xv[k] = (cf32x2){bflo(xr[k]), bfhi(xr[k])};
        }
        { const f32x4* wp = (const f32x4*)(WT + (size_t)(2 * tid) * 32);
#pragma unroll
          for (int k4 = 0; k4 < 8; ++k4) { const f32x4 t4 = wp[k4], u4 = wp[8 + k4];
              wv[4 * k4] = (cf32x2){t4.x, u4.x}; wv[4 * k4 + 1] = (cf32x2){t4.y, u4.y}; wv[4 * k4 + 2] = (cf32x2){t4.z, u4.z}; if (k4 < 7) wv[4 * k4 + 3] = (cf32x2){t4.w, u4.w}; } }
#pragma unroll
        for (int k = 0; k < T; ++k) xv[30 + k] = (cf32x2){bflo(cur[k]), bfhi(cur[k])};
    }
    const cf32x2 bias2 = *(const cf32x2*)(F.inp(31) + 2 * tid);
    const cf32x2 lw = *(const cf32x2*)(F.inp(32) + 2 * tid), lb = *(const cf32x2*)(F.inp(33) + 2 * tid);
    LAS float* red = (LAS float*)(F.lds);
#pragma unroll 1
    for (int tile = 0; tile < NT; ++tile) {
        unsigned nx[T];
        if (tile + 1 < NT) {
#pragma unroll
            for (int k = 0; k < T; ++k) nx[k] = __builtin_nontemporal_load(&gp[((tile + 1) * T + k) * 512]);
        }
        float o0[T], o1[T];
#pragma unroll
        for (int t = 0; t < T; ++t) {
            cf32x2 a0 = bias2, a1 = (cf32x2){0.f, 0.f};
#pragma unroll
            for (int k = 0; k < 30; k += 2) { a0 += wv[k] * xv[t + k]; a1 += wv[k + 1] * xv[t + k + 1]; }
            a0 += wv[30] * xv[t + 30];
            a0 += a1;
            o0[t] = a0.x; o1[t] = a0.y;
        }
        LAS float* rb = red + (tile & 1) * 256;
        if constexpr (T == 16) {
            float rs, rq;
            { float sa[16];
#pragma unroll
              for (int t = 0; t < 16; ++t) sa[t] = o0[t] + o1[t];
              rs = row16_reduce_scatter(sa, lane); }
            asm volatile("" ::: "memory");
            { float qa[16];
#pragma unroll
              for (int t = 0; t < 16; ++t) qa[t] = o0[t] * o0[t] + o1[t] * o1[t];
              rq = row16_reduce_scatter(qa, lane); }
            rs += __shfl_xor(rs, 16); rq += __shfl_xor(rq, 16); rs += __shfl_xor(rs, 32); rq += __shfl_xor(rq, 32);
            if (lane < 16) { rb[lane * 16 + F.wave] = rs; rb[lane * 16 + 8 + F.wave] = rq; }
        } else {
#pragma unroll
            for (int t = 0; t < T; ++t) { const float s = wave_sum(o0[t] + o1[t]), q = wave_sum(o0[t] * o0[t] + o1[t] * o1[t]); if (lane == 0) { rb[t * 16 + F.wave] = s; rb[t * 16 + 8 + F.wave] = q; } }
        }
        __syncthreads();
        bf16* cvp = CV + (size_t)(row0 + tile * T) * 1024 + 2 * tid;
        float meanv, rstdv;
        { const int tl = lane & (T - 1);
          const f32x4 s0 = *(const LAS f32x4*)(rb + tl * 16), s1 = *(const LAS f32x4*)(rb + tl * 16 + 4), q0 = *(const LAS f32x4*)(rb + tl * 16 + 8), q1 = *(const LAS f32x4*)(rb + tl * 16 + 12);
          const float s = ((s0.x + s0.y) + (s0.z + s0.w)) + ((s1.x + s1.y) + (s1.z + s1.w)), q = ((q0.x + q0.y) + (q0.z + q0.w)) + ((q1.x + q1.y) + (q1.z + q1.w));
          meanv = s * (1.0f / 1024.0f); const float var = fmaxf(q * (1.0f / 1024.0f) - meanv * meanv, 0.f); rstdv = __builtin_amdgcn_rsqf(var + EPS); }
#pragma unroll
        for (int t = 0; t < T; ++t) {
            const float mean = __builtin_bit_cast(float, __builtin_amdgcn_readlane(__builtin_bit_cast(int, meanv), t)), rstd = __builtin_bit_cast(float, __builtin_amdgcn_readlane(__builtin_bit_cast(int, rstdv), t));
            *(unsigned*)(cvp + (size_t)t * 1024) = pk2(siluf_((o0[t] - mean) * rstd * lw.x + lb.x), siluf_((o1[t] - mean) * rstd * lw.y + lb.y));
            asm volatile("" ::: "memory");
        }
        if (tile + 1 < NT) {
#pragma unroll
            for (int k = 0; k < 30; ++k) xv[k] = xv[k + T];
#pragma unroll
            for (int k = 0; k < T; ++k) xv[30 + k] = (cf32x2){bflo(nx[k]), bfhi(nx[k])};
        }
    }
    __syncthreads();
}
constexpr int CCONV_RUNS = NBP * (SEQ / 64);
__device__ __forceinline__ void cconv_phase(Frame& F) {
    for (int b = (int)blockIdx.x; b < NBS; b += F.G) cconv_run<8, 1, true>(F, MP + 8 * b, false, F.inp(6) + (size_t)b * 30 * 1024);
    for (int u = F.vcu; u < CCONV_RUNS; u += F.G) { const int b = u >> 5, j = u & 31; cconv_run<16, 4, false>(F, b * SEQ + 64 * j, j > 0, nullptr); }
    { const bool split = (int)F.G >= 2 * NBS;
      constexpr int P9_SMALL = NBS * NWAVES;
      __syncthreads();
      if (!split) p0_weights(F, P0_PW1_ITEMS, P0_ALL_ITEMS);
      else if ((int)blockIdx.x < NBS) p0_weights(F, P0_PW1_ITEMS, P0_PW1_ITEMS + P9_SMALL, (int)blockIdx.x * NWAVES + F.wave, NBS * NWAVES);
      else p0_weights(F, P0_PW1_ITEMS + P9_SMALL, P0_ALL_ITEMS, ((int)blockIdx.x - NBS) * NWAVES + F.wave, ((int)F.G - NBS) * NWAVES);
      __syncthreads(); }
    for (int b = (int)F.G - 1 - (int)blockIdx.x; b < NBS; b += F.G) { const float* st = F.inp(6) + (size_t)b * 30 * 1024;
        for (int i = F.tid; i < 22 * 256; i += NWAVES * 64) __builtin_nontemporal_store(__builtin_nontemporal_load(&((const f32x4*)(st + 8 * 1024))[i]), &((f32x4*)(F.out + O_SCC + (size_t)b * 30 * 1024))[i]);
    }
}
#define P2_WEIGHTS() do { __syncthreads(); p0_weights(F, P0_WIN_ITEMS, P0_GO_ITEMS); __syncthreads(); } while (0)
#define PHASE2_BODY { \
    const bool wfirst = ((bx >> 4) & 1) != 0; \
    if (wfirst) P2_WEIGHTS(); \
    if ((bx >> 3) & 1) { for (int u = bx; u < 512; u += F.G) ssd_sample_unit(F, u); TSTAMP(); } \
    { S5Consts K5; int kg = -1; for (int u = bx; u < S5_UNITS; u += F.G) s5_block_unit(F, u, K5, kg); } \
    __syncthreads(); TSTAMP(); \
    if (!wfirst) P2_WEIGHTS(); \
    for (int u = bx; u < 512; u += F.G) ssd_state_unit(F, u); TSTAMP(); \
    if (!((bx >> 3) & 1)) { for (int u = bx; u < 512; u += F.G) ssd_sample_unit(F, u); TSTAMP(); } }
#define PHASE3_BODY { ssd_carry(F); }
#define PHASE4_GLU() do { \
        { const int _pre = (F.vcu & 1); pg8::gemm_tail<pg8::EpiGlu>(lds_s + RING_OFF, g.A + (size_t)MP * g.lda, g.lda, g.Bt, g.K, g.N / 64, E, F.vcu, F.G, 0, _pre); } \
        pg8::gemm_phase<pg8::EpiGlu, pg8::StaticOrder, true, true>(lds_s + RING_OFF, g, S, E); \
        { const int _pre = (F.vcu & 1); pg8::gemm_tail<pg8::EpiGlu>(lds_s + RING_OFF, g.A + (size_t)MP * g.lda, g.lda, g.Bt, g.K, g.N / 64, E, F.vcu, F.G, _pre, 1); } } while (0)
#define PHASE4_BODY { \
    pg8::Gemm g{U, (const bf16*)(F.ws + WS_WGLU), MT, 1024, 1024, 1024}; pg8::StaticOrder S; S.init(MP, 1024, F.G, bx); \
    pg8::EpiGlu E{U, CAT, F.inp(26)}; \
    const bool glu_first = ((F.vcu >> 1) & 1) != 0;                        \
    if (!glu_first) { __syncthreads(); p0_weights(F, P0_L0_ITEMS, P0_PW1_ITEMS); __syncthreads(); }        \
    if (glu_first) PHASE4_GLU(); \
    for (int u = bx; u < 512; u += F.G) ssd_y_unit(F, u); TSTAMP(); \
    if (glu_first) { __syncthreads(); p0_weights(F, P0_L0_ITEMS, P0_PW1_ITEMS); __syncthreads(); } \
    if (!glu_first) PHASE4_GLU(); \
    TSTAMP(); }
#define PHASE9_BODY { cconv_phase(F); }
struct Args { const float* in[38]; float* out; unsigned char* ws; int ph_lo, ph_hi; };
constexpr int N_PHASES = 14;

__global__ void __launch_bounds__(NWAVES * 64, 2) hybrid_fwd(Args args) {
    extern __shared__ __attribute__((aligned(16))) unsigned char lds[];
    Frame F;
    { unsigned vz; asm volatile("v_mov_b32 %0, 0" : "=v"(vz)); F.lds = (LAS unsigned char*)lds + vz; }
    LAS unsigned char* const lds_s = (LAS unsigned char*)lds;
    F.MISC = (volatile LAS unsigned*)(F.lds + MISC_OFF);
    F.tid = threadIdx.x; F.lane = F.tid & 63; F.wave = __builtin_amdgcn_readfirstlane(F.tid >> 6);
    F.G = gridDim.x; { const int bx = blockIdx.x; F.vcu = (F.G % 8 == 0) ? (bx % 8) * (F.G / 8) + bx / 8 : bx; }
    F.ws = args.ws; F.out = args.out; F.ctl = (gu32*)(args.ws + WS_CTL);
    F.in = (LAS cfp*)(F.lds + PTRTAB_OFF);
    for (int u = F.tid; u < (LDS_BYTES - LDSCTL_OFF) / 4; u += NWAVES * 64) ((LAS unsigned*)(F.lds + LDSCTL_OFF))[u] = 0u;
    __syncthreads();
    if (F.tid < 38) F.in[F.tid] = args.in[F.tid];
    __syncthreads();
    XcdBarrier bar = xcd_barrier_post((unsigned*)(F.ctl + CW_BAR), F.MISC + 8);
    const int lo = args.ph_lo, hi = args.ph_hi;
#define IN(k) (lo <= (k) && (k) < hi)
#if defined(MK_TIMING)
    volatile LAS unsigned* TS = (volatile LAS unsigned*)(F.lds + LDSCTL_OFF);
    F.nts = 0;
#define TSTAMP() FSTAMP(F)
#define SEAM(k) do { if (IN(k) && IN((k) + 1)) xcd_barrier(bar); TSTAMP(); } while (0)
    TSTAMP();
#else
#define TSTAMP() do {} while (0)
#define SEAM(k) do { if (IN(k) && IN((k) + 1)) xcd_barrier(bar); } while (0)
#endif

    bf16* CAT = (bf16*)(F.ws + WS_CAT); bf16* XBC = (bf16*)(F.ws + WS_XBC); bf16* U = (bf16*)(F.ws + WS_U); bf16* XB = (bf16*)(F.ws + WS_XB);
    bf16* H = (bf16*)(F.ws + WS_H); bf16* Gb = (bf16*)(F.ws + WS_G); bf16* CV = (bf16*)(F.ws + WS_CV);
    float* SS = (float*)(F.ws + WS_SS); float* X = F.out + O_Y;
    const int bx = (int)blockIdx.x;

    if (IN(0)) { p0_prologue(F); } SEAM(0);
    if (IN(1)) {
        pg8::Gemm g{CAT + 1024, (const bf16*)(F.ws + WS_WIN), MT, 4096, 1024, 2048}; pg8::StaticOrder S; S.init(MP, 4096, F.G, bx);
        pg8::EpiInProj E{CAT, XBC, U, SS, F.out, (bf16*)(F.ws + WS_HALO)};
        if ((F.vcu & 1)) pg8::gemm_tail_wide<4, pg8::EpiInProj>(lds_s + RING_OFF, g.A + (size_t)MP * g.lda, g.lda, g.Bt, g.K, E, F.vcu, F.G);
        pg8::gemm_phase<pg8::EpiInProj, pg8::StaticOrder, true, true>(lds_s + RING_OFF, g, S, E, SS); TSTAMP();
        if (!(F.vcu & 1)) pg8::gemm_tail_wide<4, pg8::EpiInProj>(lds_s + RING_OFF, g.A + (size_t)MP * g.lda, g.lda, g.Bt, g.K, E, F.vcu, F.G);
    } SEAM(1);
    if (IN(2)) { PHASE2_BODY } SEAM(2);
    if (IN(3)) { PHASE3_BODY } SEAM(3);
    if (IN(4)) { PHASE4_BODY } SEAM(4);
    if (IN(5)) {
        pg8::Gemm g{CAT, (const bf16*)(F.ws + WS_WOUT), MT, 1024, 2048, 2048}; pg8::StaticOrder S; S.init(MP, 1024, F.G, bx);
        pg8::EpiRes E{F.inp(0), F.inp(1), nullptr, nullptr, XB, SS, nullptr};
        { const int _n = (g.N / 64) * 16 / F.G, _pre = (_n == 1) ? (F.vcu & 1) : ((_n * (F.vcu & 3)) >> 2); pg8::gemm_tail<pg8::EpiRes>(lds_s + RING_OFF, g.A + (size_t)MP * g.lda, g.lda, g.Bt, g.K, g.N / 64, E, F.vcu, F.G, 0, _pre); }
        pg8::gemm_phase<pg8::EpiRes, pg8::StaticOrder, true, true>(lds_s + RING_OFF, g, S, E); TSTAMP();
        { const int _n = (g.N / 64) * 16 / F.G, _pre = (_n == 1) ? (F.vcu & 1) : ((_n * (F.vcu & 3)) >> 2); pg8::gemm_tail<pg8::EpiRes>(lds_s + RING_OFF, g.A + (size_t)MP * g.lda, g.lda, g.Bt, g.K, g.N / 64, E, F.vcu, F.G, _pre, _n); }
        if (!(F.vcu & 1)) { __syncthreads(); p0_weights(F, P0_GO_ITEMS, P0_FF10_ITEMS, (F.vcu >> 1) * NWAVES + F.wave, (int)(F.G >> 1) * NWAVES); __syncthreads(); }
    } SEAM(5);
    if (IN(6)) {
        pg8::Gemm g{XB, (const bf16*)(F.ws + WS_WFF1), MT, FF, 1024, 1024}; pg8::StaticOrder S; S.init(MP, FF, F.G, bx);
        pg8::EpiFF1 E{H, SS};
        if ((F.vcu & 1)) pg8::gemm_tail_wide<4, pg8::EpiFF1>(lds_s + RING_OFF, g.A + (size_t)MP * g.lda, g.lda, g.Bt, g.K, E, F.vcu, F.G);
        pg8::gemm_phase<pg8::EpiFF1, pg8::StaticOrder, true, true>(lds_s + RING_OFF, g, S, E, SS); TSTAMP();
        if (!(F.vcu & 1)) pg8::gemm_tail_wide<4, pg8::EpiFF1>(lds_s + RING_OFF, g.A + (size_t)MP * g.lda, g.lda, g.Bt, g.K, E, F.vcu, F.G);
        if (!(F.vcu & 1)) { __syncthreads(); p0_weights(F, P0_FF10_ITEMS, P0_L0_ITEMS, (F.vcu >> 1) * NWAVES + F.wave, (int)(F.G >> 1) * NWAVES); __syncthreads(); }
    } SEAM(6);
    if (IN(7)) {
        pg8::Gemm g{H, (const bf16*)(F.ws + WS_WFF2), MT, 1024, FF, FF}; pg8::StaticOrder S; S.init(MP, 1024, F.G, bx);
        pg8::EpiRes E{nullptr, nullptr, XB, nullptr, XB, SS, nullptr};
        { const int _n = (g.N / 64) * 16 / F.G, _pre = (_n == 1) ? (F.vcu & 1) : ((_n * (F.vcu & 3)) >> 2); pg8::gemm_tail<pg8::EpiRes>(lds_s + RING_OFF, g.A + (size_t)MP * g.lda, g.lda, g.Bt, g.K, g.N / 64, E, F.vcu, F.G, 0, _pre); }
        pg8::gemm_phase<pg8::EpiRes, pg8::StaticOrder, true, true>(lds_s + RING_OFF, g, S, E); TSTAMP();
        { const int _n = (g.N / 64) * 16 / F.G, _pre = (_n == 1) ? (F.vcu & 1) : ((_n * (F.vcu & 3)) >> 2); pg8::gemm_tail<pg8::EpiRes>(lds_s + RING_OFF, g.A + (size_t)MP * g.lda, g.lda, g.Bt, g.K, g.N / 64, E, F.vcu, F.G, _pre, _n); }
    } SEAM(7);
    if (IN(8)) {
        pg8::Gemm g{XB, (const bf16*)(F.ws + WS_WPW1), MT, 2048, 1024, 1024}; pg8::StaticOrder S; S.init(MP, 2048, F.G, bx);
        pg8::EpiPw1 E{Gb, SS, F.inp(29), F.out};
        if ((F.vcu & 1)) pg8::gemm_tail_wide<2, pg8::EpiPw1>(lds_s + RING_OFF, g.A + (size_t)MP * g.lda, g.lda, g.Bt, g.K, E, F.vcu, F.G);
        pg8::gemm_phase<pg8::EpiPw1, pg8::StaticOrder, true, true>(lds_s + RING_OFF, g, S, E, SS); TSTAMP();
        if (!(F.vcu & 1)) pg8::gemm_tail_wide<2, pg8::EpiPw1>(lds_s + RING_OFF, g.A + (size_t)MP * g.lda, g.lda, g.Bt, g.K, E, F.vcu, F.G);
    } SEAM(8);
    if (IN(9)) { PHASE9_BODY } SEAM(9);
    if (IN(10)) {
        pg8::Gemm g{CV, (const bf16*)(F.ws + WS_WPW2), MT, 1024, 1024, 1024}; pg8::StaticOrder S; S.init(MP, 1024, F.G, bx);
        pg8::EpiRes E{nullptr, nullptr, XB, nullptr, XB, SS, F.inp(35)};
        { const int _n = (g.N / 64) * 16 / F.G, _pre = (_n == 1) ? (F.vcu & 1) : ((_n * (F.vcu & 3)) >> 2); pg8::gemm_tail<pg8::EpiRes>(lds_s + RING_OFF, g.A + (size_t)MP * g.lda, g.lda, g.Bt, g.K, g.N / 64, E, F.vcu, F.G, 0, _pre); }
        pg8::gemm_phase<pg8::EpiRes, pg8::StaticOrder, true, true>(lds_s + RING_OFF, g, S, E); TSTAMP();
        { const int _n = (g.N / 64) * 16 / F.G, _pre = (_n == 1) ? (F.vcu & 1) : ((_n * (F.vcu & 3)) >> 2); pg8::gemm_tail<pg8::EpiRes>(lds_s + RING_OFF, g.A + (size_t)MP * g.lda, g.lda, g.Bt, g.K, g.N / 64, E, F.vcu, F.G, _pre, _n); }
    } SEAM(10);
    if (IN(11)) {
        pg8::Gemm g{XB, (const bf16*)(F.ws + WS_WFF1) + (size_t)FF * 1024, MT, FF, 1024, 1024}; pg8::StaticOrder S; S.init(MP, FF, F.G, bx);
        pg8::EpiFF1 E{H, SS};
        if ((F.vcu & 1)) pg8::gemm_tail_wide<4, pg8::EpiFF1>(lds_s + RING_OFF, g.A + (size_t)MP * g.lda, g.lda, g.Bt, g.K, E, F.vcu, F.G);
        pg8::gemm_phase<pg8::EpiFF1, pg8::StaticOrder, true, true>(lds_s + RING_OFF, g, S, E, SS); TSTAMP();
        if (!(F.vcu & 1)) pg8::gemm_tail_wide<4, pg8::EpiFF1>(lds_s + RING_OFF, g.A + (size_t)MP * g.lda, g.lda, g.Bt, g.K, E, F.vcu, F.G);
    } SEAM(11);
    if (IN(12)) {
        pg8::Gemm g{H, (const bf16*)(F.ws + WS_WFF2) + (size_t)1024 * FF, MT, 1024, FF, FF}; pg8::StaticOrder S; S.init(MP, 1024, F.G, bx);
        pg8::EpiRes E{nullptr, nullptr, XB, nullptr, XB, SS, nullptr};
        { const int _n = (g.N / 64) * 16 / F.G, _pre = (_n == 1) ? (F.vcu & 1) : ((_n * (F.vcu & 3)) >> 2); pg8::gemm_tail<pg8::EpiRes>(lds_s + RING_OFF, g.A + (size_t)MP * g.lda, g.lda, g.Bt, g.K, g.N / 64, E, F.vcu, F.G, 0, _pre); }
        pg8::gemm_phase<pg8::EpiRes, pg8::StaticOrder, true, true>(lds_s + RING_OFF, g, S, E); TSTAMP();
        { const int _n = (g.N / 64) * 16 / F.G, _pre = (_n == 1) ? (F.vcu & 1) : ((_n * (F.vcu & 3)) >> 2); pg8::gemm_tail<pg8::EpiRes>(lds_s + RING_OFF, g.A + (size_t)MP * g.lda, g.lda, g.Bt, g.K, g.N / 64, E, F.vcu, F.G, _pre, _n); }
    } SEAM(12);
    if (IN(13)) {
        const int gw = F.vcu * NWAVES + F.wave, NGW = F.G * NWAVES; const float* nf = F.inp(9);
        f32x4 wv[4];
#pragma unroll
        for (int j = 0; j < 2; ++j) { wv[2 * j] = ((const f32x4*)nf)[128 * j + 2 * F.lane]; wv[2 * j + 1] = ((const f32x4*)nf)[128 * j + 2 * F.lane + 1]; }
        for (int m = gw; m < MT; m += NGW) {
            const float rs = row_rstd(SS, m);
            const v4u* xb = (const v4u*)(XB + (size_t)m * DM) + F.lane;
            f32x4* yr = (f32x4*)(X + (size_t)m * DM) + 2 * F.lane;
#pragma unroll
            for (int j = 0; j < 2; ++j) { const v4u w = __builtin_nontemporal_load(&xb[64 * j]);
                __builtin_nontemporal_store((f32x4){bflo(w.x), bfhi(w.x), bflo(w.y), bfhi(w.y)} * rs * wv[2 * j], &yr[128 * j]);
                __builtin_nontemporal_store((f32x4){bflo(w.z), bfhi(w.z), bflo(w.w), bfhi(w.w)} * rs * wv[2 * j + 1], &yr[128 * j + 1]); }
        }
    }
#if defined(MK_TIMING)
    TSTAMP();
    xcd_barrier(bar);
    if (blockIdx.x == 0) {
        __syncthreads();
#if defined(MK_COLDPROBE)
        { volatile unsigned* cwp = (volatile unsigned*)(F.ws + 65536 + 256); volatile unsigned* store = (volatile unsigned*)(F.ws + 65536 + 512);
          const bool cold = (*cwp == 0xAAAAAAAAu);
          __syncthreads();
          if (F.tid < 64) { if (cold) store[F.tid] = TS[F.tid]; else TS[F.tid] = store[F.tid]; }
          __syncthreads();
          if (F.tid == 0) *cwp = 0x12345678u;
          __syncthreads(); }
#endif
        const size_t offs[12] = {O_Y, O_Y + (size_t)MP * 1024, O_PAC, O_PAS, O_PBR, O_PBI, O_PCC, O_SAC, O_SAS, O_SBR, O_SBI, O_SCC};
#pragma unroll
        for (int k = 0; k < 12; ++k) {
            const unsigned t0 = TS[MK_TIMING + k], t1 = (MK_TIMING + k + 1 < F.nts) ? TS[MK_TIMING + k + 1] : t0;
#if defined(MK_DEBUGCNT)
            const unsigned us = __hip_atomic_load((unsigned*)(F.ws + WS_CTL) + 2048 + k, __ATOMIC_RELAXED, __HIP_MEMORY_SCOPE_AGENT);
#else
            const unsigned us = (t1 - t0) / 100u;
#endif
            for (unsigned i = F.tid; i < us; i += NWAVES * 64) ((unsigned*)F.out)[offs[k] + i] = 0xAAAAAAAAu;
        }
    }
#endif
#undef IN
#undef SEAM
}

extern "C" void kernel_launch(void* const* d_in, const int* in_sizes, int n_in, void* d_out, int out_size, void* d_ws, size_t ws_size, hipStream_t stream) {
    static int grid = 0;
    if (grid == 0) {
        if (n_in != 38 || out_size != (int)O_END || ws_size < WS_END) { fprintf(stderr, "kernel_launch: unexpected shapes: n_in %d out %d ws %zu\n", n_in, out_size, ws_size); grid = -1; return; }
        int dev = 0, cus = 0, per_cu = 0;
        if (hipGetDevice(&dev) != hipSuccess || hipDeviceGetAttribute(&cus, hipDeviceAttributeMultiprocessorCount, dev) != hipSuccess) { grid = -1; return; }
        if (hipFuncSetAttribute((const void*)hybrid_fwd, hipFuncAttributeMaxDynamicSharedMemorySize, LDS_BYTES) != hipSuccess) { fprintf(stderr, "kernel_launch: hipFuncSetAttribute failed\n"); grid = -1; return; }
        if (hipOccupancyMaxActiveBlocksPerMultiprocessor(&per_cu, (const void*)hybrid_fwd, NWAVES * 64, LDS_BYTES) != hipSuccess || per_cu < 1)
            fprintf(stderr, "kernel_launch: note: occupancy query reports %d blocks per CU\n", per_cu);
        (void)hipGetLastError();
        grid = cus;
    }
    if (grid < 0) return;
    if (hipMemsetAsync((char*)d_ws + WS_CTL, 0, CTL_ZERO_BYTES, stream) != hipSuccess) { fprintf(stderr, "kernel_launch: memset failed\n"); return; }
    Args a{};
    for (int i = 0; i < 38; ++i) a.in[i] = (const float*)d_in[i];
    a.out = (float*)d_out; a.ws = (unsigned char*)d_ws;
#if MK_N_LAUNCHES == 1
    a.ph_lo = 0; a.ph_hi = N_PHASES;
    hipLaunchKernelGGL(hybrid_fwd, dim3(grid), dim3(NWAVES * 64), LDS_BYTES, stream, a);
#else
    for (int p = 0; p < N_PHASES; ++p) { a.ph_lo = p; a.ph_hi = p + 1; hipLaunchKernelGGL(hybrid_fwd, dim3(grid), dim3(NWAVES * 64), LDS_BYTES, stream, a); }
#endif
    const hipError_t le = hipPeekAtLastError();
    if (le != hipSuccess) fprintf(stderr, "kernel_launch: launch failed: %s\n", hipGetErrorName(le));
}
```

```cpp
#include <hip/hip_runtime.h>
#include <cstdio>
#include <cstdint>
#ifndef MK_N_LAUNCHES
#define MK_N_LAUNCHES 1
#endif
__device__ __forceinline__ float row_rstd(const float* SS, int r);
namespace pg8 {
#define PG8_LAS __attribute__((address_space(3)))
typedef unsigned short bf16_t;
typedef short bf16x8 __attribute__((ext_vector_type(8)));
typedef float f32x4 __attribute__((ext_vector_type(4)));
typedef unsigned u32x4 __attribute__((ext_vector_type(4)));
typedef unsigned u32x2 __attribute__((ext_vector_type(2)));
constexpr int BM = 256, BK = 64, HALF = 128, HTB = HALF * BK * 2  , STAGE_BYTES = 8 * HTB, NXCD = 8, WGM = 8;

__host__ __device__ __forceinline__ int lds_byte(int r, int c) { const int st = (r >> 4) * 2 + (c >> 5), rr = r & 15, cc = c & 31, ob = rr * 64 + cc * 2; return st * 1024 + (ob ^ (((ob >> 9) & 1) << 5)); }
__host__ __device__ __forceinline__ void stage_rc(int b, int& R, int& C) { const int st = b / 1024, sb = b % 1024, swz = sb ^ (((sb >> 9) & 1) << 5); R = (st >> 1) * 16 + swz / 64; C = (st & 1) * 32 + (swz % 64) / 2; }
__host__ __device__ __forceinline__ int perm32(int rho) { const int n = rho >> 4, i = rho & 15; return 8 * (i >> 2) + 4 * n + (i & 3); }

struct Unit { int pm, pn; };
struct Gemm { const bf16_t* A; const bf16_t* Bt; int M, N, K, lda; };

struct StaticOrder {
    int nM, nN, nwg, G, c;
    __host__ __device__ void init(int M, int N, int G_, int c_) { nM = M / BM; nN = N / BM; nwg = nM * nN; G = G_; c = c_; }
    __host__ __device__ bool next(int i, Unit& u) const {
        const long L = (long)i * G + c; if (L >= nwg) return false;
        int wgid = (int)L; { const int q = nwg / NXCD, r = nwg % NXCD, xcd = wgid % NXCD, off = wgid / NXCD; wgid = (xcd < r ? xcd * (q + 1) : r * (q + 1) + (xcd - r) * q) + off; }
        const int nig = WGM * nN, gid = wgid / nig, fm = gid * WGM, gsz = (nM - fm) < WGM ? (nM - fm) : WGM;
        u.pm = fm + ((wgid % nig) % gsz); u.pn = (wgid % nig) / gsz; return true;
    }
};

__device__ __forceinline__ unsigned cvt_pk_bf16(float lo, float hi) { unsigned r; asm volatile("v_cvt_pk_bf16_f32 %0, %1, %2" : "=v"(r) : "v"(lo), "v"(hi)); return r; }

template <class Epi, class Sched, bool ALIGN_EPI = false, bool SP2 = false>
__device__ __forceinline__ void gemm_phase(PG8_LAS unsigned char* lds, const Gemm g, const Sched& S, const Epi& E, const float* SSp = nullptr) {
    const int tid = threadIdx.x, wid = __builtin_amdgcn_readfirstlane(tid >> 6), lane = tid & 63, wr = wid >> 2, wc = wid & 3, fr = lane & 15, fq = lane >> 4;
    const int K = g.K, nt = K / BK, lda = g.lda;
    unsigned voffA[2], voffB[2];
#pragma unroll
    for (int i = 0; i < 2; ++i) { int R, C; stage_rc(tid * 16 + i * 8192, R, C); const int Rb = (R >> 5) * 64 + perm32(R & 31);
        voffA[i] = (unsigned)(R * lda + C) * 2u; voffB[i] = (unsigned)(Rb * K + C) * 2u; }
    static_assert(Epi::PERM, "the column map assumes PERM epilogues");
    const size_t kstep = (size_t)(BK * 2);
    const size_t hA = (size_t)HALF * lda * 2, hB = (size_t)32 * K * 2;
    const size_t tA = 2 * hA, tB = (size_t)BM * K * 2;
    const unsigned ldsw = (unsigned)wid * 1024u;
    const int aoff = lds_byte(wr * 64 + fr, fq * 8), boff = lds_byte(wc * 32 + fr, fq * 8);
#define PG8_SA(b, h) (((b) * 2 + (h)) * HTB)
#define PG8_SB(b, h) ((4 + (b) * 2 + (h)) * HTB)
#define PG8_STAGE(bufoff, gbase, voff) do { _Pragma("unroll") for (int _i = 0; _i < 2; ++_i) \
        __builtin_amdgcn_global_load_lds((const unsigned*)((const char*)(gbase) + (voff)[_i]), (PG8_LAS unsigned*)(lds + (bufoff) + ldsw + _i * 8192), 16, 0, 0); } while (0)
#define PG8_LDA(dst, b, h) do { _Pragma("unroll") for (int m = 0; m < 4; ++m) _Pragma("unroll") for (int k = 0; k < 2; ++k) dst[m][k] = *(const PG8_LAS bf16x8*)(lds + PG8_SA(b, h) + aoff + m * 2048 + k * 1024); } while (0)
#define PG8_LDB(dst, b, h) do { _Pragma("unroll") for (int n = 0; n < 2; ++n) _Pragma("unroll") for (int k = 0; k < 2; ++k) dst[n][k] = *(const PG8_LAS bf16x8*)(lds + PG8_SB(b, h) + boff + n * 2048 + k * 1024); } while (0)
#define PG8_MMA(ai, bj, At, Bt) do { __builtin_amdgcn_s_setprio(1); _Pragma("unroll") for (int m = 0; m < 4; ++m) _Pragma("unroll") for (int n = 0; n < 2; ++n) _Pragma("unroll") for (int k = 0; k < 2; ++k) \
        acc[ai][bj][m][n] = __builtin_amdgcn_mfma_f32_16x16x32_bf16(Bt[n][k], At[m][k], acc[ai][bj][m][n], 0, 0, 0); __builtin_amdgcn_s_setprio(0); } while (0)
#define PG8_WAIT_V(n) asm volatile("s_waitcnt vmcnt(" #n ")" ::: "memory")
#define PG8_WAIT_L(n) asm volatile("s_waitcnt lgkmcnt(" #n ")" ::: "memory")
#define PG8_BAR __builtin_amdgcn_s_barrier()
#define PG8_SCHED __builtin_amdgcn_sched_barrier(0)
    Unit cur, nxt; int ui = 0;
    if (!S.next(0, cur)) return;
    PG8_LAS float* RS = (PG8_LAS float*)(lds + STAGE_BYTES);
    if (SSp) {
#pragma unroll
        for (int j = 0; j < 2; ++j) { const int uj = (tid >> 8) + 2 * j; Unit uu;
            if (S.next(uj, uu)) RS[uj * 256 + (tid & 255)] = row_rstd(SSp, uu.pm * BM + (tid & 255)); }
        asm volatile("s_waitcnt vmcnt(0) lgkmcnt(0)" ::: "memory"); __builtin_amdgcn_s_barrier(); asm volatile("" ::: "memory");
    }
    f32x4 acc[2][2][4][2];
#pragma unroll
    for (int a = 0; a < 2; ++a)
#pragma unroll
        for (int b = 0; b < 2; ++b)
#pragma unroll
            for (int m = 0; m < 4; ++m)
#pragma unroll
                for (int n = 0; n < 2; ++n) acc[a][b][m][n] = (f32x4){0.f, 0.f, 0.f, 0.f};
    bf16x8 At[4][2], B0[2][2], B1[2][2];
    const char* cA = (const char*)g.A + (size_t)cur.pm * tA; const char* cB = (const char*)g.Bt + (size_t)cur.pn * tB;
    if constexpr (SP2) {
        PG8_STAGE(PG8_SB(0, 0), cB, voffB); PG8_STAGE(PG8_SB(0, 1), cB + hB, voffB); PG8_STAGE(PG8_SA(0, 0), cA, voffA); PG8_STAGE(PG8_SA(0, 1), cA + hA, voffA);
        if (wr == 1) PG8_BAR;
        PG8_WAIT_V(2); PG8_BAR;
        PG8_STAGE(PG8_SB(1, 0), cB + kstep, voffB); PG8_STAGE(PG8_SA(1, 0), cA + kstep, voffA); PG8_STAGE(PG8_SB(1, 1), cB + hB + kstep, voffB);
        PG8_WAIT_V(6); PG8_BAR;
    } else {
        PG8_STAGE(PG8_SB(0, 0), cB, voffB); PG8_STAGE(PG8_SA(0, 0), cA, voffA); PG8_STAGE(PG8_SB(0, 1), cB + hB, voffB); PG8_STAGE(PG8_SA(0, 1), cA + hA, voffA);
        if (wr == 1) PG8_BAR;
        PG8_WAIT_V(4); PG8_BAR;
        PG8_STAGE(PG8_SB(1, 0), cB + kstep, voffB); PG8_STAGE(PG8_SA(1, 0), cA + kstep, voffA); PG8_STAGE(PG8_SB(1, 1), cB + hB + kstep, voffB);
        PG8_WAIT_V(6); PG8_BAR;
    }
    for (;;) {
        const bool has_next = S.next(ui + 1, nxt);
        const char* nA = has_next ? (const char*)g.A + (size_t)nxt.pm * tA : cA; const char* nB = has_next ? (const char*)g.Bt + (size_t)nxt.pn * tB : cB;
        for (int t = 0; t < nt; t += 2) {
            const bool last = (t == nt - 2);
            const char* a1 = cA + (size_t)(t + 1) * kstep;
            const char* a2 = last ? nA : cA + (size_t)(t + 2) * kstep; const char* b2 = last ? nB : cB + (size_t)(t + 2) * kstep;
            const char* a3 = a2 + kstep; const char* b3 = b2 + kstep;
            if constexpr (SP2) {
            PG8_LDB(B0, 0, 0); PG8_LDB(B1, 0, 1); PG8_SCHED; PG8_LDA(At, 0, 0); PG8_STAGE(PG8_SA(1, 1), a1 + hA, voffA);
            PG8_WAIT_V(8); PG8_WAIT_L(0); PG8_BAR; PG8_MMA(0, 0, At, B0); PG8_MMA(0, 1, At, B1); PG8_BAR; PG8_SCHED;
            PG8_LDA(At, 0, 1); PG8_STAGE(PG8_SB(0, 0), b2, voffB); PG8_STAGE(PG8_SB(0, 1), b2 + hB, voffB); PG8_STAGE(PG8_SA(0, 0), a2, voffA);
            PG8_WAIT_V(8); PG8_WAIT_L(0); PG8_BAR; PG8_MMA(1, 0, At, B0); PG8_MMA(1, 1, At, B1); PG8_BAR; PG8_SCHED;
            PG8_LDB(B0, 1, 0); PG8_LDB(B1, 1, 1); PG8_SCHED; PG8_LDA(At, 1, 0); PG8_STAGE(PG8_SA(0, 1), a2 + hA, voffA);
            PG8_WAIT_V(8); PG8_WAIT_L(0); PG8_BAR; PG8_MMA(0, 0, At, B0); PG8_MMA(0, 1, At, B1); PG8_BAR; PG8_SCHED;
            PG8_LDA(At, 1, 1); PG8_STAGE(PG8_SB(1, 0), b3, voffB); PG8_STAGE(PG8_SB(1, 1), b3 + hB, voffB); PG8_STAGE(PG8_SA(1, 0), a3, voffA);
            PG8_WAIT_V(8); PG8_WAIT_L(0); PG8_BAR; PG8_MMA(1, 0, At, B0); PG8_MMA(1, 1, At, B1); PG8_BAR; PG8_SCHED;
            } else {
            PG8_LDB(B0, 0, 0); PG8_SCHED; PG8_LDA(At, 0, 0); PG8_STAGE(PG8_SA(1, 1), a1 + hA, voffA);
            PG8_WAIT_L(8); PG8_BAR; PG8_WAIT_L(0); PG8_MMA(0, 0, At, B0); PG8_BAR; PG8_SCHED;
            PG8_LDB(B1, 0, 1); PG8_STAGE(PG8_SB(0, 0), b2, voffB);
            PG8_BAR; PG8_WAIT_L(0); PG8_MMA(0, 1, At, B1); PG8_BAR;
            PG8_LDA(At, 0, 1); PG8_STAGE(PG8_SA(0, 0), a2, voffA);
            PG8_BAR; PG8_WAIT_L(0); PG8_MMA(1, 0, At, B0); PG8_BAR; PG8_SCHED;
            PG8_STAGE(PG8_SB(0, 1), b2 + hB, voffB);
            PG8_WAIT_V(6); PG8_BAR; PG8_MMA(1, 1, At, B1); PG8_BAR;
            PG8_LDB(B0, 1, 0); PG8_SCHED; PG8_LDA(At, 1, 0); PG8_STAGE(PG8_SA(0, 1), a2 + hA, voffA);
            PG8_WAIT_L(8); PG8_BAR; PG8_WAIT_L(0); PG8_MMA(0, 0, At, B0); PG8_BAR; PG8_SCHED;
            PG8_LDB(B1, 1, 1); PG8_STAGE(PG8_SB(1, 0), b3, voffB);
            PG8_BAR; PG8_WAIT_L(0); PG8_MMA(0, 1, At, B1); PG8_BAR;
            PG8_LDA(At, 1, 1); PG8_STAGE(PG8_SA(1, 0), a3, voffA);
            PG8_BAR; PG8_WAIT_L(0); PG8_MMA(1, 0, At, B0); PG8_BAR; PG8_SCHED;
            PG8_STAGE(PG8_SB(1, 1), b3 + hB, voffB);
            PG8_WAIT_V(6); PG8_BAR; PG8_MMA(1, 1, At, B1); PG8_BAR;
            }
        }
        if constexpr (ALIGN_EPI) { if (wr == 0) PG8_BAR; }
        E(acc, cur, wr, wc, fr, fq, RS + (ui & 3) * 256);
        if (!has_next) break;
#pragma unroll
        for (int a = 0; a < 2; ++a)
#pragma unroll
            for (int b = 0; b < 2; ++b)
#pragma unroll
                for (int m = 0; m < 4; ++m)
#pragma unroll
                    for (int n = 0; n < 2; ++n) acc[a][b][m][n] = (f32x4){0.f, 0.f, 0.f, 0.f};
        cur = nxt; cA = nA; cB = nB; ++ui;
        if constexpr (ALIGN_EPI) { if (wr == 1) PG8_BAR; }
    }
    PG8_WAIT_V(0);
    if constexpr (!ALIGN_EPI) { if (wr == 0) PG8_BAR; }
    PG8_BAR;
#undef PG8_SA
#undef PG8_SB
#undef PG8_STAGE
#undef PG8_LDA
#undef PG8_LDB
#undef PG8_MMA
#undef PG8_WAIT_V
#undef PG8_WAIT_L
#undef PG8_BAR
#undef PG8_SCHED
}
}
constexpr int NWAVES = 8;
constexpr int DM = 1024, NBP = 8, SEQ = 2048, MP = NBP * SEQ, NBS = 128, DSEQ = 8, MS = NBS * DSEQ, MT = MP + MS;
constexpr int AH = 16, AP = 64, AG = 4, AN = 128, ACD = 2048, INC = 4112, FF = 4096, CWID = 31;
constexpr float EPS = 1e-6f;
constexpr size_t O_Y = 0, O_PAC = 17825792, O_PAS = 17874944, O_PBR = 18923520, O_PBI = 18956288, O_PCC = 18989056,
                 O_SAC = 19234816, O_SAS = 20021248, O_SBR = 36798464, O_SBI = 37322752, O_SCC = 37847040, O_END = 41779200;
constexpr size_t MiB = 1u << 20;
constexpr size_t WS_CTL = 0, CTL_ZERO_BYTES = 64 * 1024;
constexpr size_t WS_SS = 1 * MiB;
constexpr size_t WS_DT = 3 * MiB;
constexpr size_t WS_DA = 5 * MiB;
constexpr size_t WS_WDT = 7 * MiB;
constexpr size_t WS_W = 8 * MiB;
constexpr size_t WS_WIN = WS_W, WS_WGLU = WS_WIN + 8 * MiB, WS_WOUT = WS_WGLU + 2 * MiB, WS_WFF1 = WS_WOUT + 4 * MiB, WS_WFF2 = WS_WFF1 + 16 * MiB,
                 WS_WPW1 = WS_WFF2 + 16 * MiB, WS_WPW2 = WS_WPW1 + 4 * MiB, WS_WEND = WS_WPW2 + 2 * MiB;
constexpr size_t WS_CAT = 60 * MiB;
constexpr size_t WS_XBC = 128 * MiB;
constexpr size_t WS_U = 196 * MiB;
constexpr size_t WS_XB = WS_U;
constexpr size_t WS_H = 60 * MiB;
constexpr size_t WS_G = 60 * MiB;
constexpr size_t WS_CV = 94 * MiB;
constexpr size_t WS_END = 256 * MiB;
static_assert(WS_WEND == 60 * MiB, "weights end");
constexpr int CW_BAR = 4096;

constexpr int RING_OFF = 0, RING_BYTES = 131072;
constexpr int LDS_BYTES = 155648;
constexpr int LDSCTL_OFF = LDS_BYTES - 1024, MISC_OFF = LDSCTL_OFF + 320, PTRTAB_OFF = LDSCTL_OFF + 512;

#define GAS __attribute__((address_space(1)))
#define LAS __attribute__((address_space(3)))
typedef unsigned short bf16;
typedef unsigned v4u __attribute__((ext_vector_type(4)));
typedef unsigned v2u __attribute__((ext_vector_type(2)));
typedef float f32x4 __attribute__((ext_vector_type(4)));
typedef float f32x16 __attribute__((ext_vector_type(16)));
typedef short bf16x8 __attribute__((ext_vector_type(8)));
typedef GAS unsigned gu32;
#define RLX_AGENT __ATOMIC_RELAXED, __HIP_MEMORY_SCOPE_AGENT
#define LDS_WAIT() asm volatile("s_waitcnt lgkmcnt(0)" ::: "memory")
#define VM_WAIT() asm volatile("s_waitcnt vmcnt(0)" ::: "memory")
__device__ __forceinline__ unsigned f2bf(float f) { unsigned r; asm("v_cvt_pk_bf16_f32 %0, %1, %1" : "=v"(r) : "v"(f)); return r & 0xffffu; }
__device__ __forceinline__ unsigned pk2(float lo, float hi) { unsigned r; asm("v_cvt_pk_bf16_f32 %0, %1, %2" : "=v"(r) : "v"(lo), "v"(hi)); return r; }
__device__ __forceinline__ unsigned f2bf_int(float f) { const unsigned u = __builtin_bit_cast(unsigned, f); return (u + 0x7fffu + ((u >> 16) & 1u)) >> 16; }
__device__ __forceinline__ float bf2f(unsigned short b) { return __builtin_bit_cast(float, ((unsigned)b) << 16); }
__device__ __forceinline__ float bflo(unsigned w) { return __builtin_bit_cast(float, w << 16); }
__device__ __forceinline__ float bfhi(unsigned w) { return __builtin_bit_cast(float, w & 0xffff0000u); }
__device__ __forceinline__ float frcp_(float x) { return __builtin_amdgcn_rcpf(x); }
__device__ __forceinline__ float sigmoidf_(float x) { return frcp_(1.0f + __builtin_amdgcn_exp2f(-1.4426950408889634f * x)); }
__device__ __forceinline__ float siluf_(float x) { return x * frcp_(1.0f + __builtin_amdgcn_exp2f(-1.4426950408889634f * x)); }

#define XB_TMO      128
#define XB_XCNT(j)  (256  + 64 * (j))
#define XB_XSUB(j)  (1280 + 64 * (j))
#define XB_XGEN(j)  (2304 + 64 * (j))
#define XB_TOP      3328
#define XB_TOPGEN   3392
#define XCD_BAR_WORDS 3456
#define XB_SPIN_CAP (1u << 20)
__device__ __forceinline__ unsigned xb_ld(unsigned* p)              { return __hip_atomic_load(p, __ATOMIC_RELAXED, __HIP_MEMORY_SCOPE_AGENT); }
__device__ __forceinline__ unsigned xb_add(unsigned* p, unsigned v) { return __hip_atomic_fetch_add(p, v, __ATOMIC_RELAXED, __HIP_MEMORY_SCOPE_AGENT); }
__device__ __forceinline__ unsigned xb_xcc_id() { return (unsigned)__builtin_amdgcn_s_getreg((3 << 11) | 20) & 0xFu; }
#define XB_SPIN(cond, bar) do { unsigned _sp = 0; while (cond) { __builtin_amdgcn_s_sleep(1); \
    if ((++_sp & 255u) == 0u) { if (xb_ld(&(bar)[XB_TMO])) break; if (_sp > XB_SPIN_CAP) { atomicAdd(&(bar)[XB_TMO], 1u); break; } } } } while (0)
struct XcdBarrier { unsigned* bar; unsigned x; volatile LAS unsigned* st; };
__device__ __forceinline__ XcdBarrier xcd_barrier_post(unsigned* bar, volatile LAS unsigned* st) {
    XcdBarrier b; b.bar = bar; b.x = xb_xcc_id(); b.st = st;
    if (threadIdx.x == 0) (void)xb_add(&bar[XB_XCNT(b.x)], 1u);
    return b;
}
__device__ __forceinline__ void xcd_barrier_complete(unsigned* bar, unsigned x, unsigned& nloc, unsigned& nx) {
    const unsigned G = gridDim.x * gridDim.y * gridDim.z;
    unsigned sum, cnt, mine, sp = 0u;
    for (;;) {
        sum = 0u; cnt = 0u; mine = 0u;
#pragma unroll
        for (unsigned j = 0; j < 16; ++j) { const unsigned c = xb_ld(&bar[XB_XCNT(j)]); sum += c; cnt += (c > 0u) ? 1u : 0u; mine = (j == x) ? c : mine; }
        if (sum == G) break;
        __builtin_amdgcn_s_sleep(1);
        if ((++sp & 255u) == 0u) { if (xb_ld(&bar[XB_TMO])) break; if (sp > XB_SPIN_CAP) { atomicAdd(&bar[XB_TMO], 1u); break; } }
    }
    nloc = mine > 0u ? mine : 1u; nx = cnt > 0u ? cnt : 1u;
}
__device__ __forceinline__ void xcd_barrier(const XcdBarrier& b) {
    asm volatile("s_waitcnt vmcnt(0)" ::: "memory");
    __syncthreads();
    if (threadIdx.x == 0) {
        unsigned* bar = b.bar;
        __builtin_amdgcn_s_waitcnt(0);
        unsigned nloc = b.st[0], nx = b.st[1];
        if (nloc == 0u) { xcd_barrier_complete(bar, b.x, nloc, nx); b.st[0] = nloc; b.st[1] = nx; }
        const unsigned old = xb_add(&bar[XB_XSUB(b.x)], 1u);
        const unsigned gen = old / nloc;
        if (old + 1u == (gen + 1u) * nloc) {
            __builtin_amdgcn_fence(__ATOMIC_RELEASE, "agent");
            asm volatile("s_waitcnt vmcnt(0)" ::: "memory");
            const unsigned og = xb_add(&bar[XB_TOP], 1u);
            const unsigned tg = og / nx;
            if (og + 1u == (tg + 1u) * nx) xb_add(&bar[XB_TOPGEN], 1u);
            else XB_SPIN(xb_ld(&bar[XB_TOPGEN]) == tg, bar);
            __builtin_amdgcn_fence(__ATOMIC_ACQUIRE, "agent");
            xb_add(&bar[XB_XGEN(b.x)], 1u);
            asm volatile("s_waitcnt vmcnt(0)" ::: "memory");
        } else {
            XB_SPIN(xb_ld(&bar[XB_XGEN(b.x)]) == gen, bar);
            __builtin_amdgcn_fence(__ATOMIC_ACQUIRE, "agent");
            asm volatile("s_waitcnt vmcnt(0)" ::: "memory");
        }
    }
    __syncthreads();
}

typedef const float* cfp;
struct Frame {
    LAS unsigned char* lds;
    volatile LAS unsigned* MISC;
    gu32* ctl;
    int tid, lane, wave;
    int vcu, G;
    LAS cfp* in;
    float* out;
    unsigned char* ws;
    int nts;
    __device__ __forceinline__ const float* inp(int k) const { return (const float*)(const GAS float*)in[k]; }
};
#if defined(MK_DEBUGCNT)
#define DBG_COUNT(F, k) do { __hip_atomic_fetch_add((unsigned*)((F).ws + WS_CTL) + 2048 + (k), 1u, __ATOMIC_RELAXED, __HIP_MEMORY_SCOPE_AGENT); } while (0)
#else
#define DBG_COUNT(F, k) do {} while (0)
#endif
#if defined(MK_TIMING)
#define FSTAMP(F) do { if (blockIdx.x == 0 && (F).tid == 0 && (F).nts < 62) ((volatile LAS unsigned*)((F).lds + LDSCTL_OFF))[(F).nts] = (unsigned)__builtin_amdgcn_s_memrealtime(); ++(F).nts; } while (0)
#else
#define FSTAMP(F) do {} while (0)
#endif
template <int CTRL, int ROWMASK> __device__ __forceinline__ float dpp_get(float v) {
    return __builtin_bit_cast(float, __builtin_amdgcn_update_dpp(0, __builtin_bit_cast(int, v), CTRL, ROWMASK, 0xF, false));
}
__device__ __forceinline__ float dpp_sum8(float v) { v += dpp_get<0xB1, 0xF>(v); v += dpp_get<0x4E, 0xF>(v); v += dpp_get<0x141, 0xF>(v); return v; }
__device__ __forceinline__ float dpp_sum16(float v) { v = dpp_sum8(v); v += dpp_get<0x140, 0xF>(v); return v; }
__device__ __forceinline__ float dpp_sum32_hi(float v) { v = dpp_sum16(v); v += dpp_get<0x142, 0xA>(v); return v; }
__device__ __forceinline__ float wave_sum(float v) {
    v = dpp_sum32_hi(v); v += dpp_get<0x143, 0xC>(v);
    return __builtin_bit_cast(float, __builtin_amdgcn_readlane(__builtin_bit_cast(int, v), 63));
}
__device__ __forceinline__ float row16_reduce_scatter(const float (&d)[16], int lane) {
    const bool s3 = (lane & 8) != 0, s2 = (lane & 4) != 0, s1 = (lane & 2) != 0, s0 = (lane & 1) != 0;
    float a[8], b[4], c[2];
#pragma unroll
    for (int h = 0; h < 8; ++h) { const float keep = s3 ? d[h + 8] : d[h], give = s3 ? d[h] : d[h + 8]; a[h] = keep + dpp_get<0x140, 0xF>(give); }
#pragma unroll
    for (int h = 0; h < 4; ++h) { const float keep = s2 ? a[h + 4] : a[h], give = s2 ? a[h] : a[h + 4]; b[h] = keep + dpp_get<0x141, 0xF>(give); }
#pragma unroll
    for (int h = 0; h < 2; ++h) { const float keep = s1 ? b[h + 2] : b[h], give = s1 ? b[h] : b[h + 2]; c[h] = keep + dpp_get<0x4E, 0xF>(give); }
    const float keep = s0 ? c[1] : c[0], give = s0 ? c[0] : c[1];
    return keep + dpp_get<0xB1, 0xF>(give);
}
__device__ __forceinline__ float row_rstd(const float* SS, int r) {
    const f32x4* p = (const f32x4*)(SS + (size_t)r * 16);
    const f32x4 a = p[0], b = p[1], c = p[2], d = p[3];
    const float s = ((a.x + a.y) + (a.z + a.w)) + ((b.x + b.y) + (b.z + b.w)) + ((c.x + c.y) + (c.z + c.w)) + ((d.x + d.y) + (d.z + d.w));
    return __builtin_amdgcn_rsqf(s * (1.0f / DM) + EPS);
}
namespace pg8 {
struct EpiInProj {
    static constexpr bool PERM = true;
    bf16_t* CAT; bf16_t* XBC; bf16_t* U; const float* SS; float* out; bf16_t* HALO;
    __device__ __forceinline__ void operator()(const f32x4 (&acc)[2][2][4][2], const Unit& u, int wr, int wc, int fr, int fq, const PG8_LAS float* rs) const {
        const int row0 = u.pm * BM + wr * 64 + fr; const int colt = u.pn * BM;
        bf16_t* base; int ldc, c0; const bool isx = (colt >= 1024 && colt < 3072);
        if (colt < 1024) { base = CAT; ldc = 2048; c0 = colt; } else if (colt < 3072) { base = XBC; ldc = 2048; c0 = colt - 1024; } else { base = U; ldc = 1024; c0 = colt - 3072; }
        const int col0 = c0 + wc * 64 + 8 * fq;
#pragma unroll
        for (int ai = 0; ai < 2; ++ai)
#pragma unroll
            for (int m = 0; m < 4; ++m) {
                const int r = row0 + ai * HALF + m * 16; const float rsv = rs[wr * 64 + ai * HALF + m * 16 + fr];
                bf16_t* rowp = base + (size_t)r * ldc + col0;
                float* st = nullptr; bf16_t* hl = nullptr;
                if (isx) { if (r < MP) { const int t = r & 2047; if (t >= 2045) st = out + O_PAC + ((size_t)(r >> 11) * 3 + (t - 2045)) * 2048;
                                         if ((t & 63) >= 61) hl = HALO + ((size_t)((r >> 11) * 32 + (t >> 6)) * 3 + ((t & 63) - 61)) * 2048; }
                           else { const int rr = r - MP, t = rr & 7; if (t >= 5) st = out + O_SAC + ((size_t)(rr >> 3) * 3 + (t - 5)) * 2048; } }
#pragma unroll
                for (int bj = 0; bj < 2; ++bj) { const f32x4 v0 = acc[ai][bj][m][0] * rsv, v1 = acc[ai][bj][m][1] * rsv;
                    u32x4 w; w.x = cvt_pk_bf16(v0[0], v0[1]); w.y = cvt_pk_bf16(v0[2], v0[3]); w.z = cvt_pk_bf16(v1[0], v1[1]); w.w = cvt_pk_bf16(v1[2], v1[3]);
                    if (colt < 1024) __builtin_nontemporal_store(w, (u32x4*)(rowp + bj * 32));
                    else *(u32x4*)(rowp + bj * 32) = w;
                    if (hl) *(u32x4*)(hl + col0 + bj * 32) = w;
                    if (st) { __builtin_nontemporal_store(v0, (f32x4*)(st + col0 + bj * 32)); __builtin_nontemporal_store(v1, (f32x4*)(st + col0 + bj * 32 + 4)); } } }
    }
    __device__ __forceinline__ void tail_cols(int cb, int& w0, int& w1) const { w0 = 64 * cb; w1 = w0 + 32; }
    __device__ __forceinline__ void tail(const f32x4& a0, const f32x4& a1, int row, int cb, int coff, int wm, int wn, int fr, int fq, PG8_LAS unsigned char* red) const {
        const float rs = row_rstd(SS, row); const int rr = row - MP, t = rr & 7;
#pragma unroll
        for (int sg = 0; sg < 2; ++sg) { const int col = 64 * cb + 32 * sg + coff; const f32x4 v = (sg ? a1 : a0) * rs;
            u32x2 w; w.x = cvt_pk_bf16(v[0], v[1]); w.y = cvt_pk_bf16(v[2], v[3]);
            if (col < 1024) *(u32x2*)(CAT + (size_t)row * 2048 + col) = w;
            else if (col < 3072) { *(u32x2*)(XBC + (size_t)row * 2048 + (col - 1024)) = w; if (t >= 5) *(f32x4*)(out + O_SAC + ((size_t)(rr >> 3) * 3 + (t - 5)) * 2048 + (col - 1024)) = v; }
            else *(u32x2*)(U + (size_t)row * 1024 + (col - 3072)) = w; }
    }
};
struct EpiGlu {
    static constexpr bool PERM = true;
    const bf16_t* YS; bf16_t* CAT; const float* bias;
    __device__ __forceinline__ void operator()(const f32x4 (&acc)[2][2][4][2], const Unit& u, int wr, int wc, int fr, int fq, const PG8_LAS float* rs) const {
        const int row0 = u.pm * BM + wr * 64 + fr; const int col0 = u.pn * BM + wc * 64 + 8 * fq;
        f32x4 bv[2][2];
#pragma unroll
        for (int bj = 0; bj < 2; ++bj)
#pragma unroll
            for (int n = 0; n < 2; ++n) bv[bj][n] = *(const f32x4*)(bias + col0 + bj * 32 + 4 * n);
#pragma unroll
        for (int ai = 0; ai < 2; ++ai)
#pragma unroll
            for (int m = 0; m < 4; ++m) { const int r = row0 + ai * HALF + m * 16;
#pragma unroll
                for (int bj = 0; bj < 2; ++bj) { const u32x4 yw = *(const u32x4*)(YS + (size_t)r * 1024 + col0 + bj * 32);
                    const f32x4 g0 = acc[ai][bj][m][0] + bv[bj][0], g1 = acc[ai][bj][m][1] + bv[bj][1];
                    float o[8]; o[0] = bflo(yw.x) * sigmoidf_(g0[0]); o[1] = bfhi(yw.x) * sigmoidf_(g0[1]); o[2] = bflo(yw.y) * sigmoidf_(g0[2]); o[3] = bfhi(yw.y) * sigmoidf_(g0[3]);
                    o[4] = bflo(yw.z) * sigmoidf_(g1[0]); o[5] = bfhi(yw.z) * sigmoidf_(g1[1]); o[6] = bflo(yw.w) * sigmoidf_(g1[2]); o[7] = bfhi(yw.w) * sigmoidf_(g1[3]);
                    u32x4 w; w.x = cvt_pk_bf16(o[0], o[1]); w.y = cvt_pk_bf16(o[2], o[3]); w.z = cvt_pk_bf16(o[4], o[5]); w.w = cvt_pk_bf16(o[6], o[7]);
                    *(u32x4*)(CAT + (size_t)r * 2048 + 1024 + col0 + bj * 32) = w; }
                asm volatile("" ::: "memory"); }
    }
    __device__ __forceinline__ void tail_cols(int cb, int& w0, int& w1) const { w0 = 64 * cb; w1 = w0 + 32; }
    __device__ __forceinline__ void tail(const f32x4& a0, const f32x4& a1, int row, int cb, int coff, int wm, int wn, int fr, int fq, PG8_LAS unsigned char* red) const {
#pragma unroll
        for (int sg = 0; sg < 2; ++sg) { const int col = 64 * cb + 32 * sg + coff; const f32x4 g = (sg ? a1 : a0) + *(const f32x4*)(bias + col);
            const u32x2 yw = *(const u32x2*)(YS + (size_t)row * 1024 + col);
            u32x2 w; w.x = cvt_pk_bf16(bflo(yw.x) * sigmoidf_(g[0]), bfhi(yw.x) * sigmoidf_(g[1])); w.y = cvt_pk_bf16(bflo(yw.y) * sigmoidf_(g[2]), bfhi(yw.y) * sigmoidf_(g[3]));
            *(u32x2*)(CAT + (size_t)row * 2048 + 1024 + col) = w; }
    }
};
struct EpiRes {
    static constexpr bool PERM = true;
    const float* resP; const float* resS; const bf16_t* RB; float* X; bf16_t* XB; float* SS; const float* bias;
    __device__ __forceinline__ void operator()(const f32x4 (&acc)[2][2][4][2], const Unit& u, int wr, int wc, int fr, int fq, const PG8_LAS float* rs) const {
        const int row0 = u.pm * BM + wr * 64 + fr; const int col0 = u.pn * BM + wc * 64 + 8 * fq;
        f32x4 bv[2][2];
#pragma unroll
        for (int bj = 0; bj < 2; ++bj)
#pragma unroll
            for (int n = 0; n < 2; ++n) bv[bj][n] = bias ? *(const f32x4*)(bias + col0 + bj * 32 + 4 * n) : (f32x4){0.f, 0.f, 0.f, 0.f};
#pragma unroll
        for (int ai = 0; ai < 2; ++ai)
#pragma unroll
            for (int m = 0; m < 4; ++m) { const int r = row0 + ai * HALF + m * 16;
                float ssq = 0.f;
#pragma unroll
                for (int bj = 0; bj < 2; ++bj) { const int c = col0 + bj * 32;
                    f32x4 x0, x1;
                    if (RB) { const u32x4 rw = *(const u32x4*)(RB + (size_t)r * 1024 + c); x0 = (f32x4){bflo(rw.x), bfhi(rw.x), bflo(rw.y), bfhi(rw.y)}; x1 = (f32x4){bflo(rw.z), bfhi(rw.z), bflo(rw.w), bfhi(rw.w)}; }
                    else { const float* rp = resP + (size_t)r * 1024; x0 = __builtin_nontemporal_load((const f32x4*)(rp + c)); x1 = __builtin_nontemporal_load((const f32x4*)(rp + c + 4)); }
                    x0 = x0 + acc[ai][bj][m][0] + bv[bj][0]; x1 = x1 + acc[ai][bj][m][1] + bv[bj][1];
                    if (X) { *(f32x4*)(X + (size_t)r * 1024 + c) = x0; *(f32x4*)(X + (size_t)r * 1024 + c + 4) = x1; }
                    if (XB) { u32x4 w; w.x = cvt_pk_bf16(x0[0], x0[1]); w.y = cvt_pk_bf16(x0[2], x0[3]); w.z = cvt_pk_bf16(x1[0], x1[1]); w.w = cvt_pk_bf16(x1[2], x1[3]); *(u32x4*)(XB + (size_t)r * 1024 + c) = w; }
                    ssq += (x0[0] * x0[0] + x0[1] * x0[1]) + (x0[2] * x0[2] + x0[3] * x0[3]) + (x1[0] * x1[0] + x1[1] * x1[1]) + (x1[2] * x1[2] + x1[3] * x1[3]); }
                ssq += __shfl_xor(ssq, 16); ssq += __shfl_xor(ssq, 32);
                if (fq == 0) SS[(size_t)r * 16 + u.pn * 4 + wc] = ssq;
                asm volatile("" ::: "memory"); }
    }
    __device__ __forceinline__ void tail_cols(int cb, int& w0, int& w1) const { w0 = 64 * cb; w1 = w0 + 32; }
    __device__ __forceinline__ void tail(const f32x4& a0, const f32x4& a1, int row, int cb, int coff, int wm, int wn, int fr, int fq, PG8_LAS unsigned char* red) const {
        float ssq = 0.f;
#pragma unroll
        for (int sg = 0; sg < 2; ++sg) { const int col = 64 * cb + 32 * sg + coff;
            f32x4 x;
            if (RB) { const u32x2 rw = *(const u32x2*)(RB + (size_t)row * 1024 + col); x = (f32x4){bflo(rw.x), bfhi(rw.x), bflo(rw.y), bfhi(rw.y)}; }
            else x = __builtin_nontemporal_load((const f32x4*)(resS + (size_t)(row - MP) * 1024 + col));
            x = x + (sg ? a1 : a0); if (bias) x = x + *(const f32x4*)(bias + col);
            if (X) *(f32x4*)(X + (size_t)row * 1024 + col) = x;
            if (XB) { u32x2 w; w.x = cvt_pk_bf16(x[0], x[1]); w.y = cvt_pk_bf16(x[2], x[3]); *(u32x2*)(XB + (size_t)row * 1024 + col) = w; }
            ssq += (x[0] * x[0] + x[1] * x[1]) + (x[2] * x[2] + x[3] * x[3]); }
        ssq += __shfl_xor(ssq, 16); ssq += __shfl_xor(ssq, 32);
        PG8_LAS float* rd = (PG8_LAS float*)red;
        if (fq == 0) rd[wn * 64 + 16 * wm + fr] = ssq;
        asm volatile("s_waitcnt lgkmcnt(0)" ::: "memory"); __builtin_amdgcn_s_barrier(); asm volatile("" ::: "memory");
        if (wn == 0 && fq == 0) SS[(size_t)row * 16 + cb] = rd[16 * wm + fr] + rd[64 + 16 * wm + fr];
    }
};
struct EpiFF1 {
    static constexpr bool PERM = true;
    bf16_t* H; const float* SS;
    __device__ __forceinline__ void operator()(const f32x4 (&acc)[2][2][4][2], const Unit& u, int wr, int wc, int fr, int fq, const PG8_LAS float* rs) const {
        const int row0 = u.pm * BM + wr * 64 + fr; const int col0 = u.pn * BM + wc * 64 + 8 * fq;
#pragma unroll
        for (int ai = 0; ai < 2; ++ai)
#pragma unroll
            for (int m = 0; m < 4; ++m) { const int r = row0 + ai * HALF + m * 16; const float rsv = rs[wr * 64 + ai * HALF + m * 16 + fr];
#pragma unroll
                for (int bj = 0; bj < 2; ++bj) { f32x4 v0 = acc[ai][bj][m][0] * rsv, v1 = acc[ai][bj][m][1] * rsv;
#pragma unroll
                    for (int j = 0; j < 4; ++j) { const float a = fmaxf(v0[j], 0.f), b = fmaxf(v1[j], 0.f); v0[j] = a * a; v1[j] = b * b; }
                    u32x4 w; w.x = cvt_pk_bf16(v0[0], v0[1]); w.y = cvt_pk_bf16(v0[2], v0[3]); w.z = cvt_pk_bf16(v1[0], v1[1]); w.w = cvt_pk_bf16(v1[2], v1[3]);
                    *(u32x4*)(H + (size_t)r * FF + col0 + bj * 32) = w; } }
    }
    __device__ __forceinline__ void tail_cols(int cb, int& w0, int& w1) const { w0 = 64 * cb; w1 = w0 + 32; }
    __device__ __forceinline__ void tail(const f32x4& a0, const f32x4& a1, int row, int cb, int coff, int wm, int wn, int fr, int fq, PG8_LAS unsigned char* red) const {
        const float rs = row_rstd(SS, row);
#pragma unroll
        for (int sg = 0; sg < 2; ++sg) { const int col = 64 * cb + 32 * sg + coff; f32x4 v = (sg ? a1 : a0) * rs;
#pragma unroll
            for (int j = 0; j < 4; ++j) { const float a = fmaxf(v[j], 0.f); v[j] = a * a; }
            u32x2 w; w.x = cvt_pk_bf16(v[0], v[1]); w.y = cvt_pk_bf16(v[2], v[3]);
            *(u32x2*)(H + (size_t)row * FF + col) = w; }
    }
};
struct EpiPw1 {
    static constexpr bool PERM = true;
    bf16_t* G; const float* SS; const float* bias; float* out;
    __device__ __forceinline__ void operator()(const f32x4 (&acc)[2][2][4][2], const Unit& u, int wr, int wc, int fr, int fq, const PG8_LAS float* rs) const {
        const int row0 = u.pm * BM + wr * 64 + fr; const int col0 = u.pn * HALF + wc * 32 + 8 * fq;
        f32x4 bv[2][2];
#pragma unroll
        for (int bj = 0; bj < 2; ++bj)
#pragma unroll
            for (int n = 0; n < 2; ++n) bv[bj][n] = *(const f32x4*)(bias + bj * 1024 + col0 + 4 * n);
#pragma unroll
        for (int ai = 0; ai < 2; ++ai)
#pragma unroll
            for (int m = 0; m < 4; ++m) { const int r = row0 + ai * HALF + m * 16; const float rsv = rs[wr * 64 + ai * HALF + m * 16 + fr];
                f32x4 o0, o1;
#pragma unroll
                for (int j = 0; j < 4; ++j) { o0[j] = (acc[ai][0][m][0][j] * rsv + bv[0][0][j]) * sigmoidf_(acc[ai][1][m][0][j] * rsv + bv[1][0][j]);
                                              o1[j] = (acc[ai][0][m][1][j] * rsv + bv[0][1][j]) * sigmoidf_(acc[ai][1][m][1][j] * rsv + bv[1][1][j]); }
                u32x4 w; w.x = cvt_pk_bf16(o0[0], o0[1]); w.y = cvt_pk_bf16(o0[2], o0[3]); w.z = cvt_pk_bf16(o1[0], o1[1]); w.w = cvt_pk_bf16(o1[2], o1[3]);
                *(u32x4*)(G + (size_t)r * 1024 + col0) = w;
                float* st = nullptr;
                if (r < MP) { const int t = r & 2047; if (t >= 2018) st = out + O_PCC + ((size_t)(r >> 11) * 30 + (t - 2018)) * 1024; }
                else { const int rr = r - MP; st = out + O_SCC + ((size_t)(rr >> 3) * 30 + 22 + (rr & 7)) * 1024; }
                if (st) { __builtin_nontemporal_store(o0, (f32x4*)(st + col0)); __builtin_nontemporal_store(o1, (f32x4*)(st + col0 + 4)); } }
    }
    __device__ __forceinline__ void tail_cols(int cb, int& w0, int& w1) const { w0 = 256 * (cb >> 2) + 64 * (cb & 3); w1 = w0 + 32; }
    __device__ __forceinline__ void tail(const f32x4& a0, const f32x4& a1, int row, int cb, int coff, int wm, int wn, int fr, int fq, PG8_LAS unsigned char* red) const {
        const float rs = row_rstd(SS, row); const int oc = 32 * cb + coff, rr = row - MP;
        const f32x4 bv = *(const f32x4*)(bias + oc), bg = *(const f32x4*)(bias + 1024 + oc);
        f32x4 o;
#pragma unroll
        for (int j = 0; j < 4; ++j) o[j] = (a0[j] * rs + bv[j]) * sigmoidf_(a1[j] * rs + bg[j]);
        u32x2 w; w.x = cvt_pk_bf16(o[0], o[1]); w.y = cvt_pk_bf16(o[2], o[3]);
        *(u32x2*)(G + (size_t)row * 1024 + oc) = w;
        *(f32x4*)(out + O_SCC + ((size_t)(rr >> 3) * 30 + 22 + (rr & 7)) * 1024 + oc) = o;
    }
};
}
namespace pg8 {
constexpr int TL_STAGE = 32768, TL_RED = 3 * TL_STAGE;
template <class Epi>
__device__ __forceinline__ void gemm_tail(PG8_LAS unsigned char* lds, const bf16_t* A  , int lda, const bf16_t* Bt, int K, int ntiles_n  , const Epi& E, int bx, int G, int i_begin, int i_end) {
    const int tid = threadIdx.x, wid = __builtin_amdgcn_readfirstlane(tid >> 6), lane = tid & 63, wm = wid >> 1, wn = wid & 1, fr = lane & 15, fq = lane >> 4;
    const int nk = K / 128, ntiles = 16 * ntiles_n;
    const int lrow = lane >> 4, lch = lane & 15;
    for (int ii = i_begin; ii < i_end; ++ii) { const int ti = bx + G * ii; if (ti >= ntiles) break;
        const int rb = ti & 15, cb = ti >> 4;
        int wrow0, wrow1; E.tail_cols(cb, wrow0, wrow1);
        const char* srcA[2]; const char* srcB[2];
#pragma unroll
        for (int i = 0; i < 2; ++i) {
            const int r = 8 * wid + 4 * i + lrow;
            srcA[i] = (const char*)(A + (size_t)(rb * 64 + r) * lda) + ((lch ^ (r & 15)) << 4);
            const int wr_ = (r < 32) ? (wrow0 + r) : (wrow1 + r - 32);
            srcB[i] = (const char*)(Bt + (size_t)wr_ * K) + ((lch ^ (r & 15)) << 4);
        }
#define TL_ISSUE(kt, st) do { _Pragma("unroll") for (int _i = 0; _i < 2; ++_i) { \
            __builtin_amdgcn_global_load_lds((const unsigned*)(srcA[_i] + (size_t)(kt) * 256), (PG8_LAS unsigned*)(lds + (st) * TL_STAGE + (8 * wid + 4 * _i) * 256), 16, 0, 0); \
            __builtin_amdgcn_global_load_lds((const unsigned*)(srcB[_i] + (size_t)(kt) * 256), (PG8_LAS unsigned*)(lds + (st) * TL_STAGE + 16384 + (8 * wid + 4 * _i) * 256), 16, 0, 0); } } while (0)
        f32x4 acc[2] = {(f32x4){0.f, 0.f, 0.f, 0.f}, (f32x4){0.f, 0.f, 0.f, 0.f}};
        TL_ISSUE(0, 0); TL_ISSUE(1, 1);
        for (int kt = 0; kt < nk; ++kt) {
            const int st = kt % 3;
            if (kt + 1 < nk) asm volatile("s_waitcnt vmcnt(4)" ::: "memory"); else asm volatile("s_waitcnt vmcnt(0)" ::: "memory");
            asm volatile("s_waitcnt lgkmcnt(0)" ::: "memory"); __builtin_amdgcn_s_barrier(); asm volatile("" ::: "memory");
            if (kt + 2 < nk) TL_ISSUE(kt + 2, (kt + 2) % 3);
            const PG8_LAS unsigned char* sa = lds + st * TL_STAGE + (16 * wm + fr) * 256;
            const PG8_LAS unsigned char* sb0 = lds + st * TL_STAGE + 16384 + (16 * wn + fr) * 256;
            const PG8_LAS unsigned char* sb1 = sb0 + 32 * 256;
#pragma unroll
            for (int ks = 0; ks < 4; ++ks) {
                const int co = ((4 * ks + fq) ^ fr) << 4;
                const bf16x8 a = *(const PG8_LAS bf16x8*)(sa + co), b0 = *(const PG8_LAS bf16x8*)(sb0 + co), b1 = *(const PG8_LAS bf16x8*)(sb1 + co);
                acc[0] = __builtin_amdgcn_mfma_f32_16x16x32_bf16(b0, a, acc[0], 0, 0, 0);
                acc[1] = __builtin_amdgcn_mfma_f32_16x16x32_bf16(b1, a, acc[1], 0, 0, 0);
            }
        }
#undef TL_ISSUE
        E.tail(acc[0], acc[1], MP + rb * 64 + 16 * wm + fr, cb, 16 * wn + 4 * fq, wm, wn, fr, fq, lds + TL_RED);
        asm volatile("s_waitcnt lgkmcnt(0)" ::: "memory"); __builtin_amdgcn_s_barrier(); asm volatile("" ::: "memory");
    }
}
template <int NCB, class Epi>
__device__ __forceinline__ void gemm_tail_wide(PG8_LAS unsigned char* lds, const bf16_t* A  , int lda, const bf16_t* Bt, int K, const Epi& E, int bx, int G) {
    static_assert(NCB == 2 || NCB == 4, "NCB");
    constexpr int STAGE = 8192 * (1 + NCB), CJ = (NCB == 4) ? 4 : 2;
    const int tid = threadIdx.x, wid = __builtin_amdgcn_readfirstlane(tid >> 6), lane = tid & 63, wm2 = wid >> 2, wn4 = wid & 3, fr = lane & 15, fq = lane >> 4;
    const int nk = K / 64;
    const int lrow = lane >> 3, lch = lane & 7;
    for (int s = bx; s < 256; s += G) {
        const int rb = s & 15, cb0 = s >> 4;
        const char* srcA = (const char*)(A + (size_t)(rb * 64 + 8 * wid + lrow) * lda) + ((lch ^ lrow) << 4);
        const char* srcB[NCB];
#pragma unroll
        for (int i = 0; i < NCB; ++i) { int w0, w1; E.tail_cols(cb0 + 16 * i, w0, w1);
            const int wr_ = ((wid >> 2) ? w1 : w0) + ((8 * wid + lrow) & 31);
            srcB[i] = (const char*)(Bt + (size_t)wr_ * K) + ((lch ^ lrow) << 4); }
#define TW_ISSUE(kt, st) do { \
            __builtin_amdgcn_global_load_lds((const unsigned*)(srcA + (size_t)(kt) * 128), (PG8_LAS unsigned*)(lds + (st) * STAGE + (8 * wid) * 128), 16, 0, 0); \
            _Pragma("unroll") for (int _i = 0; _i < NCB; ++_i) \
                __builtin_amdgcn_global_load_lds((const unsigned*)(srcB[_i] + (size_t)(kt) * 128), (PG8_LAS unsigned*)(lds + (st) * STAGE + 8192 + (64 * _i + 8 * wid) * 128), 16, 0, 0); } while (0)
        f32x4 acc[2][CJ];
#pragma unroll
        for (int ri = 0; ri < 2; ++ri)
#pragma unroll
            for (int j = 0; j < CJ; ++j) acc[ri][j] = (f32x4){0.f, 0.f, 0.f, 0.f};
        const int brow0 = (NCB == 4) ? 64 * wn4 : (64 * (wn4 >> 1) + 16 * (wn4 & 1));
        TW_ISSUE(0, 0); TW_ISSUE(1, 1);
        for (int kt = 0; kt < nk; ++kt) {
            const int st = kt % 3;
            if (kt + 1 < nk) { if (NCB == 4) asm volatile("s_waitcnt vmcnt(5)" ::: "memory"); else asm volatile("s_waitcnt vmcnt(3)" ::: "memory"); }
            else asm volatile("s_waitcnt vmcnt(0)" ::: "memory");
            asm volatile("s_waitcnt lgkmcnt(0)" ::: "memory"); __builtin_amdgcn_s_barrier(); asm volatile("" ::: "memory");
            if (kt + 2 < nk) TW_ISSUE(kt + 2, (kt + 2) % 3);
            const PG8_LAS unsigned char* sa = lds + st * STAGE + (32 * wm2 + fr) * 128;
            const PG8_LAS unsigned char* sb = lds + st * STAGE + 8192 + (brow0 + fr) * 128;
#pragma unroll
            for (int ks = 0; ks < 2; ++ks) {
                const int co = ((4 * ks + fq) ^ (fr & 7)) << 4;
                const bf16x8 a0 = *(const PG8_LAS bf16x8*)(sa + co), a1 = *(const PG8_LAS bf16x8*)(sa + 16 * 128 + co);
#pragma unroll
                for (int j = 0; j < CJ; ++j) {
                    const bf16x8 b = *(const PG8_LAS bf16x8*)(sb + ((NCB == 4) ? 16 : 32) * j * 128 + co);
                    acc[0][j] = __builtin_amdgcn_mfma_f32_16x16x32_bf16(b, a0, acc[0][j], 0, 0, 0);
                    acc[1][j] = __builtin_amdgcn_mfma_f32_16x16x32_bf16(b, a1, acc[1][j], 0, 0, 0);
                }
            }
        }
#undef TW_ISSUE
#pragma unroll
        for (int ri = 0; ri < 2; ++ri) {
            const int row = MP + rb * 64 + 32 * wm2 + 16 * ri + fr;
            if (NCB == 4) {
#pragma unroll
                for (int wn = 0; wn < 2; ++wn) E.tail(acc[ri][wn], acc[ri][2 + wn], row, cb0 + 16 * wn4, 16 * wn + 4 * fq, 2 * wm2 + ri, wn, fr, fq, nullptr);
            } else {
                const int wn = wn4 & 1;
                E.tail(acc[ri][0], acc[ri][1], row, cb0 + 16 * (wn4 >> 1), 16 * wn + 4 * fq, 2 * wm2 + ri, wn, fr, fq, nullptr);
            }
        }
        asm volatile("s_waitcnt lgkmcnt(0)" ::: "memory"); __builtin_amdgcn_s_barrier(); asm volatile("" ::: "memory");
    }
}
}
__device__ __forceinline__ void p0_transpose_item(const float* W, int ldw, int K, bf16* WT, int dst_row0, const float* kscale, LAS float* scr, int k0, int n0, int lane) {
    float tv[32];
#pragma unroll
    for (int i = 0; i < 32; ++i) { const int kk = 2 * i + (lane >> 5); tv[i] = W[(size_t)(k0 + kk) * ldw + n0 + (lane & 31)]; }
    if (kscale) {
#pragma unroll
        for (int i = 0; i < 32; ++i) tv[i] *= kscale[k0 + 2 * i + (lane >> 5)];
    }
#pragma unroll
    for (int i = 0; i < 32; ++i) { const int kk = 2 * i + (lane >> 5); scr[kk * 33 + (lane & 31)] = tv[i]; }
    LDS_WAIT(); asm volatile("" ::: "memory");
    const int c = lane & 7;
#pragma unroll
    for (int j = 0; j < 4; ++j) { const int n = (lane >> 3) + 8 * j; const LAS float* s = scr + (8 * c) * 33 + n;
        v4u o; o.x = pk2(s[0 * 33], s[1 * 33]); o.y = pk2(s[2 * 33], s[3 * 33]); o.z = pk2(s[4 * 33], s[5 * 33]); o.w = pk2(s[6 * 33], s[7 * 33]);
        *(GAS v4u*)(WT + (size_t)(dst_row0 + n) * K + k0 + 8 * c) = o; }
    LDS_WAIT(); asm volatile("" ::: "memory");
}
__device__ __forceinline__ void p0_mat(const float* W, int ldw, int K, int ncols, bf16* WT, int row_off, const float* kscale, LAS float* scr, int item, int lane, int glu_map) {
    const int nblk = ncols / 32, kb = item / nblk, nb = item % nblk, n0 = 32 * nb;
    int dst = row_off + n0;
    if (glu_map) dst = (n0 < 1024) ? (256 * (n0 >> 7) + 64 * ((n0 & 127) >> 5)) : (256 * ((n0 - 1024) >> 7) + 64 * (((n0 - 1024) & 127) >> 5) + 32);
    p0_transpose_item(W, ldw, K, WT, dst, kscale, scr, 64 * kb, n0, lane);
}
constexpr int P0_SCR_STRIDE = 8704;
constexpr int P0_WD_OFF = NWAVES * P0_SCR_STRIDE;
constexpr int P0_WD_LD = 1028, P0_WDB_PITCH = 2064;
static_assert(P0_WD_OFF + 16 * P0_WD_LD * 4 <= LDSCTL_OFF, "P0 LDS");

constexpr int P0_WIN_ITEMS = 16 * 96 + 16 * 32, P0_L0_ITEMS = P0_WIN_ITEMS + 16 * 32 + 32 * 32 + 16 * 128 + 64 * 32  , P0_PW1_ITEMS = P0_L0_ITEMS + 16 * 64  , P0_ALL_ITEMS = 16 * 96 + 16 * 32 + 16 * 32 + 32 * 32 + 2 * 16 * 128 + 2 * 64 * 32 + 16 * 64 + 16 * 32;
__device__ __forceinline__ void p0_weights(Frame& F, int lo, int hi, int gw_ = -1  , int NGW_ = 0) {
    LAS float* scr = (LAS float*)(F.lds + F.wave * P0_SCR_STRIDE);
    const int gw = gw_ >= 0 ? gw_ : F.vcu * NWAVES + F.wave, NGW = gw_ >= 0 ? NGW_ : F.G * NWAVES;
    const float* w_in = F.inp(10); const float* nmix = F.inp(7); const float* nff = F.inp(8);
    bf16* Win = (bf16*)(F.ws + WS_WIN); bf16* Wglu = (bf16*)(F.ws + WS_WGLU); bf16* Wout = (bf16*)(F.ws + WS_WOUT);
    bf16* Wff1 = (bf16*)(F.ws + WS_WFF1); bf16* Wff2 = (bf16*)(F.ws + WS_WFF2); bf16* Wpw1 = (bf16*)(F.ws + WS_WPW1); bf16* Wpw2 = (bf16*)(F.ws + WS_WPW2);
    constexpr int I1 = 16 * 96, I2 = 16 * 32, I3 = 16 * 32, I4 = 32 * 32, I5 = 16 * 128, I6 = 64 * 32, I7 = 16 * 64, I8 = 16 * 32;
    constexpr int NITEMS = I1 + I2 + I3 + I4 + 2 * I5 + 2 * I6 + I7 + I8;
#define P0_DECODE(it_, src_, ldw_, dst_, K_, ks_) do { \
        const float* W_; int ncols_, roff_ = 0, glu_ = 0; bf16* WT_; const float* ksc_ = nullptr; int r_ = (it_); \
        if (r_ < I1) { W_ = w_in; ldw_ = INC; K_ = 1024; ncols_ = 3072; WT_ = Win; ksc_ = nmix; } \
        else if ((r_ -= I1) < I2) { W_ = w_in + 3088; ldw_ = INC; K_ = 1024; ncols_ = 1024; WT_ = Win; roff_ = 3072; ksc_ = nmix; } \
        else if ((r_ -= I2) < I3) { W_ = F.inp(25); ldw_ = 1024; K_ = 1024; ncols_ = 1024; WT_ = Wglu; } \
        else if ((r_ -= I3) < I4) { W_ = F.inp(27); ldw_ = 1024; K_ = 2048; ncols_ = 1024; WT_ = Wout; } \
        else if ((r_ -= I4) < I5) { W_ = F.inp(36); ldw_ = 4096; K_ = 1024; ncols_ = 4096; WT_ = Wff1; ksc_ = nff; } \
        else if ((r_ -= I5) < I6) { W_ = F.inp(37); ldw_ = 1024; K_ = 4096; ncols_ = 1024; WT_ = Wff2; } \
        else if ((r_ -= I6) < I7) { W_ = F.inp(28); ldw_ = 2048; K_ = 1024; ncols_ = 2048; WT_ = Wpw1; ksc_ = nmix + 1024; glu_ = 1; } \
        else if ((r_ -= I7) < I5) { W_ = F.inp(36) + (size_t)1024 * 4096; ldw_ = 4096; K_ = 1024; ncols_ = 4096; WT_ = Wff1 + (size_t)4096 * 1024; ksc_ = nff + 1024; } \
        else if ((r_ -= I5) < I6) { W_ = F.inp(37) + (size_t)4096 * 1024; ldw_ = 1024; K_ = 4096; ncols_ = 1024; WT_ = Wff2 + (size_t)1024 * 4096; } \
        else { r_ -= I6; W_ = F.inp(34); ldw_ = 1024; K_ = 1024; ncols_ = 1024; WT_ = Wpw2; } \
        const int nblk_ = ncols_ >> 5, kb_ = r_ / nblk_, n0_ = 32 * (r_ - kb_ * nblk_); \
        int drow_ = roff_ + n0_; \
        if (glu_) drow_ = (n0_ < 1024) ? (256 * (n0_ >> 7) + 64 * ((n0_ & 127) >> 5)) : (256 * ((n0_ - 1024) >> 7) + 64 * (((n0_ - 1024) & 127) >> 5) + 32); \
        src_ = W_ + (size_t)(64 * kb_ + (F.lane >> 5)) * ldw_ + n0_ + (F.lane & 31); \
        dst_ = WT_ + (size_t)drow_ * K_ + 64 * kb_; ks_ = ksc_ ? ksc_ + 64 * kb_ : nullptr; } while (0)
    {
        float tv[32];
        const float* src; int ldw = 0, K = 0; bf16* dst; const float* ks;
        if (lo + gw < hi) { P0_DECODE(lo + gw, src, ldw, dst, K, ks);
#pragma unroll
            for (int i = 0; i < 32; ++i) tv[i] = __builtin_nontemporal_load(&src[(size_t)(2 * i) * ldw]); }
        for (int it = lo + gw; it < hi; it += NGW) {
            float nv_[32]; const float* nsrc; int nldw = 0, nK = 0; bf16* ndst = nullptr; const float* nks = nullptr;
            const bool more = it + NGW < hi;
            if (more) { P0_DECODE(it + NGW, nsrc, nldw, ndst, nK, nks);
#pragma unroll
                for (int i = 0; i < 32; ++i) nv_[i] = __builtin_nontemporal_load(&nsrc[(size_t)(2 * i) * nldw]); }
            const int c = F.lane & 7;
            f32x4 k0v = (f32x4){1.f, 1.f, 1.f, 1.f}, k1v = k0v;
            if (ks) { k0v = *(const f32x4*)(ks + 8 * c); k1v = *(const f32x4*)(ks + 8 * c + 4); }
#pragma unroll
            for (int i = 0; i < 32; ++i) { const int kk = 2 * i + (F.lane >> 5); scr[kk * 33 + (F.lane & 31)] = tv[i]; }
            LDS_WAIT(); asm volatile("" ::: "memory");
#pragma unroll
            for (int j = 0; j < 4; ++j) { const int n = (F.lane >> 3) + 8 * j; const LAS float* sp = scr + (8 * c) * 33 + n;
                v4u o; o.x = pk2(sp[0 * 33] * k0v.x, sp[1 * 33] * k0v.y); o.y = pk2(sp[2 * 33] * k0v.z, sp[3 * 33] * k0v.w); o.z = pk2(sp[4 * 33] * k1v.x, sp[5 * 33] * k1v.y); o.w = pk2(sp[6 * 33] * k1v.z, sp[7 * 33] * k1v.w);
                if (lo >= P0_WIN_ITEMS) __builtin_nontemporal_store(o, (GAS v4u*)(dst + (size_t)n * K + 8 * c));
                else *(GAS v4u*)(dst + (size_t)n * K + 8 * c) = o; }
            LDS_WAIT(); asm volatile("" ::: "memory");
            if (more) {
#pragma unroll
                for (int i = 0; i < 32; ++i) tv[i] = nv_[i];
                dst = ndst; K = nK; ks = nks; }
        }
    }
#undef P0_DECODE
}
__device__ __forceinline__ void p0_prologue(Frame& F) {
    LAS float* scr = (LAS float*)(F.lds + F.wave * P0_SCR_STRIDE);
    const int gw = F.vcu * NWAVES + F.wave, NGW = F.G * NWAVES;
    const float* w_in = F.inp(10); const float* nmix = F.inp(7); const float* nff = F.inp(8);
    f32x4 nv[4];
    { const int m0 = gw < MT ? gw : 0; const float* xrow = (m0 < MP) ? F.inp(0) + (size_t)m0 * DM : F.inp(1) + (size_t)(m0 - MP) * DM; const GAS f32x4* xr = (const GAS f32x4*)xrow + F.lane;
#pragma unroll
      for (int j = 0; j < 4; ++j) nv[j] = __builtin_nontemporal_load(&xr[64 * j]); }
    { LAS unsigned char* WD = F.lds + P0_WD_OFF;
      for (int k = F.tid; k < 1024; k += NWAVES * 64) { const float nk = nmix[k]; const f32x4* wp = (const f32x4*)(w_in + (size_t)k * INC + 3072);
#pragma unroll
          for (int q = 0; q < 4; ++q) { const f32x4 w4 = wp[q];
              *(LAS unsigned short*)(WD + (4 * q) * P0_WDB_PITCH + k * 2) = (unsigned short)f2bf(w4.x * nk); *(LAS unsigned short*)(WD + (4 * q + 1) * P0_WDB_PITCH + k * 2) = (unsigned short)f2bf(w4.y * nk);
              *(LAS unsigned short*)(WD + (4 * q + 2) * P0_WDB_PITCH + k * 2) = (unsigned short)f2bf(w4.z * nk); *(LAS unsigned short*)(WD + (4 * q + 3) * P0_WDB_PITCH + k * 2) = (unsigned short)f2bf(w4.w * nk); } } }
    { float* WT = (float*)(F.ws + (235u << 20)); const float* wd = F.inp(30);
      for (int idx = (int)blockIdx.x * (NWAVES * 64) + F.tid; idx < 1024 * 32; idx += F.G * NWAVES * 64) { const int ch = idx >> 5, k = idx & 31; WT[idx] = (k < 31) ? wd[k * 1024 + ch] : 0.f; } }
    p0_weights(F, 0, P0_WIN_ITEMS);
    FSTAMP(F);
    bf16* CAT = (bf16*)(F.ws + WS_CAT); float* SS = (float*)(F.ws + WS_SS); float* DT = (float*)(F.ws + WS_DT); float* DA = (float*)(F.ws + WS_DA);
    typedef __bf16 p0_bf2 __attribute__((ext_vector_type(2)));
    __syncthreads();
    unsigned wdt[16][8];
#pragma unroll
    for (int h = 0; h < 16; ++h)
#pragma unroll
        for (int j = 0; j < 4; ++j) { const v2u w2 = *(const LAS v2u*)(F.lds + P0_WD_OFF + h * P0_WDB_PITCH + (4 * F.lane + 256 * j) * 2); wdt[h][2 * j] = w2.x; wdt[h][2 * j + 1] = w2.y; }
    const float dt_bias = F.inp(13)[F.lane & 15], dt_a = -__expf(F.inp(14)[F.lane & 15]);
    for (int m = gw; m < MT; m += NGW) {
        f32x4 v[4]; float s = 0.f;
#pragma unroll
        for (int j = 0; j < 4; ++j) { v[j] = nv[j]; s += (v[j].x * v[j].x + v[j].y * v[j].y) + (v[j].z * v[j].z + v[j].w * v[j].w); }
        { const int mn = (m + NGW < MT) ? m + NGW : m; const float* xrow = (mn < MP) ? F.inp(0) + (size_t)mn * DM : F.inp(1) + (size_t)(mn - MP) * DM; const GAS f32x4* xr = (const GAS f32x4*)xrow + F.lane;
#pragma unroll
          for (int j = 0; j < 4; ++j) nv[j] = __builtin_nontemporal_load(&xr[64 * j]); }
        s = wave_sum(s);
        GAS unsigned long long* o8 = (GAS unsigned long long*)(CAT + (size_t)m * 2048 + 1024) + F.lane;
        unsigned xp[8];
#pragma unroll
        for (int j = 0; j < 4; ++j) { xp[2 * j] = pk2(v[j].x, v[j].y); xp[2 * j + 1] = pk2(v[j].z, v[j].w); o8[64 * j] = (unsigned long long)xp[2 * j] | ((unsigned long long)xp[2 * j + 1] << 32); }
        if (F.lane < 16) SS[(size_t)m * 16 + F.lane] = (F.lane == 0) ? s : 0.f;
        float dd[16];
#pragma unroll
        for (int h = 0; h < 16; ++h) {
            float d = 0.f;
#pragma unroll
            for (int q = 0; q < 8; ++q) d = __builtin_amdgcn_fdot2_f32_bf16(__builtin_bit_cast(p0_bf2, xp[q]), __builtin_bit_cast(p0_bf2, wdt[h][q]), d, false);
            dd[h] = d;
        }
        float dsel = row16_reduce_scatter(dd, F.lane);
        dsel += __shfl_xor(dsel, 16); dsel += __shfl_xor(dsel, 32);
        if (F.lane < 16) {
            const float xr_ = dsel * __builtin_amdgcn_rsqf(s * (1.0f / 1024.0f) + EPS) + dt_bias;
            const float dtv = xr_ > 20.f ? xr_ : log1pf(__expf(xr_));
            DT[(size_t)m * 16 + F.lane] = dtv; DA[(size_t)m * 16 + F.lane] = dtv * dt_a;
        }
    }
}
constexpr int DT_WPITCH = 2064;
__device__ __forceinline__ void dt_phase(Frame& F) {
    typedef short dt_bf16x8 __attribute__((ext_vector_type(8)));
    const bf16* WDT = (const bf16*)(F.ws + WS_WDT); const bf16* CAT = (const bf16*)(F.ws + WS_CAT); const float* SS = (const float*)(F.ws + WS_SS);
    float* DT = (float*)(F.ws + WS_DT); float* DA = (float*)(F.ws + WS_DA);
    LAS unsigned char* WL = F.lds;
    for (int pc = F.tid; pc < 16 * 128; pc += NWAVES * 64) { const int h = pc >> 7, q = pc & 127; *(LAS v4u*)(WL + h * DT_WPITCH + q * 16) = *(const v4u*)(WDT + (size_t)h * 1024 + q * 8); }
    __syncthreads();
    const int fr = F.lane & 15, fq = F.lane >> 4;
    const int gw = F.vcu * NWAVES + F.wave;
    if (gw < MT / 16) {
        const int row = gw * 16 + fr;
        const bf16* xp = CAT + (size_t)row * 2048 + 1024 + 8 * fq;
        f32x4 acc = (f32x4){0.f, 0.f, 0.f, 0.f};
#pragma unroll
        for (int s8 = 0; s8 < 4; ++s8) {
            dt_bf16x8 xf[8];
#pragma unroll
            for (int k = 0; k < 8; ++k) xf[k] = *(const dt_bf16x8*)(xp + 32 * (8 * s8 + k));
#pragma unroll
            for (int k = 0; k < 8; ++k) { const dt_bf16x8 wf = *(const LAS dt_bf16x8*)(WL + fr * DT_WPITCH + (32 * (8 * s8 + k) + 8 * fq) * 2);
                acc = __builtin_amdgcn_mfma_f32_16x16x32_bf16(wf, xf[k], acc, 0, 0, 0); }
        }
        const float rstd = row_rstd(SS, row);
        const f32x4 bias = *(const f32x4*)(F.inp(13) + 4 * fq), al = *(const f32x4*)(F.inp(14) + 4 * fq);
        f32x4 dtv, dav;
#pragma unroll
        for (int j = 0; j < 4; ++j) { const float xr_ = acc[j] * rstd + bias[j]; dtv[j] = xr_ > 20.f ? xr_ : log1pf(__expf(xr_)); dav[j] = -dtv[j] * __expf(al[j]); }
        *(f32x4*)(DT + (size_t)row * 16 + 4 * fq) = dtv; *(f32x4*)(DA + (size_t)row * 16 + 4 * fq) = dav;
    }
    __syncthreads();
}
typedef short s5_bf16x8 __attribute__((ext_vector_type(8)));
constexpr int S5_HB_ROW = 272;
constexpr int S5_HB_WAVE = 2 * 16 * S5_HB_ROW;
constexpr int S5_HE_OFF = NWAVES * S5_HB_WAVE;
constexpr int S5_YT_OFF = S5_HE_OFF + NWAVES * 2 * 64 * 2 * 4;
constexpr int S5_LDS_END = S5_YT_OFF + NWAVES * 1024;
static_assert(S5_LDS_END <= LDSCTL_OFF, "S5 LDS");
constexpr int S5_PROMPT_UNITS = 256, S5_SAMPLE_UNITS = 256, S5_UNITS = S5_PROMPT_UNITS + S5_SAMPLE_UNITS;

__device__ __forceinline__ float gelu_tanh(float x) {
    const float arg = x * __builtin_fmaf(x * x, 0.10294324f, 2.3022082f);
    const float r = frcp_(__builtin_amdgcn_exp2f(arg) + 1.0f);
    return __builtin_fmaf(-x, r, x);
}

struct S5Consts {
    float lr[2], li[2];
    s5_bf16x8 bfr[2][2];
    s5_bf16x8 cm[4];
    s5_bf16x8 dm;
};
__device__ __forceinline__ void s5_setup(const Frame& F, int g, S5Consts& K) {
    const int lane = F.lane, r = lane & 31, hh = lane >> 5;
    const float step = expf(F.inp(19)[g]);
#pragma unroll
    for (int pt = 0; pt < 2; ++pt) {
        const int p = 32 * pt + r;
        const float lr = F.inp(17)[g * 64 + p], li = F.inp(18)[g * 64 + p];
        const float mag = expf(lr * step), ar = mag * cosf(li * step), ai = mag * sinf(li * step);
        const float den = lr * lr + li * li;
        const float kr = ((ar - 1.0f) * lr + ai * li) / den, ki = (ai * lr - (ar - 1.0f) * li) / den;
        K.lr[pt] = ar; K.li[pt] = ai;
        const float* br = F.inp(20) + ((size_t)(g * 64 + p) * 16 + 8 * hh); const float* bi = F.inp(21) + ((size_t)(g * 64 + p) * 16 + 8 * hh);
        unsigned wr_[4], wi_[4];
#pragma unroll
        for (int j = 0; j < 4; ++j) {
            const float b0r = br[2 * j], b0i = bi[2 * j], b1r = br[2 * j + 1], b1i = bi[2 * j + 1];
            wr_[j] = pk2(kr * b0r - ki * b0i, kr * b1r - ki * b1i);
            wi_[j] = pk2(kr * b0i + ki * b0r, kr * b1i + ki * b1r);
        }
        K.bfr[pt][0] = __builtin_bit_cast(s5_bf16x8, (v4u){wr_[0], wr_[1], wr_[2], wr_[3]});
        K.bfr[pt][1] = __builtin_bit_cast(s5_bf16x8, (v4u){wi_[0], wi_[1], wi_[2], wi_[3]});
    }
    const int c = lane & 15, q = lane >> 4;
#pragma unroll
    for (int s = 0; s < 4; ++s) {
        const int p0 = 16 * s + 4 * q;
        const float* cr = F.inp(22) + ((size_t)(g * 16 + c) * 64 + p0); const float* ci = F.inp(23) + ((size_t)(g * 16 + c) * 64 + p0);
        unsigned w[4];
#pragma unroll
        for (int j = 0; j < 4; ++j) w[j] = pk2(cr[j], -ci[j]);
        K.cm[s] = __builtin_bit_cast(s5_bf16x8, (v4u){w[0], w[1], w[2], w[3]});
    }
    { const float dv = F.inp(24)[g * 16 + c]; unsigned w[4];
#pragma unroll
      for (int j = 0; j < 4; ++j) { const int k0 = 8 * q + 2 * j; w[j] = pk2((q < 2 && k0 == c) ? dv : 0.f, (q < 2 && k0 + 1 == c) ? dv : 0.f); }
      K.dm = __builtin_bit_cast(s5_bf16x8, (v4u){w[0], w[1], w[2], w[3]}); }
}

struct S5Frags { s5_bf16x8 a, u0, u1; };
template <bool WITH_Y>
__device__ __forceinline__ S5Frags s5_load_a(const Frame& F, const bf16* U, int g, int base0, int base1) {
    S5Frags fr;
    const int r = F.lane & 31, hh = F.lane >> 5, h = (r >> 2) & 1, i = (r & 3) + 4 * (r >> 3);
    const int arow = (h ? base1 : base0) + i;
    fr.a = *(const GAS s5_bf16x8*)(U + (size_t)arow * 1024 + g * 16 + 8 * hh);
    const s5_bf16x8 zz = (s5_bf16x8){0, 0, 0, 0, 0, 0, 0, 0};
    fr.u0 = zz; fr.u1 = zz;
    if (WITH_Y) {
        const int t = F.lane & 15, q = F.lane >> 4;
        if (q < 2) { fr.u0 = *(const GAS s5_bf16x8*)(U + (size_t)(base0 + t) * 1024 + g * 16 + 8 * q); fr.u1 = *(const GAS s5_bf16x8*)(U + (size_t)(base1 + t) * 1024 + g * 16 + 8 * q); }
    }
    return fr;
}

template <int SEGLEN, bool WITH_Y>
__device__ __forceinline__ void s5_step(const Frame& F, const S5Consts& K, bf16* U, int g, int base0, int base1, const S5Frags& fg,
                                        float (&hr)[2][2], float (&hi)[2][2]  , LAS unsigned char* hb, LAS unsigned char* yt) {
    const s5_bf16x8 afrag = fg.a;
    const int lane = F.lane, hh = lane >> 5, r = lane & 31;
    f32x16 bu[2][2];
#pragma unroll
    for (int pt = 0; pt < 2; ++pt)
#pragma unroll
        for (int ri = 0; ri < 2; ++ri) {
            f32x16 z;
#pragma unroll
            for (int i = 0; i < 16; ++i) z[i] = 0.f;
            bu[pt][ri] = __builtin_amdgcn_mfma_f32_32x32x16_bf16(afrag, K.bfr[pt][ri], z, 0, 0, 0);
        }
#pragma unroll
    for (int i = 0; i < 16; ++i) {
        constexpr int dummy = 0; (void)dummy;
        const int cs = (SEGLEN == 8) ? (i >> 3) : 0;
#pragma unroll
        for (int pt = 0; pt < 2; ++pt) {
            const float nr = __builtin_fmaf(K.lr[pt], hr[cs][pt], __builtin_fmaf(-K.li[pt], hi[cs][pt], bu[pt][0][i]));
            const float ni = __builtin_fmaf(K.lr[pt], hi[cs][pt], __builtin_fmaf(K.li[pt], hr[cs][pt], bu[pt][1][i]));
            hr[cs][pt] = nr; hi[cs][pt] = ni;
            if (WITH_Y) *(LAS unsigned*)(hb + (hh * 16 + i) * S5_HB_ROW + (2 * (32 * pt + r)) * 2) = pk2(nr, ni);
        }
    }
    if (WITH_Y) {
        LDS_WAIT(); asm volatile("" ::: "memory");
        const int c = lane & 15, q = lane >> 4;
#pragma unroll
        for (int hf = 0; hf < 2; ++hf) {
            f32x4 y = (f32x4){0.f, 0.f, 0.f, 0.f};
#pragma unroll
            for (int s = 0; s < 4; ++s) {
                const s5_bf16x8 a = *(const LAS s5_bf16x8*)(hb + (hf * 16 + c) * S5_HB_ROW + (32 * s + 8 * q) * 2);
                y = __builtin_amdgcn_mfma_f32_16x16x32_bf16(a, K.cm[s], y, 0, 0, 0);
            }
            y = __builtin_amdgcn_mfma_f32_16x16x32_bf16(hf ? fg.u1 : fg.u0, K.dm, y, 0, 0, 0);
#pragma unroll
            for (int j = 0; j < 4; ++j) *(LAS unsigned short*)(yt + ((hf * 16 + 4 * q + j) * 16 + c) * 2) = (unsigned short)f2bf(gelu_tanh(y[j]));
        }
        {
            const int hf2 = lane >> 5, t = (lane & 31) >> 1, ck = lane & 1;
            const v4u o = *(const LAS v4u*)(yt + ((hf2 * 16 + t) * 16 + 8 * ck) * 2);
            *(GAS v4u*)(U + (size_t)((hf2 ? base1 : base0) + t) * 1024 + g * 16 + 8 * ck) = o;
        }
        LDS_WAIT(); asm volatile("" ::: "memory");
    }
}

__device__ __forceinline__ void s5_block_unit(Frame& F, int unit, S5Consts& K, int& kg  ) {
    bf16* U = (bf16*)(F.ws + WS_U);
    LAS unsigned char* hb = F.lds + F.wave * S5_HB_WAVE;
    LAS unsigned char* yt = F.lds + S5_YT_OFF + F.wave * 1024;
    LAS float* HE = (LAS float*)(F.lds + S5_HE_OFF);
    const int lane = F.lane, hh = lane >> 5, r = lane & 31, w = F.wave;
    if (unit < S5_PROMPT_UNITS) {
        const int g = unit & 63, bp = unit >> 6;
        FSTAMP(F);
        const int rb0 = bp * SEQ + 256 * w, rb1 = (bp + 4) * SEQ + 256 * w;
        S5Frags pf0 = s5_load_a<false>(F, U, g, rb0, rb1), pf1 = s5_load_a<false>(F, U, g, rb0 + 16, rb1 + 16);
        if (kg != g) { s5_setup(F, g, K); kg = g; }
        FSTAMP(F);
        float hr[2][2], hi[2][2];
#pragma unroll
        for (int a = 0; a < 2; ++a)
#pragma unroll
            for (int b = 0; b < 2; ++b) { hr[a][b] = 0.f; hi[a][b] = 0.f; }
        if (w < 7) {
            S5Frags af = pf0, af1 = pf1;
            for (int s = 0; s < 16; ++s) {
                const int s2 = (s + 2) & 15;
                const S5Frags af2 = s5_load_a<false>(F, U, g, rb0 + 16 * s2, rb1 + 16 * s2);
                s5_step<16, false>(F, K, U, g, rb0 + 16 * s, rb1 + 16 * s, af, hr, hi, hb, yt);
                af = af1; af1 = af2;
            }
        }
        S5Frags qf0 = s5_load_a<true>(F, U, g, rb0, rb1), qf1 = s5_load_a<true>(F, U, g, rb0 + 16, rb1 + 16);
#pragma unroll
        for (int pt = 0; pt < 2; ++pt) { HE[((w * 2 + hh) * 64 + 32 * pt + r) * 2 + 0] = hr[0][pt]; HE[((w * 2 + hh) * 64 + 32 * pt + r) * 2 + 1] = hi[0][pt]; }
        FSTAMP(F);
        __syncthreads();
        FSTAMP(F);
        float l256r[2], l256i[2];
#pragma unroll
        for (int pt = 0; pt < 2; ++pt) { float ar = K.lr[pt], ai = K.li[pt];
#pragma unroll
            for (int k = 0; k < 8; ++k) { const float nr = ar * ar - ai * ai, ni = 2.0f * ar * ai; ar = nr; ai = ni; }
            l256r[pt] = ar; l256i[pt] = ai; hr[0][pt] = 0.f; hi[0][pt] = 0.f; }
        for (int cp = 0; cp < w; ++cp) {
#pragma unroll
            for (int pt = 0; pt < 2; ++pt) {
                const float er = HE[((cp * 2 + hh) * 64 + 32 * pt + r) * 2 + 0], ei = HE[((cp * 2 + hh) * 64 + 32 * pt + r) * 2 + 1];
                const float nr = l256r[pt] * hr[0][pt] - l256i[pt] * hi[0][pt] + er, ni = l256r[pt] * hi[0][pt] + l256i[pt] * hr[0][pt] + ei;
                hr[0][pt] = nr; hi[0][pt] = ni; }
        }
        FSTAMP(F);
        {
            S5Frags af = qf0, af1 = qf1;
            for (int s = 0; s < 16; ++s) {
                const int s2 = (s + 2 < 16) ? s + 2 : 15;
                const S5Frags af2 = s5_load_a<true>(F, U, g, rb0 + 16 * s2, rb1 + 16 * s2);
                s5_step<16, true>(F, K, U, g, rb0 + 16 * s, rb1 + 16 * s, af, hr, hi, hb, yt);
                af = af1; af1 = af2;
            }
        }
        FSTAMP(F);
        if (w == 7) {
            const int b = hh ? bp + 4 : bp;
#pragma unroll
            for (int pt = 0; pt < 2; ++pt) { F.out[O_PBR + (size_t)(b * 64 + g) * 64 + 32 * pt + r] = hr[0][pt]; F.out[O_PBI + (size_t)(b * 64 + g) * 64 + 32 * pt + r] = hi[0][pt]; }
        }
        __syncthreads();
    } else {
        const int su = unit - S5_PROMPT_UNITS, g = su & 63, quarter = su >> 6;
        if (kg != g) { s5_setup(F, g, K); kg = g; }
        for (int qq = 0; qq < 1; ++qq) {
            const int quad = quarter * 8 + w, sb0 = 4 * quad;
            const int base0 = MP + sb0 * 8, base1 = base0 + 16;
            float hr[2][2], hi[2][2];
#pragma unroll
            for (int cs = 0; cs < 2; ++cs)
#pragma unroll
                for (int pt = 0; pt < 2; ++pt) { const int seq = sb0 + 2 * hh + cs; const size_t o = (size_t)(seq * 64 + g) * 64 + 32 * pt + r; hr[cs][pt] = __builtin_nontemporal_load(&F.inp(4)[o]); hi[cs][pt] = __builtin_nontemporal_load(&F.inp(5)[o]); }
            const S5Frags af = s5_load_a<true>(F, U, g, base0, base1);
            s5_step<8, true>(F, K, U, g, base0, base1, af, hr, hi, hb, yt);
#pragma unroll
            for (int cs = 0; cs < 2; ++cs)
#pragma unroll
                for (int pt = 0; pt < 2; ++pt) { const int seq = sb0 + 2 * hh + cs; const size_t o = (size_t)(seq * 64 + g) * 64 + 32 * pt + r; F.out[O_SBR + o] = hr[cs][pt]; F.out[O_SBI + o] = hi[cs][pt]; }
        }
    }
}
constexpr size_t WS_HALO = 230 * MiB;
constexpr size_t WS_CDEC = 234 * MiB;
typedef short ssd_bf16x8 __attribute__((ext_vector_type(8)));
constexpr int SSD_PITCH = 272;

constexpr int SSDS_XS = 0, SSDS_BS = SSDS_XS + 8 * 256 * 4, SSDS_CS = SSDS_BS + 8 * 128 * 4, SSDS_YS = SSDS_CS + 8 * 128 * 4, SSDS_END = SSDS_YS + 8 * 256 * 4;
__device__ __forceinline__ void ssd_sample_unit(Frame& F, int unit) {
    const int b = unit >> 2, g = unit & 3, tid = F.tid, lane = F.lane;
    const bf16* XBC = (const bf16*)(F.ws + WS_XBC); bf16* CAT = (bf16*)(F.ws + WS_CAT);
    const float* DT = (const float*)(F.ws + WS_DT); const float* DA = (const float*)(F.ws + WS_DA);
    LAS float* xs = (LAS float*)(F.lds + SSDS_XS); LAS float* Bs = (LAS float*)(F.lds + SSDS_BS); LAS float* Cs = (LAS float*)(F.lds + SSDS_CS); LAS float* ys = (LAS float*)(F.lds + SSDS_YS);
    const int row0 = MP + b * 8;
    const int p = tid >> 3, ns = tid & 7;
    f32x4 hst[4][4];
#pragma unroll
    for (int e = 0; e < 4; ++e) { const float* sp = F.inp(3) + ((size_t)(b * 16 + 4 * g + e) * 64 + p) * 128 + ns * 4;
#pragma unroll
        for (int k = 0; k < 4; ++k) hst[e][k] = __builtin_nontemporal_load((const f32x4*)(sp + 32 * k)); }
    f32x4 dt4[8], da4[8];
#pragma unroll
    for (int t = 0; t < 8; ++t) { dt4[t] = *(const f32x4*)(DT + (size_t)(row0 + t) * 16 + 4 * g); da4[t] = *(const f32x4*)(DA + (size_t)(row0 + t) * 16 + 4 * g); }
    bf16* zp = CAT + (size_t)(row0 + F.wave) * 2048 + g * 256 + 4 * lane;
    const v2u zw = *(const v2u*)zp;
    {
        const int col = (tid < 256) ? (g * 256 + tid) : ((tid < 384) ? (1024 + g * 128 + (tid - 256)) : (1536 + g * 128 + (tid - 384)));
        const float* cw = F.inp(11); const float w0 = cw[col], w1 = cw[2048 + col], w2 = cw[4096 + col], w3 = cw[6144 + col], bias = F.inp(12)[col];
        const float* st = F.inp(2) + (size_t)b * 3 * 2048 + col;
        float x0 = st[0], x1 = st[2048], x2 = st[4096];
        float xr[8];
#pragma unroll
        for (int t = 0; t < 8; ++t) xr[t] = bf2f(XBC[(size_t)(row0 + t) * 2048 + col]);
#pragma unroll
        for (int t = 0; t < 8; ++t) {
            const float x3 = xr[t];
            const float o = siluf_(bias + w0 * x0 + w1 * x1 + w2 * x2 + w3 * x3);
            if (tid < 256) xs[t * 256 + tid] = o; else if (tid < 384) Bs[t * 128 + (tid - 256)] = o; else Cs[t * 128 + (tid - 384)] = o;
            x0 = x1; x1 = x2; x2 = x3;
        }
    }
    __syncthreads();
#pragma unroll
    for (int e = 0; e < 4; ++e) {
        const int head = 4 * g + e;
        const size_t so = ((size_t)(b * 16 + head) * 64 + p) * 128 + ns * 4;
        const float dsk = F.inp(15)[head];
#pragma unroll
        for (int t = 0; t < 8; ++t) {
            const float dec = __expf(da4[t][e]);
            const float xv = xs[t * 256 + e * 64 + p], dtx = dt4[t][e] * xv;
            float yp = 0.f, yq = 0.f;
#pragma unroll
            for (int k = 0; k < 4; ++k) {
                const f32x4 bv = *(const LAS f32x4*)(Bs + t * 128 + ns * 4 + 32 * k), cv = *(const LAS f32x4*)(Cs + t * 128 + ns * 4 + 32 * k);
                hst[e][k] = hst[e][k] * dec + bv * dtx;
                yp = __builtin_fmaf(cv.x, hst[e][k].x, yp); yq = __builtin_fmaf(cv.y, hst[e][k].y, yq);
                yp = __builtin_fmaf(cv.z, hst[e][k].z, yp); yq = __builtin_fmaf(cv.w, hst[e][k].w, yq);
            }
            yp = dpp_sum8(yp + yq);
            if (ns == 0) ys[t * 256 + e * 64 + p] = yp + dsk * xv;
            asm volatile("" ::: "memory");
        }
#pragma unroll
        for (int k = 0; k < 4; ++k) __builtin_nontemporal_store(hst[e][k], (f32x4*)(F.out + O_SAS + so + 32 * k));
    }
    __syncthreads();
    {
        const int t = F.wave, ch = 4 * lane;
        const f32x4 yv = *(const LAS f32x4*)(ys + t * 256 + ch);
        f32x4 gv; gv.x = yv.x * siluf_(bflo(zw.x)); gv.y = yv.y * siluf_(bfhi(zw.x)); gv.z = yv.z * siluf_(bflo(zw.y)); gv.w = yv.w * siluf_(bfhi(zw.y));
        const float ssq = wave_sum((gv.x * gv.x + gv.y * gv.y) + (gv.z * gv.z + gv.w * gv.w));
        const float rs = __builtin_amdgcn_rsqf(ssq * (1.0f / 256.0f) + EPS);
        const f32x4 nw = *(const f32x4*)(F.inp(16) + g * 256 + ch);
        v2u o; o.x = pk2(gv.x * rs * nw.x, gv.y * rs * nw.y); o.y = pk2(gv.z * rs * nw.z, gv.w * rs * nw.w);
        *(v2u*)zp = o;
    }
    __syncthreads();
}

__device__ __forceinline__ void ssd_cum(Frame& F, int rowc  , int g, LAS float* cum, LAS float* dtl) {
    if (F.wave < 4) {
        const int e = F.wave, l = F.lane; const float* DT = (const float*)(F.ws + WS_DT); const float* DA = (const float*)(F.ws + WS_DA);
        const float a0 = DA[(size_t)(rowc + 2 * l) * 16 + 4 * g + e], a1 = DA[(size_t)(rowc + 2 * l + 1) * 16 + 4 * g + e];
        dtl[e * 128 + 2 * l] = DT[(size_t)(rowc + 2 * l) * 16 + 4 * g + e]; dtl[e * 128 + 2 * l + 1] = DT[(size_t)(rowc + 2 * l + 1) * 16 + 4 * g + e];
        float s = a0 + a1;
#pragma unroll
        for (int o = 1; o < 64; o <<= 1) { const float t = __shfl_up(s, o); if (l >= o) s += t; }
        cum[e * 128 + 2 * l + 1] = s * 1.4426950408889634f; cum[e * 128 + 2 * l] = (s - a1) * 1.4426950408889634f;
    }
}

constexpr int SSD2_XT = 0, SSD2_BT = SSD2_XT + 256 * SSD_PITCH, SSD2_CUM = SSD2_BT + 128 * SSD_PITCH, SSD2_DT = SSD2_CUM + 4 * 128 * 4, SSD2_W = SSD2_DT + 4 * 128 * 4, SSD2_END = SSD2_W + 4 * 128 * 4;
static_assert(SSD2_END <= LDSCTL_OFF, "SSD2 LDS");
__device__ __forceinline__ void ssd_state_unit(Frame& F, int unit) {
    const int g = unit & 3, c = (unit >> 2) & 15, b = unit >> 6, tid = F.tid, lane = F.lane;
    bf16* XBC = (bf16*)(F.ws + WS_XBC); const bf16* HALO = (const bf16*)(F.ws + WS_HALO);
    bf16* SSTB = (bf16*)(F.out + O_Y); float* CDEC = (float*)(F.ws + WS_CDEC);
    LAS unsigned char* XT = F.lds + SSD2_XT; LAS unsigned char* BT = F.lds + SSD2_BT;
    LAS float* cum = (LAS float*)(F.lds + SSD2_CUM); LAS float* dtl = (LAS float*)(F.lds + SSD2_DT); LAS float* wl = (LAS float*)(F.lds + SSD2_W);
    const int rowc = b * SEQ + c * 128;
    {
        const int cp = tid & 255, th = tid >> 8;
        const int kind = (cp < 128) ? 0 : ((cp < 192) ? 1 : 2);
        const int lc = (kind == 0) ? 2 * cp : ((kind == 1) ? 2 * (cp - 128) : 2 * (cp - 192));
        const int col = (kind == 0) ? (g * 256 + lc) : ((kind == 1) ? (1024 + g * 128 + lc) : (1536 + g * 128 + lc));
        const float* cw = F.inp(11);
        const float wa0 = cw[col], wa1 = cw[2048 + col], wa2 = cw[4096 + col], wa3 = cw[6144 + col], ba = F.inp(12)[col];
        const float wb0 = cw[col + 1], wb1 = cw[2048 + col + 1], wb2 = cw[4096 + col + 1], wb3 = cw[6144 + col + 1], bb = F.inp(12)[col + 1];
        const int seg = c * 2 + th;
        float xa0 = 0.f, xa1 = 0.f, xa2 = 0.f, xb0 = 0.f, xb1 = 0.f, xb2 = 0.f;
        if (seg > 0) { const bf16* hp = HALO + ((size_t)(b * 32 + seg - 1) * 3) * 2048 + col;
            const unsigned h0 = *(const unsigned*)hp, h1 = *(const unsigned*)(hp + 2048), h2 = *(const unsigned*)(hp + 4096);
            xa0 = bflo(h0); xb0 = bfhi(h0); xa1 = bflo(h1); xb1 = bfhi(h1); xa2 = bflo(h2); xb2 = bfhi(h2); }
        const int e = lc >> 6;
        bf16* xp = XBC + (size_t)(rowc + 64 * th) * 2048 + col;
        unsigned nxt[8], nx2[8];
#pragma unroll
        for (int k = 0; k < 8; ++k) { nxt[k] = __builtin_nontemporal_load((const unsigned*)(xp + (size_t)k * 2048)); nx2[k] = __builtin_nontemporal_load((const unsigned*)(xp + (size_t)(8 + k) * 2048)); }
        ssd_cum(F, rowc, g, cum, dtl);
        __syncthreads();
        { const int e2 = tid >> 7, j = tid & 127; wl[e2 * 128 + j] = __builtin_amdgcn_exp2f(cum[e2 * 128 + 127] - cum[e2 * 128 + j]) * dtl[e2 * 128 + j];
          if (j == 127) CDEC[(b * 16 + c) * 16 + 4 * g + e2] = __builtin_amdgcn_exp2f(cum[e2 * 128 + 127]); }
        __syncthreads();
        for (int t8 = 0; t8 < 8; ++t8) {
            unsigned raw[8];
#pragma unroll
            for (int k = 0; k < 8; ++k) { raw[k] = nxt[k]; nxt[k] = nx2[k]; }
            if (t8 < 6) {
#pragma unroll
                for (int k = 0; k < 8; ++k) nx2[k] = __builtin_nontemporal_load((const unsigned*)(xp + (size_t)(t8 * 8 + 16 + k) * 2048));
            }
            unsigned oa[4], ob[4]; float pa = 0.f, pb = 0.f;
#pragma unroll
            for (int k = 0; k < 8; ++k) {
                const float xa3 = bflo(raw[k]), xb3 = bfhi(raw[k]);
                const float va = siluf_(ba + wa0 * xa0 + wa1 * xa1 + wa2 * xa2 + wa3 * xa3), vb = siluf_(bb + wb0 * xb0 + wb1 * xb1 + wb2 * xb2 + wb3 * xb3);
                xa0 = xa1; xa1 = xa2; xa2 = xa3; xb0 = xb1; xb1 = xb2; xb2 = xb3;
                *(unsigned*)(xp + (size_t)(t8 * 8 + k) * 2048) = pk2(va, vb);
                float sa = va, sb = vb;
                if (kind == 0) { const float ww = wl[e * 128 + 64 * th + t8 * 8 + k]; sa *= ww; sb *= ww; }
                if (k & 1) { oa[k >> 1] = pk2(pa, sa); ob[k >> 1] = pk2(pb, sb); } else { pa = sa; pb = sb; }
            }
            if (kind == 0) { *(LAS v4u*)(XT + lc * SSD_PITCH + (64 * th + t8 * 8) * 2) = (v4u){oa[0], oa[1], oa[2], oa[3]}; *(LAS v4u*)(XT + (lc + 1) * SSD_PITCH + (64 * th + t8 * 8) * 2) = (v4u){ob[0], ob[1], ob[2], ob[3]}; }
            else if (kind == 1) { *(LAS v4u*)(BT + lc * SSD_PITCH + (64 * th + t8 * 8) * 2) = (v4u){oa[0], oa[1], oa[2], oa[3]}; *(LAS v4u*)(BT + (lc + 1) * SSD_PITCH + (64 * th + t8 * 8) * 2) = (v4u){ob[0], ob[1], ob[2], ob[3]}; }
        }
    }
    __syncthreads();
    {
        const int e = F.wave >> 1, ph = F.wave & 1, r = lane & 31, hh = lane >> 5;
        f32x16 acc[4];
#pragma unroll
        for (int nt = 0; nt < 4; ++nt)
#pragma unroll
            for (int i = 0; i < 16; ++i) acc[nt][i] = 0.f;
#pragma unroll
        for (int s = 0; s < 8; ++s) {
            const ssd_bf16x8 a = *(const LAS ssd_bf16x8*)(XT + (e * 64 + 32 * ph + r) * SSD_PITCH + (16 * s + 8 * hh) * 2);
#pragma unroll
            for (int nt = 0; nt < 4; ++nt) {
                const ssd_bf16x8 bq = *(const LAS ssd_bf16x8*)(BT + (32 * nt + r) * SSD_PITCH + (16 * s + 8 * hh) * 2);
                acc[nt] = __builtin_amdgcn_mfma_f32_32x32x16_bf16(a, bq, acc[nt], 0, 0, 0);
            }
        }
        bf16* sp = SSTB + ((size_t)((b * 16 + c) * 16 + 4 * g + e) * 64 + 32 * ph) * 128;
#pragma unroll
        for (int nt = 0; nt < 4; ++nt)
#pragma unroll
            for (int i = 0; i < 16; ++i) { const int prow = (i & 3) + 8 * (i >> 2) + 4 * hh; sp[(size_t)prow * 128 + 32 * nt + r] = (bf16)f2bf_int(acc[nt][i]); }
    }
    __syncthreads();
}

__device__ __forceinline__ void ssd_carry(Frame& F) {
    bf16* SSTB = (bf16*)(F.out + O_Y); const float* CDEC = (const float*)(F.ws + WS_CDEC);
    const int gt = (int)blockIdx.x * 512 + F.tid, NT = F.G * 512;
    for (int idx = gt; idx < 8 * 16 * 1024; idx += NT) {
        const int q8 = idx & 1023, head = (idx >> 10) & 15, b = idx >> 14;
        float h[8];
#pragma unroll
        for (int k = 0; k < 8; ++k) h[k] = 0.f;
        v4u cur = __builtin_nontemporal_load((const v4u*)(SSTB + ((size_t)((b * 16 + 0) * 16 + head)) * 8192) + q8);
        for (int c = 0; c < 16; ++c) {
            v4u* sp = (v4u*)(SSTB + ((size_t)((b * 16 + c) * 16 + head)) * 8192) + q8;
            const v4u sv = cur;
            if (c < 15) cur = __builtin_nontemporal_load((const v4u*)(SSTB + ((size_t)((b * 16 + c + 1) * 16 + head)) * 8192) + q8);
            *sp = (v4u){pk2(h[0], h[1]), pk2(h[2], h[3]), pk2(h[4], h[5]), pk2(h[6], h[7])};
            const float d = CDEC[(b * 16 + c) * 16 + head];
            h[0] = h[0] * d + bflo(sv.x); h[1] = h[1] * d + bfhi(sv.x); h[2] = h[2] * d + bflo(sv.y); h[3] = h[3] * d + bfhi(sv.y);
            h[4] = h[4] * d + bflo(sv.z); h[5] = h[5] * d + bfhi(sv.z); h[6] = h[6] * d + bflo(sv.w); h[7] = h[7] * d + bfhi(sv.w);
        }
        f32x4* op = (f32x4*)(F.out + O_PAS + (size_t)(b * 16 + head) * 8192) + 2 * q8;
        __builtin_nontemporal_store((f32x4){h[0], h[1], h[2], h[3]}, &op[0]); __builtin_nontemporal_store((f32x4){h[4], h[5], h[6], h[7]}, &op[1]);
    }
}

constexpr int SSD4_ZP = 144, SSD4_OP = 528;
constexpr int SSD4_CS = 0, SSD4_BS = SSD4_CS + 128 * SSD_PITCH, SSD4_L = SSD4_BS + 128 * SSD_PITCH, SSD4_XT = SSD4_L + 128 * SSD_PITCH, SSD4_HIN = SSD4_XT + 64 * SSD_PITCH,
              SSD4_CUM = SSD4_HIN + 64 * SSD_PITCH, SSD4_DT = SSD4_CUM + 4 * 128 * 4, SSD4_RED = SSD4_DT + 4 * 128 * 4, SSD4_END = SSD4_RED + 2 * 128 * 4;
static_assert(SSD4_END <= LDSCTL_OFF && 128 * SSD4_ZP <= 128 * SSD_PITCH && 128 * SSD4_OP <= SSD4_XT, "SSD4 LDS");
__device__ __forceinline__ void ssd_y_unit(Frame& F, int unit) {
    const int g = unit & 3, c = (unit >> 2) & 15, b = unit >> 6, tid = F.tid, lane = F.lane, wv = F.wave, r = lane & 31, hh = lane >> 5;
    const bf16* XBC = (const bf16*)(F.ws + WS_XBC); bf16* CAT = (bf16*)(F.ws + WS_CAT); const bf16* HINB = (const bf16*)(F.out + O_Y);
    LAS unsigned char* Cs = F.lds + SSD4_CS; LAS unsigned char* Bs = F.lds + SSD4_BS; LAS unsigned char* Lm = F.lds + SSD4_L; LAS unsigned char* XT = F.lds + SSD4_XT; LAS unsigned char* Hn = F.lds + SSD4_HIN;
    LAS float* cum = (LAS float*)(F.lds + SSD4_CUM); LAS float* dtl = (LAS float*)(F.lds + SSD4_DT); LAS float* red = (LAS float*)(F.lds + SSD4_RED);
    const int rowc = b * SEQ + c * 128;
    const bool stp = unit < 256;
    if (stp) FSTAMP(F);
    unsigned pre_raw[8]; v4u pre_z[2]; v4u pre_h[2];
#define SSD4_PREFETCH(EE) do { const int _e = (EE); \
        { const int cp = tid & 31, tb = tid >> 5; _Pragma("unroll") for (int k = 0; k < 8; ++k) pre_raw[k] = __builtin_nontemporal_load((const unsigned*)(XBC + (size_t)(rowc + tb * 8 + k) * 2048 + g * 256 + _e * 64 + 2 * cp)); } \
        _Pragma("unroll") for (int k = 0; k < 2; ++k) { const int pc = tid + 512 * k, row = pc >> 3, q = pc & 7; pre_z[k] = __builtin_nontemporal_load((const v4u*)(CAT + (size_t)(rowc + row) * 2048 + g * 256 + _e * 64 + q * 8)); } \
        { const int p = tid >> 3, n0 = (tid & 7) * 16; const v4u* hp = (const v4u*)(HINB + ((size_t)((b * 16 + c) * 16 + 4 * g + _e) * 64 + p) * 128 + n0); \
          pre_h[0] = __builtin_nontemporal_load(&hp[0]); pre_h[1] = __builtin_nontemporal_load(&hp[1]); } } while (0)
    v4u bcb[4], bcc[4];
#pragma unroll
    for (int k = 0; k < 4; ++k) { const int pc = tid + 512 * k, row = pc >> 4, q = pc & 15;
        bcb[k] = __builtin_nontemporal_load((const v4u*)(XBC + (size_t)(rowc + row) * 2048 + 1024 + g * 128 + q * 8)); bcc[k] = __builtin_nontemporal_load((const v4u*)(XBC + (size_t)(rowc + row) * 2048 + 1536 + g * 128 + q * 8)); }
    SSD4_PREFETCH(0);
    ssd_cum(F, rowc, g, cum, dtl);
#pragma unroll
    for (int k = 0; k < 4; ++k) { const int pc = tid + 512 * k, row = pc >> 4, q = pc & 15;
        *(LAS v4u*)(Bs + row * SSD_PITCH + q * 16) = bcb[k]; *(LAS v4u*)(Cs + row * SSD_PITCH + q * 16) = bcc[k]; }
    __syncthreads();
    if (stp) FSTAMP(F);
    const int pw = (0x50317642 >> (4 * wv)) & 7;
    f32x16 G[2];
#pragma unroll
    for (int tt = 0; tt < 2; ++tt) {
        const int idx = 2 * pw + tt, it = idx >> 2, jt = idx & 3;
#pragma unroll
        for (int i = 0; i < 16; ++i) G[tt][i] = 0.f;
        if (jt <= it) {
#pragma unroll
            for (int s = 0; s < 8; ++s) {
                const ssd_bf16x8 a = *(const LAS ssd_bf16x8*)(Cs + (32 * it + r) * SSD_PITCH + (16 * s + 8 * hh) * 2);
                const ssd_bf16x8 bq = *(const LAS ssd_bf16x8*)(Bs + (32 * jt + r) * SSD_PITCH + (16 * s + 8 * hh) * 2);
                G[tt] = __builtin_amdgcn_mfma_f32_32x32x16_bf16(a, bq, G[tt], 0, 0, 0);
            }
        }
    }
    __syncthreads();
    if (stp) FSTAMP(F);
    const int yit = wv >> 1, ypt = wv & 1;
    v4u ya0, yb0, ya1, yb1, ya2, yb2, ya3, yb3;
    float ssq_acc = 0.f;
    for (int e = 0; e < 4; ++e) {
        asm volatile("" ::: "memory");
#pragma unroll
        for (int tt = 0; tt < 2; ++tt) {
            const int idx = 2 * pw + tt, it = idx >> 2, jt = idx & 3;
            const int j = 32 * jt + r;
            if (jt > it) {
                if (e == 0) {
#pragma unroll
                    for (int i16 = 0; i16 < 16; ++i16) { const int i = 32 * it + (i16 & 3) + 8 * (i16 >> 2) + 4 * hh; *(LAS unsigned short*)(Lm + i * SSD_PITCH + j * 2) = (unsigned short)0; }
                }
                continue;
            }
            const float cj = cum[e * 128 + j], dj = dtl[e * 128 + j];
#pragma unroll
            for (int a4 = 0; a4 < 4; ++a4) {
                const f32x4 ci = *(const LAS f32x4*)(cum + e * 128 + 32 * it + 8 * a4 + 4 * hh);
#pragma unroll
                for (int b4 = 0; b4 < 4; ++b4) {
                    const int i16 = 4 * a4 + b4, i = 32 * it + b4 + 8 * a4 + 4 * hh;
                    float v = 0.f;
                    if (j <= i) v = G[tt][i16] * __builtin_amdgcn_exp2f(ci[b4] - cj) * dj;
                    *(LAS unsigned short*)(Lm + i * SSD_PITCH + j * 2) = (unsigned short)f2bf(v);
                }
            }
        }
        { const int cp = tid & 31, tb = tid >> 5;
          v4u oa, ob;
          oa.x = (pre_raw[0] & 0xffffu) | (pre_raw[1] << 16); oa.y = (pre_raw[2] & 0xffffu) | (pre_raw[3] << 16); oa.z = (pre_raw[4] & 0xffffu) | (pre_raw[5] << 16); oa.w = (pre_raw[6] & 0xffffu) | (pre_raw[7] << 16);
          ob.x = (pre_raw[0] >> 16) | (pre_raw[1] & 0xffff0000u); ob.y = (pre_raw[2] >> 16) | (pre_raw[3] & 0xffff0000u); ob.z = (pre_raw[4] >> 16) | (pre_raw[5] & 0xffff0000u); ob.w = (pre_raw[6] >> 16) | (pre_raw[7] & 0xffff0000u);
          *(LAS v4u*)(XT + (2 * cp) * SSD_PITCH + tb * 16) = oa; *(LAS v4u*)(XT + (2 * cp + 1) * SSD_PITCH + tb * 16) = ob; }
#pragma unroll
        for (int k = 0; k < 2; ++k) { const int pc = tid + 512 * k, row = pc >> 3, q = pc & 7; *(LAS v4u*)(Bs + row * SSD4_ZP + q * 16) = pre_z[k]; }
        { const int p = tid >> 3, n0 = (tid & 7) * 16;
          *(LAS v4u*)(Hn + p * SSD_PITCH + n0 * 2) = pre_h[0]; *(LAS v4u*)(Hn + p * SSD_PITCH + n0 * 2 + 16) = pre_h[1]; }
        if (stp && e == 0) FSTAMP(F);
        __syncthreads();
        if (stp && e == 0) FSTAMP(F);
        if (e < 3) SSD4_PREFETCH(e + 1);
        f32x16 yd;
#pragma unroll
        for (int i = 0; i < 16; ++i) yd[i] = 0.f;
#pragma unroll
        for (int s = 0; s < 8; ++s) {
            const ssd_bf16x8 ah = *(const LAS ssd_bf16x8*)(Hn + (32 * ypt + r) * SSD_PITCH + (16 * s + 8 * hh) * 2);
            const ssd_bf16x8 bc = *(const LAS ssd_bf16x8*)(Cs + (32 * yit + r) * SSD_PITCH + (16 * s + 8 * hh) * 2);
            yd = __builtin_amdgcn_mfma_f32_32x32x16_bf16(ah, bc, yd, 0, 0, 0);
        }
        const float dsk = F.inp(15)[4 * g + e];
        const int ti = 32 * yit + r;
        const float ec = __builtin_amdgcn_exp2f(cum[e * 128 + ti]);
#pragma unroll
        for (int i16 = 0; i16 < 16; ++i16) {
            const int pl = 32 * ypt + (i16 & 3) + 8 * (i16 >> 2) + 4 * hh;
            const float xv = bf2f(*(const LAS unsigned short*)(XT + pl * SSD_PITCH + ti * 2));
            yd[i16] = ec * yd[i16] + dsk * xv;
        }
#pragma unroll
        for (int s = 0; s < 8; ++s) {
            const ssd_bf16x8 ax = *(const LAS ssd_bf16x8*)(XT + (32 * ypt + r) * SSD_PITCH + (16 * s + 8 * hh) * 2);
            const ssd_bf16x8 bl = *(const LAS ssd_bf16x8*)(Lm + (32 * yit + r) * SSD_PITCH + (16 * s + 8 * hh) * 2);
            yd = __builtin_amdgcn_mfma_f32_32x32x16_bf16(ax, bl, yd, 0, 0, 0);
        }
#pragma unroll
        for (int g4 = 0; g4 < 4; ++g4) {
            const v2u zw = *(const LAS v2u*)(Bs + ti * SSD4_ZP + (32 * ypt + 8 * g4 + 4 * hh) * 2);
            const float g0 = yd[4 * g4] * siluf_(bflo(zw.x)), g1 = yd[4 * g4 + 1] * siluf_(bfhi(zw.x)), g2 = yd[4 * g4 + 2] * siluf_(bflo(zw.y)), g3 = yd[4 * g4 + 3] * siluf_(bfhi(zw.y));
            yd[4 * g4] = g0; yd[4 * g4 + 1] = g1; yd[4 * g4 + 2] = g2; yd[4 * g4 + 3] = g3;
            ssq_acc += (g0 * g0 + g1 * g1) + (g2 * g2 + g3 * g3);
        }
        { const v4u pa = (v4u){pk2(yd[0], yd[1]), pk2(yd[2], yd[3]), pk2(yd[4], yd[5]), pk2(yd[6], yd[7])}, pb = (v4u){pk2(yd[8], yd[9]), pk2(yd[10], yd[11]), pk2(yd[12], yd[13]), pk2(yd[14], yd[15])};
          if (e == 0) { ya0 = pa; yb0 = pb; } else if (e == 1) { ya1 = pa; yb1 = pb; } else if (e == 2) { ya2 = pa; yb2 = pb; } else { ya3 = pa; yb3 = pb; } }
        __syncthreads();
    }
#undef SSD4_PREFETCH
    const int ti = 32 * yit + r;
    ssq_acc += __shfl_xor(ssq_acc, 32);
    if (hh == 0) red[ypt * 128 + ti] = ssq_acc;
    __syncthreads();
    LAS unsigned char* Ot = F.lds;
    {
        const float rs = __builtin_amdgcn_rsqf((red[ti] + red[128 + ti]) * (1.0f / 256.0f) + EPS);
        const float* nwp = F.inp(16) + g * 256 + 32 * ypt + 4 * hh;
#pragma unroll
        for (int g4 = 0; g4 < 4; ++g4) {
            const unsigned w00 = (g4 == 0) ? ya0.x : (g4 == 1) ? ya0.z : (g4 == 2) ? yb0.x : yb0.z, w01 = (g4 == 0) ? ya0.y : (g4 == 1) ? ya0.w : (g4 == 2) ? yb0.y : yb0.w;
            const unsigned w10 = (g4 == 0) ? ya1.x : (g4 == 1) ? ya1.z : (g4 == 2) ? yb1.x : yb1.z, w11 = (g4 == 0) ? ya1.y : (g4 == 1) ? ya1.w : (g4 == 2) ? yb1.y : yb1.w;
            const unsigned w20 = (g4 == 0) ? ya2.x : (g4 == 1) ? ya2.z : (g4 == 2) ? yb2.x : yb2.z, w21 = (g4 == 0) ? ya2.y : (g4 == 1) ? ya2.w : (g4 == 2) ? yb2.y : yb2.w;
            const unsigned w30 = (g4 == 0) ? ya3.x : (g4 == 1) ? ya3.z : (g4 == 2) ? yb3.x : yb3.z, w31 = (g4 == 0) ? ya3.y : (g4 == 1) ? ya3.w : (g4 == 2) ? yb3.y : yb3.w;
            const f32x4 n0 = *(const f32x4*)(nwp + 8 * g4), n1 = *(const f32x4*)(nwp + 64 + 8 * g4), n2 = *(const f32x4*)(nwp + 128 + 8 * g4), n3 = *(const f32x4*)(nwp + 192 + 8 * g4);
            LAS unsigned char* op = Ot + ti * SSD4_OP + (32 * ypt + 8 * g4 + 4 * hh) * 2;
            *(LAS v2u*)(op)       = (v2u){pk2(bflo(w00) * rs * n0.x, bfhi(w00) * rs * n0.y), pk2(bflo(w01) * rs * n0.z, bfhi(w01) * rs * n0.w)};
            *(LAS v2u*)(op + 128) = (v2u){pk2(bflo(w10) * rs * n1.x, bfhi(w10) * rs * n1.y), pk2(bflo(w11) * rs * n1.z, bfhi(w11) * rs * n1.w)};
            *(LAS v2u*)(op + 256) = (v2u){pk2(bflo(w20) * rs * n2.x, bfhi(w20) * rs * n2.y), pk2(bflo(w21) * rs * n2.z, bfhi(w21) * rs * n2.w)};
            *(LAS v2u*)(op + 384) = (v2u){pk2(bflo(w30) * rs * n3.x, bfhi(w30) * rs * n3.y), pk2(bflo(w31) * rs * n3.z, bfhi(w31) * rs * n3.w)};
        }
    }
    __syncthreads();
#pragma unroll
    for (int k = 0; k < 8; ++k) { const int pc = tid + 512 * k, row = pc >> 5, q = pc & 31;
        *(v4u*)(CAT + (size_t)(rowc + row) * 2048 + g * 256 + q * 8) = *(const LAS v4u*)(Ot + row * SSD4_OP + q * 16); }
    __syncthreads();
}
constexpr size_t WS_WDWT = 235 * MiB;
typedef float cf32x2 __attribute__((ext_vector_type(2)));
template <int T, int NT, bool SAMPLE>
__device__ __forceinline__ void cconv_run(Frame& F, int row0  , bool has_hist  , const float* state  ) {
    const bf16* G = (const bf16*)(F.ws + WS_G); bf16* CV = (bf16*)(F.ws + WS_CV); const float* WT = (const float*)(F.ws + WS_WDWT);
    const int tid = F.tid, lane = F.lane;
    constexpr int ROWS = T + 30;
    const unsigned* gp = (const unsigned*)(G + (size_t)row0 * 1024) + tid;
    cf32x2 xv[ROWS], wv[31];
    {
        unsigned cur[T];
        if (SAMPLE) {
            cf32x2 sv[30];
#pragma unroll
            for (int k = 0; k < 30; ++k) sv[k] = __builtin_nontemporal_load((const cf32x2*)(state + (size_t)k * 1024 + 2 * tid));
#pragma unroll
            for (int k = 0; k < T; ++k) cur[k] = __builtin_nontemporal_load(&gp[k * 512]);
#pragma unroll
            for (int k = 0; k < 30; ++k) xv[k] = sv[k];
        } else {
            unsigned xr[30];
#pragma unroll
            for (int k = 0; k < 30; ++k) xr[k] = 0u;
            if (has_hist) {
#pragma unroll
                for (int k = 0; k < 30; ++k) xr[k] = __builtin_nontemporal_load(&gp[(k - 30) * 512]);
            }
#pragma unroll
            for (int k = 0; k < T; ++k) cur[k] = __builtin_nontemporal_load(&gp[k * 512]);
#pragma unroll
            for (int k = 0; k < 30; ++k) xv[k] = (cf32x2){bflo(xr[k]), bfhi(xr[k])};
        }
        { const f32x4* wp = (const f32x4*)(WT + (size_t)(2 * tid) * 32);
#pragma unroll
          for (int k4 = 0; k4 < 8; ++k4) { const f32x4 t4 = wp[k4], u4 = wp[8 + k4];
              wv[4 * k4] = (cf32x2){t4.x, u4.x}; wv[4 * k4 + 1] = (cf32x2){t4.y, u4.y}; wv[4 * k4 + 2] = (cf32x2){t4.z, u4.z}; if (k4 < 7) wv[4 * k4 + 3] = (cf32x2){t4.w, u4.w}; } }
#pragma unroll
        for (int k = 0; k < T; ++k) xv[30 + k] = (cf32x2){bflo(cur[k]), bfhi(cur[k])};
    }
    const cf32x2 bias2 = *(const cf32x2*)(F.inp(31) + 2 * tid);
    const cf32x2 lw = *(const cf32x2*)(F.inp(32) + 2 * tid), lb = *(const cf32x2*)(F.inp(33) + 2 * tid);
    LAS float* red = (LAS float*)(F.lds);
#pragma unroll 1
    for (int tile = 0; tile < NT; ++tile) {
        unsigned nx[T];
        if (tile + 1 < NT) {
#pragma unroll
            for (int k = 0; k < T; ++k) nx[k] = __builtin_nontemporal_load(&gp[((tile + 1) * T + k) * 512]);
        }
        float o0[T], o1[T];
#pragma unroll
        for (int t = 0; t < T; ++t) {
            cf32x2 a0 = bias2, a1 = (cf32x2){0.f, 0.f};
#pragma unroll
            for (int k = 0; k < 30; k += 2) { a0 += wv[k] * xv[t + k]; a1 += wv[k + 1] * xv[t + k + 1]; }
            a0 += wv[30] * xv[t + 30];
            a0 += a1;
            o0[t] = a0.x; o1[t] = a0.y;
        }
        LAS float* rb = red + (tile & 1) * 256;
        if constexpr (T == 16) {
            float rs, rq;
            { float sa[16];
#pragma unroll
              for (int t = 0; t < 16; ++t) sa[t] = o0[t] + o1[t];
              rs = row16_reduce_scatter(sa, lane); }
            asm volatile("" ::: "memory");
            { float qa[16];
#pragma unroll
              for (int t = 0; t < 16; ++t) qa[t] = o0[t] * o0[t] + o1[t] * o1[t];
              rq = row16_reduce_scatter(qa, lane); }
            rs += __shfl_xor(rs, 16); rq += __shfl_xor(rq, 16); rs += __shfl_xor(rs, 32); rq += __shfl_xor(rq, 32);
            if (lane < 16) { rb[lane * 16 + F.wave] = rs; rb[lane * 16 + 8 + F.wave] = rq; }
        } else {
#pragma unroll
            for (int t = 0; t < T; ++t) { const float s = wave_sum(o0[t] + o1[t]), q = wave_sum(o0[t] * o0[t] + o1[t] * o1[t]); if (lane == 0) { rb[t * 16 + F.wave] = s; rb[t * 16 + 8 + F.wave] = q; } }
        }
        __syncthreads();
        bf16* cvp = CV + (size_t)(row0 + tile * T) * 1024 + 2 * tid;
        float meanv, rstdv;
        { const int tl = lane & (T - 1);
          const f32x4 s0 = *(const LAS f32x4*)(rb + tl * 16), s1 = *(const LAS f32x4*)(rb + tl * 16 + 4), q0 = *(const LAS f32x4*)(rb + tl * 16 + 8), q1 = *(const LAS f32x4*)(rb + tl * 16 + 12);
          const float s = ((s0.x + s0.y) + (s0.z + s0.w)) + ((s1.x + s1.y) + (s1.z + s1.w)), q = ((q0.x + q0.y) + (q0.z + q0.w)) + ((q1.x + q1.y) + (q1.z + q1.w));
          meanv = s * (1.0f / 1024.0f); const float var = fmaxf(q * (1.0f / 1024.0f) - meanv * meanv, 0.f); rstdv = __builtin_amdgcn_rsqf(var + EPS); }
#pragma unroll
        for (int t = 0; t < T; ++t) {
            const float mean = __builtin_bit_cast(float, __builtin_amdgcn_readlane(__builtin_bit_cast(int, meanv), t)), rstd = __builtin_bit_cast(float, __builtin_amdgcn_readlane(__builtin_bit_cast(int, rstdv), t));
            *(unsigned*)(cvp + (size_t)t * 1024) = pk2(siluf_((o0[t] - mean) * rstd * lw.x + lb.x), siluf_((o1[t] - mean) * rstd * lw.y + lb.y));
            asm volatile("" ::: "memory");
        }
        if (tile + 1 < NT) {
#pragma unroll
            for (int k = 0; k < 30; ++k) xv[k] = xv[k + T];
#pragma unroll
            for (int k = 0; k < T; ++k) xv[30 + k] = (cf32x2){bflo(nx[k]), bfhi(nx[k])};
        }
    }
    __syncthreads();
}
constexpr int CCONV_RUNS = NBP * (SEQ / 64);
__device__ __forceinline__ void cconv_phase(Frame& F) {
    for (int b = (int)blockIdx.x; b < NBS; b += F.G) cconv_run<8, 1, true>(F, MP + 8 * b, false, F.inp(6) + (size_t)b * 30 * 1024);
    for (int u = F.vcu; u < CCONV_RUNS; u += F.G) { const int b = u >> 5, j = u & 31; cconv_run<16, 4, false>(F, b * SEQ + 64 * j, j > 0, nullptr); }
    { const bool split = (int)F.G >= 2 * NBS;
      constexpr int P9_SMALL = NBS * NWAVES;
      __syncthreads();
      if (!split) p0_weights(F, P0_PW1_ITEMS, P0_ALL_ITEMS);
      else if ((int)blockIdx.x < NBS) p0_weights(F, P0_PW1_ITEMS, P0_PW1_ITEMS + P9_SMALL, (int)blockIdx.x * NWAVES + F.wave, NBS * NWAVES);
      else p0_weights(F, P0_PW1_ITEMS + P9_SMALL, P0_ALL_ITEMS, ((int)blockIdx.x - NBS) * NWAVES + F.wave, ((int)F.G - NBS) * NWAVES);
      __syncthreads(); }
    for (int b = (int)F.G - 1 - (int)blockIdx.x; b < NBS; b += F.G) { const float* st = F.inp(6) + (size_t)b * 30 * 1024;
        for (int i = F.tid; i < 22 * 256; i += NWAVES * 64) __builtin_nontemporal_store(__builtin_nontemporal_load(&((const f32x4*)(st + 8 * 1024))[i]), &((f32x4*)(F.out + O_SCC + (size_t)b * 30 * 1024))[i]);
    }
}
#define P2_WEIGHTS() do { __syncthreads(); p0_weights(F, P0_WIN_ITEMS, P0_L0_ITEMS); __syncthreads(); } while (0)
#define PHASE2_BODY { \
    const bool wfirst = ((bx >> 4) & 1) != 0; \
    if (wfirst) P2_WEIGHTS(); \
    if ((bx >> 3) & 1) { for (int u = bx; u < 512; u += F.G) ssd_sample_unit(F, u); TSTAMP(); } \
    { S5Consts K5; int kg = -1; for (int u = bx; u < S5_UNITS; u += F.G) s5_block_unit(F, u, K5, kg); } \
    __syncthreads(); TSTAMP(); \
    if (!wfirst) P2_WEIGHTS(); \
    for (int u = bx; u < 512; u += F.G) ssd_state_unit(F, u); TSTAMP(); \
    if (!((bx >> 3) & 1)) { for (int u = bx; u < 512; u += F.G) ssd_sample_unit(F, u); TSTAMP(); } }
#define PHASE3_BODY { ssd_carry(F); }
#define PHASE4_GLU() do { \
        { const int _pre = (F.vcu & 1); pg8::gemm_tail<pg8::EpiGlu>(lds_s + RING_OFF, g.A + (size_t)MP * g.lda, g.lda, g.Bt, g.K, g.N / 64, E, F.vcu, F.G, 0, _pre); } \
        pg8::gemm_phase<pg8::EpiGlu, pg8::StaticOrder, true, true>(lds_s + RING_OFF, g, S, E); \
        { const int _pre = (F.vcu & 1); pg8::gemm_tail<pg8::EpiGlu>(lds_s + RING_OFF, g.A + (size_t)MP * g.lda, g.lda, g.Bt, g.K, g.N / 64, E, F.vcu, F.G, _pre, 1); } } while (0)
#define PHASE4_BODY { \
    pg8::Gemm g{U, (const bf16*)(F.ws + WS_WGLU), MT, 1024, 1024, 1024}; pg8::StaticOrder S; S.init(MP, 1024, F.G, bx); \
    pg8::EpiGlu E{U, CAT, F.inp(26)}; \
    const bool glu_first = ((F.vcu >> 1) & 1) != 0;                        \
    if (!glu_first) { __syncthreads(); p0_weights(F, P0_L0_ITEMS, P0_PW1_ITEMS); __syncthreads(); }        \
    if (glu_first) PHASE4_GLU(); \
    for (int u = bx; u < 512; u += F.G) ssd_y_unit(F, u); TSTAMP(); \
    if (glu_first) { __syncthreads(); p0_weights(F, P0_L0_ITEMS, P0_PW1_ITEMS); __syncthreads(); } \
    if (!glu_first) PHASE4_GLU(); \
    TSTAMP(); }
#define PHASE9_BODY { cconv_phase(F); }
struct Args { const float* in[38]; float* out; unsigned char* ws; int ph_lo, ph_hi; };
constexpr int N_PHASES = 14;

__global__ void __launch_bounds__(NWAVES * 64, 2) hybrid_fwd(Args args) {
    extern __shared__ __attribute__((aligned(16))) unsigned char lds[];
    Frame F;
    { unsigned vz; asm volatile("v_mov_b32 %0, 0" : "=v"(vz)); F.lds = (LAS unsigned char*)lds + vz; }
    LAS unsigned char* const lds_s = (LAS unsigned char*)lds;
    F.MISC = (volatile LAS unsigned*)(F.lds + MISC_OFF);
    F.tid = threadIdx.x; F.lane = F.tid & 63; F.wave = __builtin_amdgcn_readfirstlane(F.tid >> 6);
    F.G = gridDim.x; { const int bx = blockIdx.x; F.vcu = (F.G % 8 == 0) ? (bx % 8) * (F.G / 8) + bx / 8 : bx; }
    F.ws = args.ws; F.out = args.out; F.ctl = (gu32*)(args.ws + WS_CTL);
    F.in = (LAS cfp*)(F.lds + PTRTAB_OFF);
    for (int u = F.tid; u < (LDS_BYTES - LDSCTL_OFF) / 4; u += NWAVES * 64) ((LAS unsigned*)(F.lds + LDSCTL_OFF))[u] = 0u;
    __syncthreads();
    if (F.tid < 38) F.in[F.tid] = args.in[F.tid];
    __syncthreads();
    XcdBarrier bar = xcd_barrier_post((unsigned*)(F.ctl + CW_BAR), F.MISC + 8);
    const int lo = args.ph_lo, hi = args.ph_hi;
#define IN(k) (lo <= (k) && (k) < hi)
#if defined(MK_TIMING)
    volatile LAS unsigned* TS = (volatile LAS unsigned*)(F.lds + LDSCTL_OFF);
    F.nts = 0;
#define TSTAMP() FSTAMP(F)
#define SEAM(k) do { if (IN(k) && IN((k) + 1)) xcd_barrier(bar); TSTAMP(); } while (0)
    TSTAMP();
#else
#define TSTAMP() do {} while (0)
#define SEAM(k) do { if (IN(k) && IN((k) + 1)) xcd_barrier(bar); } while (0)
#endif

    bf16* CAT = (bf16*)(F.ws + WS_CAT); bf16* XBC = (bf16*)(F.ws + WS_XBC); bf16* U = (bf16*)(F.ws + WS_U); bf16* XB = (bf16*)(F.ws + WS_XB);
    bf16* H = (bf16*)(F.ws + WS_H); bf16* Gb = (bf16*)(F.ws + WS_G); bf16* CV = (bf16*)(F.ws + WS_CV);
    float* SS = (float*)(F.ws + WS_SS); float* X = F.out + O_Y;
    const int bx = (int)blockIdx.x;

    if (IN(0)) { p0_prologue(F); } SEAM(0);
    if (IN(1)) {
        pg8::Gemm g{CAT + 1024, (const bf16*)(F.ws + WS_WIN), MT, 4096, 1024, 2048}; pg8::StaticOrder S; S.init(MP, 4096, F.G, bx);
        pg8::EpiInProj E{CAT, XBC, U, SS, F.out, (bf16*)(F.ws + WS_HALO)};
        if ((F.vcu & 1)) pg8::gemm_tail_wide<4, pg8::EpiInProj>(lds_s + RING_OFF, g.A + (size_t)MP * g.lda, g.lda, g.Bt, g.K, E, F.vcu, F.G);
        pg8::gemm_phase<pg8::EpiInProj, pg8::StaticOrder, true, true>(lds_s + RING_OFF, g, S, E, SS); TSTAMP();
        if (!(F.vcu & 1)) pg8::gemm_tail_wide<4, pg8::EpiInProj>(lds_s + RING_OFF, g.A + (size_t)MP * g.lda, g.lda, g.Bt, g.K, E, F.vcu, F.G);
    } SEAM(1);
    if (IN(2)) { PHASE2_BODY } SEAM(2);
    if (IN(3)) { PHASE3_BODY } SEAM(3);
    if (IN(4)) { PHASE4_BODY } SEAM(4);
    if (IN(5)) {
        pg8::Gemm g{CAT, (const bf16*)(F.ws + WS_WOUT), MT, 1024, 2048, 2048}; pg8::StaticOrder S; S.init(MP, 1024, F.G, bx);
        pg8::EpiRes E{F.inp(0), F.inp(1), nullptr, nullptr, XB, SS, nullptr};
        { const int _n = (g.N / 64) * 16 / F.G, _pre = (_n == 1) ? (F.vcu & 1) : ((_n * (F.vcu & 3)) >> 2); pg8::gemm_tail<pg8::EpiRes>(lds_s + RING_OFF, g.A + (size_t)MP * g.lda, g.lda, g.Bt, g.K, g.N / 64, E, F.vcu, F.G, 0, _pre); }
        pg8::gemm_phase<pg8::EpiRes, pg8::StaticOrder, true, true>(lds_s + RING_OFF, g, S, E); TSTAMP();
        { const int _n = (g.N / 64) * 16 / F.G, _pre = (_n == 1) ? (F.vcu & 1) : ((_n * (F.vcu & 3)) >> 2); pg8::gemm_tail<pg8::EpiRes>(lds_s + RING_OFF, g.A + (size_t)MP * g.lda, g.lda, g.Bt, g.K, g.N / 64, E, F.vcu, F.G, _pre, _n); }
    } SEAM(5);
    if (IN(6)) {
        pg8::Gemm g{XB, (const bf16*)(F.ws + WS_WFF1), MT, FF, 1024, 1024}; pg8::StaticOrder S; S.init(MP, FF, F.G, bx);
        pg8::EpiFF1 E{H, SS};
        if ((F.vcu & 1)) pg8::gemm_tail_wide<4, pg8::EpiFF1>(lds_s + RING_OFF, g.A + (size_t)MP * g.lda, g.lda, g.Bt, g.K, E, F.vcu, F.G);
        pg8::gemm_phase<pg8::EpiFF1, pg8::StaticOrder, true, true>(lds_s + RING_OFF, g, S, E, SS); TSTAMP();
        if (!(F.vcu & 1)) pg8::gemm_tail_wide<4, pg8::EpiFF1>(lds_s + RING_OFF, g.A + (size_t)MP * g.lda, g.lda, g.Bt, g.K, E, F.vcu, F.G);
    } SEAM(6);
    if (IN(7)) {
        pg8::Gemm g{H, (const bf16*)(F.ws + WS_WFF2), MT, 1024, FF, FF}; pg8::StaticOrder S; S.init(MP, 1024, F.G, bx);
        pg8::EpiRes E{nullptr, nullptr, XB, nullptr, XB, SS, nullptr};
        { const int _n = (g.N / 64) * 16 / F.G, _pre = (_n == 1) ? (F.vcu & 1) : ((_n * (F.vcu & 3)) >> 2); pg8::gemm_tail<pg8::EpiRes>(lds_s + RING_OFF, g.A + (size_t)MP * g.lda, g.lda, g.Bt, g.K, g.N / 64, E, F.vcu, F.G, 0, _pre); }
        pg8::gemm_phase<pg8::EpiRes, pg8::StaticOrder, true, true>(lds_s + RING_OFF, g, S, E); TSTAMP();
        { const int _n = (g.N / 64) * 16 / F.G, _pre = (_n == 1) ? (F.vcu & 1) : ((_n * (F.vcu & 3)) >> 2); pg8::gemm_tail<pg8::EpiRes>(lds_s + RING_OFF, g.A + (size_t)MP * g.lda, g.lda, g.Bt, g.K, g.N / 64, E, F.vcu, F.G, _pre, _n); }
    } SEAM(7);
    if (IN(8)) {
        pg8::Gemm g{XB, (const bf16*)(F.ws + WS_WPW1), MT, 2048, 1024, 1024}; pg8::StaticOrder S; S.init(MP, 2048, F.G, bx);
        pg8::EpiPw1 E{Gb, SS, F.inp(29), F.out};
        if ((F.vcu & 1)) pg8::gemm_tail_wide<2, pg8::EpiPw1>(lds_s + RING_OFF, g.A + (size_t)MP * g.lda, g.lda, g.Bt, g.K, E, F.vcu, F.G);
        pg8::gemm_phase<pg8::EpiPw1, pg8::StaticOrder, true, true>(lds_s + RING_OFF, g, S, E, SS); TSTAMP();
        if (!(F.vcu & 1)) pg8::gemm_tail_wide<2, pg8::EpiPw1>(lds_s + RING_OFF, g.A + (size_t)MP * g.lda, g.lda, g.Bt, g.K, E, F.vcu, F.G);
    } SEAM(8);
    if (IN(9)) { PHASE9_BODY } SEAM(9);
    if (IN(10)) {
        pg8::Gemm g{CV, (const bf16*)(F.ws + WS_WPW2), MT, 1024, 1024, 1024}; pg8::StaticOrder S; S.init(MP, 1024, F.G, bx);
        pg8::EpiRes E{nullptr, nullptr, XB, nullptr, XB, SS, F.inp(35)};
        { const int _n = (g.N / 64) * 16 / F.G, _pre = (_n == 1) ? (F.vcu & 1) : ((_n * (F.vcu & 3)) >> 2); pg8::gemm_tail<pg8::EpiRes>(lds_s + RING_OFF, g.A + (size_t)MP * g.lda, g.lda, g.Bt, g.K, g.N / 64, E, F.vcu, F.G, 0, _pre); }
        pg8::gemm_phase<pg8::EpiRes, pg8::StaticOrder, true, true>(lds_s + RING_OFF, g, S, E); TSTAMP();
        { const int _n = (g.N / 64) * 16 / F.G, _pre = (_n == 1) ? (F.vcu & 1) : ((_n * (F.vcu & 3)) >> 2); pg8::gemm_tail<pg8::EpiRes>(lds_s + RING_OFF, g.A + (size_t)MP * g.lda, g.lda, g.Bt, g.K, g.N / 64, E, F.vcu, F.G, _pre, _n); }
    } SEAM(10);
    if (IN(11)) {
        pg8::Gemm g{XB, (const bf16*)(F.ws + WS_WFF1) + (size_t)FF * 1024, MT, FF, 1024, 1024}; pg8::StaticOrder S; S.init(MP, FF, F.G, bx);
        pg8::EpiFF1 E{H, SS};
        if ((F.vcu & 1)) pg8::gemm_tail_wide<4, pg8::EpiFF1>(lds_s + RING_OFF, g.A + (size_t)MP * g.lda, g.lda, g.Bt, g.K, E, F.vcu, F.G);
        pg8::gemm_phase<pg8::EpiFF1, pg8::StaticOrder, true, true>(lds_s + RING_OFF, g, S, E, SS); TSTAMP();
        if (!(F.vcu & 1)) pg8::gemm_tail_wide<4, pg8::EpiFF1>(lds_s + RING_OFF, g.A + (size_t)MP * g.lda, g.lda, g.Bt, g.K, E, F.vcu, F.G);
    } SEAM(11);
    if (IN(12)) {
        pg8::Gemm g{H, (const bf16*)(F.ws + WS_WFF2) + (size_t)1024 * FF, MT, 1024, FF, FF}; pg8::StaticOrder S; S.init(MP, 1024, F.G, bx);
        pg8::EpiRes E{nullptr, nullptr, XB, nullptr, XB, SS, nullptr};
        { const int _n = (g.N / 64) * 16 / F.G, _pre = (_n == 1) ? (F.vcu & 1) : ((_n * (F.vcu & 3)) >> 2); pg8::gemm_tail<pg8::EpiRes>(lds_s + RING_OFF, g.A + (size_t)MP * g.lda, g.lda, g.Bt, g.K, g.N / 64, E, F.vcu, F.G, 0, _pre); }
        pg8::gemm_phase<pg8::EpiRes, pg8::StaticOrder, true, true>(lds_s + RING_OFF, g, S, E); TSTAMP();
        { const int _n = (g.N / 64) * 16 / F.G, _pre = (_n == 1) ? (F.vcu & 1) : ((_n * (F.vcu & 3)) >> 2); pg8::gemm_tail<pg8::EpiRes>(lds_s + RING_OFF, g.A + (size_t)MP * g.lda, g.lda, g.Bt, g.K, g.N / 64, E, F.vcu, F.G, _pre, _n); }
    } SEAM(12);
    if (IN(13)) {
        const int gw = F.vcu * NWAVES + F.wave, NGW = F.G * NWAVES; const float* nf = F.inp(9);
        f32x4 wv[4];
#pragma unroll
        for (int j = 0; j < 2; ++j) { wv[2 * j] = ((const f32x4*)nf)[128 * j + 2 * F.lane]; wv[2 * j + 1] = ((const f32x4*)nf)[128 * j + 2 * F.lane + 1]; }
        for (int m = gw; m < MT; m += NGW) {
            const float rs = row_rstd(SS, m);
            const v4u* xb = (const v4u*)(XB + (size_t)m * DM) + F.lane;
            f32x4* yr = (f32x4*)(X + (size_t)m * DM) + 2 * F.lane;
#pragma unroll
            for (int j = 0; j < 2; ++j) { const v4u w = __builtin_nontemporal_load(&xb[64 * j]);
                __builtin_nontemporal_store((f32x4){bflo(w.x), bfhi(w.x), bflo(w.y), bfhi(w.y)} * rs * wv[2 * j], &yr[128 * j]);
                __builtin_nontemporal_store((f32x4){bflo(w.z), bfhi(w.z), bflo(w.w), bfhi(w.w)} * rs * wv[2 * j + 1], &yr[128 * j + 1]); }
        }
    }
#if defined(MK_TIMING)
    TSTAMP();
    xcd_barrier(bar);
    if (blockIdx.x == 0) {
        __syncthreads();
#if defined(MK_COLDPROBE)
        { volatile unsigned* cwp = (volatile unsigned*)(F.ws + 65536 + 256); volatile unsigned* store = (volatile unsigned*)(F.ws + 65536 + 512);
          const bool cold = (*cwp == 0xAAAAAAAAu);
          __syncthreads();
          if (F.tid < 64) { if (cold) store[F.tid] = TS[F.tid]; else TS[F.tid] = store[F.tid]; }
          __syncthreads();
          if (F.tid == 0) *cwp = 0x12345678u;
          __syncthreads(); }
#endif
        const size_t offs[12] = {O_Y, O_Y + (size_t)MP * 1024, O_PAC, O_PAS, O_PBR, O_PBI, O_PCC, O_SAC, O_SAS, O_SBR, O_SBI, O_SCC};
#pragma unroll
        for (int k = 0; k < 12; ++k) {
            const unsigned t0 = TS[MK_TIMING + k], t1 = (MK_TIMING + k + 1 < F.nts) ? TS[MK_TIMING + k + 1] : t0;
#if defined(MK_DEBUGCNT)
            const unsigned us = __hip_atomic_load((unsigned*)(F.ws + WS_CTL) + 2048 + k, __ATOMIC_RELAXED, __HIP_MEMORY_SCOPE_AGENT);
#else
            const unsigned us = (t1 - t0) / 100u;
#endif
            for (unsigned i = F.tid; i < us; i += NWAVES * 64) ((unsigned*)F.out)[offs[k] + i] = 0xAAAAAAAAu;
        }
    }
#endif
#undef IN
#undef SEAM
}

extern "C" void kernel_launch(void* const* d_in, const int* in_sizes, int n_in, void* d_out, int out_size, void* d_ws, size_t ws_size, hipStream_t stream) {
    static int grid = 0;
    if (grid == 0) {
        if (n_in != 38 || out_size != (int)O_END || ws_size < WS_END) { fprintf(stderr, "kernel_launch: unexpected shapes: n_in %d out %d ws %zu\n", n_in, out_size, ws_size); grid = -1; return; }
        int dev = 0, cus = 0, per_cu = 0;
        if (hipGetDevice(&dev) != hipSuccess || hipDeviceGetAttribute(&cus, hipDeviceAttributeMultiprocessorCount, dev) != hipSuccess) { grid = -1; return; }
        if (hipFuncSetAttribute((const void*)hybrid_fwd, hipFuncAttributeMaxDynamicSharedMemorySize, LDS_BYTES) != hipSuccess) { fprintf(stderr, "kernel_launch: hipFuncSetAttribute failed\n"); grid = -1; return; }
        if (hipOccupancyMaxActiveBlocksPerMultiprocessor(&per_cu, (const void*)hybrid_fwd, NWAVES * 64, LDS_BYTES) != hipSuccess || per_cu < 1)
            fprintf(stderr, "kernel_launch: note: occupancy query reports %d blocks per CU\n", per_cu);
        (void)hipGetLastError();
        grid = cus;
    }
    if (grid < 0) return;
    if (hipMemsetAsync((char*)d_ws + WS_CTL, 0, CTL_ZERO_BYTES, stream) != hipSuccess) { fprintf(stderr, "kernel_launch: memset failed\n"); return; }
    Args a{};
    for (int i = 0; i < 38; ++i) a.in[i] = (const float*)d_in[i];
    a.out = (float*)d_out; a.ws = (unsigned char*)d_ws;
#if MK_N_LAUNCHES == 1
    a.ph_lo = 0; a.ph_hi = N_PHASES;
    hipLaunchKernelGGL(hybrid_fwd, dim3(grid), dim3(NWAVES * 64), LDS_BYTES, stream, a);
#else
    for (int p = 0; p < N_PHASES; ++p) { a.ph_lo = p; a.ph_hi = p + 1; hipLaunchKernelGGL(hybrid_fwd, dim3(grid), dim3(NWAVES * 64), LDS_BYTES, stream, a); }
#endif
    const hipError_t le = hipPeekAtLastError();
    if (le != hipSuccess) fprintf(stderr, "kernel_launch: launch failed: %s\n", hipGetErrorName(le));
}
```

```cpp
#include <hip/hip_runtime.h>
#include <cstdio>
#include <cstdint>
#ifndef MK_N_LAUNCHES
#define MK_N_LAUNCHES 1
#endif
__device__ __forceinline__ float row_rstd(const float* SS, int r);
namespace pg8 {
#define PG8_LAS __attribute__((address_space(3)))
typedef unsigned short bf16_t;
typedef short bf16x8 __attribute__((ext_vector_type(8)));
typedef float f32x4 __attribute__((ext_vector_type(4)));
typedef unsigned u32x4 __attribute__((ext_vector_type(4)));
typedef unsigned u32x2 __attribute__((ext_vector_type(2)));
constexpr int BM = 256, BK = 64, HALF = 128, HTB = HALF * BK * 2  , STAGE_BYTES = 8 * HTB, NXCD = 8, WGM = 8;

__host__ __device__ __forceinline__ int lds_byte(int r, int c) { const int st = (r >> 4) * 2 + (c >> 5), rr = r & 15, cc = c & 31, ob = rr * 64 + cc * 2; return st * 1024 + (ob ^ (((ob >> 9) & 1) << 5)); }
__host__ __device__ __forceinline__ void stage_rc(int b, int& R, int& C) { const int st = b / 1024, sb = b % 1024, swz = sb ^ (((sb >> 9) & 1) << 5); R = (st >> 1) * 16 + swz / 64; C = (st & 1) * 32 + (swz % 64) / 2; }
__host__ __device__ __forceinline__ int perm32(int rho) { const int n = rho >> 4, i = rho & 15; return 8 * (i >> 2) + 4 * n + (i & 3); }

struct Unit { int pm, pn; };
struct Gemm { const bf16_t* A; const bf16_t* Bt; int M, N, K, lda; };

struct StaticOrder {
    int nM, nN, nwg, G, c;
    __host__ __device__ void init(int M, int N, int G_, int c_) { nM = M / BM; nN = N / BM; nwg = nM * nN; G = G_; c = c_; }
    __host__ __device__ bool next(int i, Unit& u) const {
        const long L = (long)i * G + c; if (L >= nwg) return false;
        int wgid = (int)L; { const int q = nwg / NXCD, r = nwg % NXCD, xcd = wgid % NXCD, off = wgid / NXCD; wgid = (xcd < r ? xcd * (q + 1) : r * (q + 1) + (xcd - r) * q) + off; }
        const int nig = WGM * nN, gid = wgid / nig, fm = gid * WGM, gsz = (nM - fm) < WGM ? (nM - fm) : WGM;
        u.pm = fm + ((wgid % nig) % gsz); u.pn = (wgid % nig) / gsz; return true;
    }
};

__device__ __forceinline__ unsigned cvt_pk_bf16(float lo, float hi) { unsigned r; asm volatile("v_cvt_pk_bf16_f32 %0, %1, %2" : "=v"(r) : "v"(lo), "v"(hi)); return r; }

template <class Epi, class Sched, bool ALIGN_EPI = false, bool SP2 = false>
__device__ __forceinline__ void gemm_phase(PG8_LAS unsigned char* lds, const Gemm g, const Sched& S, const Epi& E, const float* SSp = nullptr) {
    const int tid = threadIdx.x, wid = __builtin_amdgcn_readfirstlane(tid >> 6), lane = tid & 63, wr = wid >> 2, wc = wid & 3, fr = lane & 15, fq = lane >> 4;
    const int K = g.K, nt = K / BK, lda = g.lda;
    unsigned voffA[2], voffB[2];
#pragma unroll
    for (int i = 0; i < 2; ++i) { int R, C; stage_rc(tid * 16 + i * 8192, R, C); const int Rb = (R >> 5) * 64 + perm32(R & 31);
        voffA[i] = (unsigned)(R * lda + C) * 2u; voffB[i] = (unsigned)(Rb * K + C) * 2u; }
    static_assert(Epi::PERM, "the column map assumes PERM epilogues");
    const size_t kstep = (size_t)(BK * 2);
    const size_t hA = (size_t)HALF * lda * 2, hB = (size_t)32 * K * 2;
    const size_t tA = 2 * hA, tB = (size_t)BM * K * 2;
    const unsigned ldsw = (unsigned)wid * 1024u;
    const int aoff = lds_byte(wr * 64 + fr, fq * 8), boff = lds_byte(wc * 32 + fr, fq * 8);
#define PG8_SA(b, h) (((b) * 2 + (h)) * HTB)
#define PG8_SB(b, h) ((4 + (b) * 2 + (h)) * HTB)
#define PG8_STAGE(bufoff, gbase, voff) do { _Pragma("unroll") for (int _i = 0; _i < 2; ++_i) \
        __builtin_amdgcn_global_load_lds((const unsigned*)((const char*)(gbase) + (voff)[_i]), (PG8_LAS unsigned*)(lds + (bufoff) + ldsw + _i * 8192), 16, 0, 0); } while (0)
#define PG8_LDA(dst, b, h) do { _Pragma("unroll") for (int m = 0; m < 4; ++m) _Pragma("unroll") for (int k = 0; k < 2; ++k) dst[m][k] = *(const PG8_LAS bf16x8*)(lds + PG8_SA(b, h) + aoff + m * 2048 + k * 1024); } while (0)
#define PG8_LDB(dst, b, h) do { _Pragma("unroll") for (int n = 0; n < 2; ++n) _Pragma("unroll") for (int k = 0; k < 2; ++k) dst[n][k] = *(const PG8_LAS bf16x8*)(lds + PG8_SB(b, h) + boff + n * 2048 + k * 1024); } while (0)
#define PG8_MMA(ai, bj, At, Bt) do { __builtin_amdgcn_s_setprio(1); _Pragma("unroll") for (int m = 0; m < 4; ++m) _Pragma("unroll") for (int n = 0; n < 2; ++n) _Pragma("unroll") for (int k = 0; k < 2; ++k) \
        acc[ai][bj][m][n] = __builtin_amdgcn_mfma_f32_16x16x32_bf16(Bt[n][k], At[m][k], acc[ai][bj][m][n], 0, 0, 0); __builtin_amdgcn_s_setprio(0); } while (0)
#define PG8_WAIT_V(n) asm volatile("s_waitcnt vmcnt(" #n ")" ::: "memory")
#define PG8_WAIT_L(n) asm volatile("s_waitcnt lgkmcnt(" #n ")" ::: "memory")
#define PG8_BAR __builtin_amdgcn_s_barrier()
#define PG8_SCHED __builtin_amdgcn_sched_barrier(0)
    Unit cur, nxt; int ui = 0;
    if (!S.next(0, cur)) return;
    PG8_LAS float* RS = (PG8_LAS float*)(lds + STAGE_BYTES);
    if (SSp) {
#pragma unroll
        for (int j = 0; j < 2; ++j) { const int uj = (tid >> 8) + 2 * j; Unit uu;
            if (S.next(uj, uu)) RS[uj * 256 + (tid & 255)] = row_rstd(SSp, uu.pm * BM + (tid & 255)); }
        asm volatile("s_waitcnt vmcnt(0) lgkmcnt(0)" ::: "memory"); __builtin_amdgcn_s_barrier(); asm volatile("" ::: "memory");
    }
    f32x4 acc[2][2][4][2];
#pragma unroll
    for (int a = 0; a < 2; ++a)
#pragma unroll
        for (int b = 0; b < 2; ++b)
#pragma unroll
            for (int m = 0; m < 4; ++m)
#pragma unroll
                for (int n = 0; n < 2; ++n) acc[a][b][m][n] = (f32x4){0.f, 0.f, 0.f, 0.f};
    bf16x8 At[4][2], B0[2][2], B1[2][2];
    const char* cA = (const char*)g.A + (size_t)cur.pm * tA; const char* cB = (const char*)g.Bt + (size_t)cur.pn * tB;
    if constexpr (SP2) {
        PG8_STAGE(PG8_SB(0, 0), cB, voffB); PG8_STAGE(PG8_SB(0, 1), cB + hB, voffB); PG8_STAGE(PG8_SA(0, 0), cA, voffA); PG8_STAGE(PG8_SA(0, 1), cA + hA, voffA);
        if (wr == 1) PG8_BAR;
        PG8_WAIT_V(2); PG8_BAR;
        PG8_STAGE(PG8_SB(1, 0), cB + kstep, voffB); PG8_STAGE(PG8_SA(1, 0), cA + kstep, voffA); PG8_STAGE(PG8_SB(1, 1), cB + hB + kstep, voffB);
        PG8_WAIT_V(6); PG8_BAR;
    } else {
        PG8_STAGE(PG8_SB(0, 0), cB, voffB); PG8_STAGE(PG8_SA(0, 0), cA, voffA); PG8_STAGE(PG8_SB(0, 1), cB + hB, voffB); PG8_STAGE(PG8_SA(0, 1), cA + hA, voffA);
        if (wr == 1) PG8_BAR;
        PG8_WAIT_V(4); PG8_BAR;
        PG8_STAGE(PG8_SB(1, 0), cB + kstep, voffB); PG8_STAGE(PG8_SA(1, 0), cA + kstep, voffA); PG8_STAGE(PG8_SB(1, 1), cB + hB + kstep, voffB);
        PG8_WAIT_V(6); PG8_BAR;
    }
    for (;;) {
        const bool has_next = S.next(ui + 1, nxt);
        const char* nA = has_next ? (const char*)g.A + (size_t)nxt.pm * tA : cA; const char* nB = has_next ? (const char*)g.Bt + (size_t)nxt.pn * tB : cB;
        for (int t = 0; t < nt; t += 2) {
            const bool last = (t == nt - 2);
            const char* a1 = cA + (size_t)(t + 1) * kstep;
            const char* a2 = last ? nA : cA + (size_t)(t + 2) * kstep; const char* b2 = last ? nB : cB + (size_t)(t + 2) * kstep;
            const char* a3 = a2 + kstep; const char* b3 = b2 + kstep;
            if constexpr (SP2) {
            PG8_LDB(B0, 0, 0); PG8_LDB(B1, 0, 1); PG8_SCHED; PG8_LDA(At, 0, 0); PG8_STAGE(PG8_SA(1, 1), a1 + hA, voffA);
            PG8_WAIT_V(8); PG8_WAIT_L(0); PG8_BAR; PG8_MMA(0, 0, At, B0); PG8_MMA(0, 1, At, B1); PG8_BAR; PG8_SCHED;
            PG8_LDA(At, 0, 1); PG8_STAGE(PG8_SB(0, 0), b2, voffB); PG8_STAGE(PG8_SB(0, 1), b2 + hB, voffB); PG8_STAGE(PG8_SA(0, 0), a2, voffA);
            PG8_WAIT_V(8); PG8_WAIT_L(0); PG8_BAR; PG8_MMA(1, 0, At, B0); PG8_MMA(1, 1, At, B1); PG8_BAR; PG8_SCHED;
            PG8_LDB(B0, 1, 0); PG8_LDB(B1, 1, 1); PG8_SCHED; PG8_LDA(At, 1, 0); PG8_STAGE(PG8_SA(0, 1), a2 + hA, voffA);
            PG8_WAIT_V(8); PG8_WAIT_L(0); PG8_BAR; PG8_MMA(0, 0, At, B0); PG8_MMA(0, 1, At, B1); PG8_BAR; PG8_SCHED;
            PG8_LDA(At, 1, 1); PG8_STAGE(PG8_SB(1, 0), b3, voffB); PG8_STAGE(PG8_SB(1, 1), b3 + hB, voffB); PG8_STAGE(PG8_SA(1, 0), a3, voffA);
            PG8_WAIT_V(8); PG8_WAIT_L(0); PG8_BAR; PG8_MMA(1, 0, At, B0); PG8_MMA(1, 1, At, B1); PG8_BAR; PG8_SCHED;
            } else {
            PG8_LDB(B0, 0, 0); PG8_SCHED; PG8_LDA(At, 0, 0); PG8_STAGE(PG8_SA(1, 1), a1 + hA, voffA);
            PG8_WAIT_L(8); PG8_BAR; PG8_WAIT_L(0); PG8_MMA(0, 0, At, B0); PG8_BAR; PG8_SCHED;
            PG8_LDB(B1, 0, 1); PG8_STAGE(PG8_SB(0, 0), b2, voffB);
            PG8_BAR; PG8_WAIT_L(0); PG8_MMA(0, 1, At, B1); PG8_BAR;
            PG8_LDA(At, 0, 1); PG8_STAGE(PG8_SA(0, 0), a2, voffA);
            PG8_BAR; PG8_WAIT_L(0); PG8_MMA(1, 0, At, B0); PG8_BAR; PG8_SCHED;
            PG8_STAGE(PG8_SB(0, 1), b2 + hB, voffB);
            PG8_WAIT_V(6); PG8_BAR; PG8_MMA(1, 1, At, B1); PG8_BAR;
            PG8_LDB(B0, 1, 0); PG8_SCHED; PG8_LDA(At, 1, 0); PG8_STAGE(PG8_SA(0, 1), a2 + hA, voffA);
            PG8_WAIT_L(8); PG8_BAR; PG8_WAIT_L(0); PG8_MMA(0, 0, At, B0); PG8_BAR; PG8_SCHED;
            PG8_LDB(B1, 1, 1); PG8_STAGE(PG8_SB(1, 0), b3, voffB);
            PG8_BAR; PG8_WAIT_L(0); PG8_MMA(0, 1, At, B1); PG8_BAR;
            PG8_LDA(At, 1, 1); PG8_STAGE(PG8_SA(1, 0), a3, voffA);
            PG8_BAR; PG8_WAIT_L(0); PG8_MMA(1, 0, At, B0); PG8_BAR; PG8_SCHED;
            PG8_STAGE(PG8_SB(1, 1), b3 + hB, voffB);
            PG8_WAIT_V(6); PG8_BAR; PG8_MMA(1, 1, At, B1); PG8_BAR;
            }
        }
        if constexpr (ALIGN_EPI) { if (wr == 0) PG8_BAR; }
        E(acc, cur, wr, wc, fr, fq, RS + (ui & 3) * 256);
        if (!has_next) break;
#pragma unroll
        for (int a = 0; a < 2; ++a)
#pragma unroll
            for (int b = 0; b < 2; ++b)
#pragma unroll
                for (int m = 0; m < 4; ++m)
#pragma unroll
                    for (int n = 0; n < 2; ++n) acc[a][b][m][n] = (f32x4){0.f, 0.f, 0.f, 0.f};
        cur = nxt; cA = nA; cB = nB; ++ui;
        if constexpr (ALIGN_EPI) { if (wr == 1) PG8_BAR; }
    }
    PG8_WAIT_V(0);
    if constexpr (!ALIGN_EPI) { if (wr == 0) PG8_BAR; }
    PG8_BAR;
#undef PG8_SA
#undef PG8_SB
#undef PG8_STAGE
#undef PG8_LDA
#undef PG8_LDB
#undef PG8_MMA
#undef PG8_WAIT_V
#undef PG8_WAIT_L
#undef PG8_BAR
#undef PG8_SCHED
}
}
constexpr int NWAVES = 8;
constexpr int DM = 1024, NBP = 8, SEQ = 2048, MP = NBP * SEQ, NBS = 128, DSEQ = 8, MS = NBS * DSEQ, MT = MP + MS;
constexpr int AH = 16, AP = 64, AG = 4, AN = 128, ACD = 2048, INC = 4112, FF = 4096, CWID = 31;
constexpr float EPS = 1e-6f;
constexpr size_t O_Y = 0, O_PAC = 17825792, O_PAS = 17874944, O_PBR = 18923520, O_PBI = 18956288, O_PCC = 18989056,
                 O_SAC = 19234816, O_SAS = 20021248, O_SBR = 36798464, O_SBI = 37322752, O_SCC = 37847040, O_END = 41779200;
constexpr size_t MiB = 1u << 20;
constexpr size_t WS_CTL = 0, CTL_ZERO_BYTES = 64 * 1024;
constexpr size_t WS_SS = 1 * MiB;
constexpr size_t WS_DT = 3 * MiB;
constexpr size_t WS_DA = 5 * MiB;
constexpr size_t WS_WDT = 7 * MiB;
constexpr size_t WS_W = 8 * MiB;
constexpr size_t WS_WIN = WS_W, WS_WGLU = WS_WIN + 8 * MiB, WS_WOUT = WS_WGLU + 2 * MiB, WS_WFF1 = WS_WOUT + 4 * MiB, WS_WFF2 = WS_WFF1 + 16 * MiB,
                 WS_WPW1 = WS_WFF2 + 16 * MiB, WS_WPW2 = WS_WPW1 + 4 * MiB, WS_WEND = WS_WPW2 + 2 * MiB;
constexpr size_t WS_CAT = 60 * MiB;
constexpr size_t WS_XBC = 128 * MiB;
constexpr size_t WS_U = 196 * MiB;
constexpr size_t WS_XB = WS_U;
constexpr size_t WS_H = 60 * MiB;
constexpr size_t WS_G = 60 * MiB;
constexpr size_t WS_CV = 94 * MiB;
constexpr size_t WS_END = 256 * MiB;
static_assert(WS_WEND == 60 * MiB, "weights end");
constexpr int CW_BAR = 4096;

constexpr int RING_OFF = 0, RING_BYTES = 131072;
constexpr int LDS_BYTES = 155648;
constexpr int LDSCTL_OFF = LDS_BYTES - 1024, MISC_OFF = LDSCTL_OFF + 320, PTRTAB_OFF = LDSCTL_OFF + 512;

#define GAS __attribute__((address_space(1)))
#define LAS __attribute__((address_space(3)))
typedef unsigned short bf16;
typedef unsigned v4u __attribute__((ext_vector_type(4)));
typedef unsigned v2u __attribute__((ext_vector_type(2)));
typedef float f32x4 __attribute__((ext_vector_type(4)));
typedef float f32x16 __attribute__((ext_vector_type(16)));
typedef short bf16x8 __attribute__((ext_vector_type(8)));
typedef GAS unsigned gu32;
#define RLX_AGENT __ATOMIC_RELAXED, __HIP_MEMORY_SCOPE_AGENT
#define LDS_WAIT() asm volatile("s_waitcnt lgkmcnt(0)" ::: "memory")
#define VM_WAIT() asm volatile("s_waitcnt vmcnt(0)" ::: "memory")
__device__ __forceinline__ unsigned f2bf(float f) { unsigned r; asm("v_cvt_pk_bf16_f32 %0, %1, %1" : "=v"(r) : "v"(f)); return r & 0xffffu; }
__device__ __forceinline__ unsigned pk2(float lo, float hi) { unsigned r; asm("v_cvt_pk_bf16_f32 %0, %1, %2" : "=v"(r) : "v"(lo), "v"(hi)); return r; }
__device__ __forceinline__ unsigned f2bf_int(float f) { const unsigned u = __builtin_bit_cast(unsigned, f); return (u + 0x7fffu + ((u >> 16) & 1u)) >> 16; }
__device__ __forceinline__ float bf2f(unsigned short b) { return __builtin_bit_cast(float, ((unsigned)b) << 16); }
__device__ __forceinline__ float bflo(unsigned w) { return __builtin_bit_cast(float, w << 16); }
__device__ __forceinline__ float bfhi(unsigned w) { return __builtin_bit_cast(float, w & 0xffff0000u); }
__device__ __forceinline__ float frcp_(float x) { return __builtin_amdgcn_rcpf(x); }
__device__ __forceinline__ float sigmoidf_(float x) { return frcp_(1.0f + __builtin_amdgcn_exp2f(-1.4426950408889634f * x)); }
__device__ __forceinline__ float siluf_(float x) { return x * frcp_(1.0f + __builtin_amdgcn_exp2f(-1.4426950408889634f * x)); }

#define XB_TMO      128
#define XB_XCNT(j)  (256  + 64 * (j))
#define XB_XSUB(j)  (1280 + 64 * (j))
#define XB_XGEN(j)  (2304 + 64 * (j))
#define XB_TOP      3328
#define XB_TOPGEN   3392
#define XCD_BAR_WORDS 3456
#define XB_SPIN_CAP (1u << 20)
__device__ __forceinline__ unsigned xb_ld(unsigned* p)              { return __hip_atomic_load(p, __ATOMIC_RELAXED, __HIP_MEMORY_SCOPE_AGENT); }
__device__ __forceinline__ unsigned xb_add(unsigned* p, unsigned v) { return __hip_atomic_fetch_add(p, v, __ATOMIC_RELAXED, __HIP_MEMORY_SCOPE_AGENT); }
__device__ __forceinline__ unsigned xb_xcc_id() { return (unsigned)__builtin_amdgcn_s_getreg((3 << 11) | 20) & 0xFu; }
#define XB_SPIN(cond, bar) do { unsigned _sp = 0; while (cond) { __builtin_amdgcn_s_sleep(1); \
    if ((++_sp & 255u) == 0u) { if (xb_ld(&(bar)[XB_TMO])) break; if (_sp > XB_SPIN_CAP) { atomicAdd(&(bar)[XB_TMO], 1u); break; } } } } while (0)
struct XcdBarrier { unsigned* bar; unsigned x; volatile LAS unsigned* st; };
__device__ __forceinline__ XcdBarrier xcd_barrier_post(unsigned* bar, volatile LAS unsigned* st) {
    XcdBarrier b; b.bar = bar; b.x = xb_xcc_id(); b.st = st;
    if (threadIdx.x == 0) (void)xb_add(&bar[XB_XCNT(b.x)], 1u);
    return b;
}
__device__ __forceinline__ void xcd_barrier_complete(unsigned* bar, unsigned x, unsigned& nloc, unsigned& nx) {
    const unsigned G = gridDim.x * gridDim.y * gridDim.z;
    unsigned sum, cnt, mine, sp = 0u;
    for (;;) {
        sum = 0u; cnt = 0u; mine = 0u;
#pragma unroll
        for (unsigned j = 0; j < 16; ++j) { const unsigned c = xb_ld(&bar[XB_XCNT(j)]); sum += c; cnt += (c > 0u) ? 1u : 0u; mine = (j == x) ? c : mine; }
        if (sum == G) break;
        __builtin_amdgcn_s_sleep(1);
        if ((++sp & 255u) == 0u) { if (xb_ld(&bar[XB_TMO])) break; if (sp > XB_SPIN_CAP) { atomicAdd(&bar[XB_TMO], 1u); break; } }
    }
    nloc = mine > 0u ? mine : 1u; nx = cnt > 0u ? cnt : 1u;
}
__device__ __forceinline__ void xcd_barrier(const XcdBarrier& b) {
    asm volatile("s_waitcnt vmcnt(0)" ::: "memory");
    __syncthreads();
    if (threadIdx.x == 0) {
        unsigned* bar = b.bar;
        __builtin_amdgcn_s_waitcnt(0);
        unsigned nloc = b.st[0], nx = b.st[1];
        if (nloc == 0u) { xcd_barrier_complete(bar, b.x, nloc, nx); b.st[0] = nloc; b.st[1] = nx; }
        const unsigned old = xb_add(&bar[XB_XSUB(b.x)], 1u);
        const unsigned gen = old / nloc;
        if (old + 1u == (gen + 1u) * nloc) {
            __builtin_amdgcn_fence(__ATOMIC_RELEASE, "agent");
            asm volatile("s_waitcnt vmcnt(0)" ::: "memory");
            const unsigned og = xb_add(&bar[XB_TOP], 1u);
            const unsigned tg = og / nx;
            if (og + 1u == (tg + 1u) * nx) xb_add(&bar[XB_TOPGEN], 1u);
            else XB_SPIN(xb_ld(&bar[XB_TOPGEN]) == tg, bar);
            __builtin_amdgcn_fence(__ATOMIC_ACQUIRE, "agent");
            xb_add(&bar[XB_XGEN(b.x)], 1u);
            asm volatile("s_waitcnt vmcnt(0)" ::: "memory");
        } else {
            XB_SPIN(xb_ld(&bar[XB_XGEN(b.x)]) == gen, bar);
            __builtin_amdgcn_fence(__ATOMIC_ACQUIRE, "agent");
            asm volatile("s_waitcnt vmcnt(0)" ::: "memory");
        }
    }
    __syncthreads();
}

typedef const float* cfp;
struct Frame {
    LAS unsigned char* lds;
    volatile LAS unsigned* MISC;
    gu32* ctl;
    int tid, lane, wave;
    int vcu, G;
    LAS cfp* in;
    float* out;
    unsigned char* ws;
    int nts;
    __device__ __forceinline__ const float* inp(int k) const { return (const float*)(const GAS float*)in[k]; }
};
#if defined(MK_DEBUGCNT)
#define DBG_COUNT(F, k) do { __hip_atomic_fetch_add((unsigned*)((F).ws + WS_CTL) + 2048 + (k), 1u, __ATOMIC_RELAXED, __HIP_MEMORY_SCOPE_AGENT); } while (0)
#else
#define DBG_COUNT(F, k) do {} while (0)
#endif
#if defined(MK_TIMING)
#define FSTAMP(F) do { if (blockIdx.x == 0 && (F).tid == 0 && (F).nts < 62) ((volatile LAS unsigned*)((F).lds + LDSCTL_OFF))[(F).nts] = (unsigned)__builtin_amdgcn_s_memrealtime(); ++(F).nts; } while (0)
#else
#define FSTAMP(F) do {} while (0)
#endif
template <int CTRL, int ROWMASK> __device__ __forceinline__ float dpp_get(float v) {
    return __builtin_bit_cast(float, __builtin_amdgcn_update_dpp(0, __builtin_bit_cast(int, v), CTRL, ROWMASK, 0xF, false));
}
__device__ __forceinline__ float dpp_sum8(float v) { v += dpp_get<0xB1, 0xF>(v); v += dpp_get<0x4E, 0xF>(v); v += dpp_get<0x141, 0xF>(v); return v; }
__device__ __forceinline__ float dpp_sum16(float v) { v = dpp_sum8(v); v += dpp_get<0x140, 0xF>(v); return v; }
__device__ __forceinline__ float dpp_sum32_hi(float v) { v = dpp_sum16(v); v += dpp_get<0x142, 0xA>(v); return v; }
__device__ __forceinline__ float wave_sum(float v) {
    v = dpp_sum32_hi(v); v += dpp_get<0x143, 0xC>(v);
    return __builtin_bit_cast(float, __builtin_amdgcn_readlane(__builtin_bit_cast(int, v), 63));
}
__device__ __forceinline__ float row16_reduce_scatter(const float (&d)[16], int lane) {
    const bool s3 = (lane & 8) != 0, s2 = (lane & 4) != 0, s1 = (lane & 2) != 0, s0 = (lane & 1) != 0;
    float a[8], b[4], c[2];
#pragma unroll
    for (int h = 0; h < 8; ++h) { const float keep = s3 ? d[h + 8] : d[h], give = s3 ? d[h] : d[h + 8]; a[h] = keep + dpp_get<0x140, 0xF>(give); }
#pragma unroll
    for (int h = 0; h < 4; ++h) { const float keep = s2 ? a[h + 4] : a[h], give = s2 ? a[h] : a[h + 4]; b[h] = keep + dpp_get<0x141, 0xF>(give); }
#pragma unroll
    for (int h = 0; h < 2; ++h) { const float keep = s1 ? b[h + 2] : b[h], give = s1 ? b[h] : b[h + 2]; c[h] = keep + dpp_get<0x4E, 0xF>(give); }
    const float keep = s0 ? c[1] : c[0], give = s0 ? c[0] : c[1];
    return keep + dpp_get<0xB1, 0xF>(give);
}
__device__ __forceinline__ float row_rstd(const float* SS, int r) {
    const f32x4* p = (const f32x4*)(SS + (size_t)r * 16);
    const f32x4 a = p[0], b = p[1], c = p[2], d = p[3];
    const float s = ((a.x + a.y) + (a.z + a.w)) + ((b.x + b.y) + (b.z + b.w)) + ((c.x + c.y) + (c.z + c.w)) + ((d.x + d.y) + (d.z + d.w));
    return __builtin_amdgcn_rsqf(s * (1.0f / DM) + EPS);
}
namespace pg8 {
struct EpiInProj {
    static constexpr bool PERM = true;
    bf16_t* CAT; bf16_t* XBC; bf16_t* U; const float* SS; float* out; bf16_t* HALO;
    __device__ __forceinline__ void operator()(const f32x4 (&acc)[2][2][4][2], const Unit& u, int wr, int wc, int fr, int fq, const PG8_LAS float* rs) const {
        const int row0 = u.pm * BM + wr * 64 + fr; const int colt = u.pn * BM;
        bf16_t* base; int ldc, c0; const bool isx = (colt >= 1024 && colt < 3072);
        if (colt < 1024) { base = CAT; ldc = 2048; c0 = colt; } else if (colt < 3072) { base = XBC; ldc = 2048; c0 = colt - 1024; } else { base = U; ldc = 1024; c0 = colt - 3072; }
        const int col0 = c0 + wc * 64 + 8 * fq;
#pragma unroll
        for (int ai = 0; ai < 2; ++ai)
#pragma unroll
            for (int m = 0; m < 4; ++m) {
                const int r = row0 + ai * HALF + m * 16; const float rsv = rs[wr * 64 + ai * HALF + m * 16 + fr];
                bf16_t* rowp = base + (size_t)r * ldc + col0;
                float* st = nullptr; bf16_t* hl = nullptr;
                if (isx) { if (r < MP) { const int t = r & 2047; if (t >= 2045) st = out + O_PAC + ((size_t)(r >> 11) * 3 + (t - 2045)) * 2048;
                                         if ((t & 63) >= 61) hl = HALO + ((size_t)((r >> 11) * 32 + (t >> 6)) * 3 + ((t & 63) - 61)) * 2048; }
                           else { const int rr = r - MP, t = rr & 7; if (t >= 5) st = out + O_SAC + ((size_t)(rr >> 3) * 3 + (t - 5)) * 2048; } }
#pragma unroll
                for (int bj = 0; bj < 2; ++bj) { const f32x4 v0 = acc[ai][bj][m][0] * rsv, v1 = acc[ai][bj][m][1] * rsv;
                    u32x4 w; w.x = cvt_pk_bf16(v0[0], v0[1]); w.y = cvt_pk_bf16(v0[2], v0[3]); w.z = cvt_pk_bf16(v1[0], v1[1]); w.w = cvt_pk_bf16(v1[2], v1[3]);
                    if (colt < 1024) __builtin_nontemporal_store(w, (u32x4*)(rowp + bj * 32));
                    else *(u32x4*)(rowp + bj * 32) = w;
                    if (hl) *(u32x4*)(hl + col0 + bj * 32) = w;
                    if (st) { __builtin_nontemporal_store(v0, (f32x4*)(st + col0 + bj * 32)); __builtin_nontemporal_store(v1, (f32x4*)(st + col0 + bj * 32 + 4)); } } }
    }
    __device__ __forceinline__ void tail_cols(int cb, int& w0, int& w1) const { w0 = 64 * cb; w1 = w0 + 32; }
    __device__ __forceinline__ void tail(const f32x4& a0, const f32x4& a1, int row, int cb, int coff, int wm, int wn, int fr, int fq, PG8_LAS unsigned char* red) const {
        const float rs = row_rstd(SS, row); const int rr = row - MP, t = rr & 7;
#pragma unroll
        for (int sg = 0; sg < 2; ++sg) { const int col = 64 * cb + 32 * sg + coff; const f32x4 v = (sg ? a1 : a0) * rs;
            u32x2 w; w.x = cvt_pk_bf16(v[0], v[1]); w.y = cvt_pk_bf16(v[2], v[3]);
            if (col < 1024) *(u32x2*)(CAT + (size_t)row * 2048 + col) = w;
            else if (col < 3072) { *(u32x2*)(XBC + (size_t)row * 2048 + (col - 1024)) = w; if (t >= 5) *(f32x4*)(out + O_SAC + ((size_t)(rr >> 3) * 3 + (t - 5)) * 2048 + (col - 1024)) = v; }
            else *(u32x2*)(U + (size_t)row * 1024 + (col - 3072)) = w; }
    }
};
struct EpiGlu {
    static constexpr bool PERM = true;
    const bf16_t* YS; bf16_t* CAT; const float* bias;
    __device__ __forceinline__ void operator()(const f32x4 (&acc)[2][2][4][2], const Unit& u, int wr, int wc, int fr, int fq, const PG8_LAS float* rs) const {
        const int row0 = u.pm * BM + wr * 64 + fr; const int col0 = u.pn * BM + wc * 64 + 8 * fq;
        f32x4 bv[2][2];
#pragma unroll
        for (int bj = 0; bj < 2; ++bj)
#pragma unroll
            for (int n = 0; n < 2; ++n) bv[bj][n] = *(const f32x4*)(bias + col0 + bj * 32 + 4 * n);
#pragma unroll
        for (int ai = 0; ai < 2; ++ai)
#pragma unroll
            for (int m = 0; m < 4; ++m) { const int r = row0 + ai * HALF + m * 16;
#pragma unroll
                for (int bj = 0; bj < 2; ++bj) { const u32x4 yw = *(const u32x4*)(YS + (size_t)r * 1024 + col0 + bj * 32);
                    const f32x4 g0 = acc[ai][bj][m][0] + bv[bj][0], g1 = acc[ai][bj][m][1] + bv[bj][1];
                    float o[8]; o[0] = bflo(yw.x) * sigmoidf_(g0[0]); o[1] = bfhi(yw.x) * sigmoidf_(g0[1]); o[2] = bflo(yw.y) * sigmoidf_(g0[2]); o[3] = bfhi(yw.y) * sigmoidf_(g0[3]);
                    o[4] = bflo(yw.z) * sigmoidf_(g1[0]); o[5] = bfhi(yw.z) * sigmoidf_(g1[1]); o[6] = bflo(yw.w) * sigmoidf_(g1[2]); o[7] = bfhi(yw.w) * sigmoidf_(g1[3]);
                    u32x4 w; w.x = cvt_pk_bf16(o[0], o[1]); w.y = cvt_pk_bf16(o[2], o[3]); w.z = cvt_pk_bf16(o[4], o[5]); w.w = cvt_pk_bf16(o[6], o[7]);
                    *(u32x4*)(CAT + (size_t)r * 2048 + 1024 + col0 + bj * 32) = w; }
                asm volatile("" ::: "memory"); }
    }
    __device__ __forceinline__ void tail_cols(int cb, int& w0, int& w1) const { w0 = 64 * cb; w1 = w0 + 32; }
    __device__ __forceinline__ void tail(const f32x4& a0, const f32x4& a1, int row, int cb, int coff, int wm, int wn, int fr, int fq, PG8_LAS unsigned char* red) const {
#pragma unroll
        for (int sg = 0; sg < 2; ++sg) { const int col = 64 * cb + 32 * sg + coff; const f32x4 g = (sg ? a1 : a0) + *(const f32x4*)(bias + col);
            const u32x2 yw = *(const u32x2*)(YS + (size_t)row * 1024 + col);
            u32x2 w; w.x = cvt_pk_bf16(bflo(yw.x) * sigmoidf_(g[0]), bfhi(yw.x) * sigmoidf_(g[1])); w.y = cvt_pk_bf16(bflo(yw.y) * sigmoidf_(g[2]), bfhi(yw.y) * sigmoidf_(g[3]));
            *(u32x2*)(CAT + (size_t)row * 2048 + 1024 + col) = w; }
    }
};
struct EpiRes {
    static constexpr bool PERM = true;
    const float* resP; const float* resS; const bf16_t* RB; float* X; bf16_t* XB; float* SS; const float* bias;
    __device__ __forceinline__ void operator()(const f32x4 (&acc)[2][2][4][2], const Unit& u, int wr, int wc, int fr, int fq, const PG8_LAS float* rs) const {
        const int row0 = u.pm * BM + wr * 64 + fr; const int col0 = u.pn * BM + wc * 64 + 8 * fq;
        f32x4 bv[2][2];
#pragma unroll
        for (int bj = 0; bj < 2; ++bj)
#pragma unroll
            for (int n = 0; n < 2; ++n) bv[bj][n] = bias ? *(const f32x4*)(bias + col0 + bj * 32 + 4 * n) : (f32x4){0.f, 0.f, 0.f, 0.f};
#pragma unroll
        for (int ai = 0; ai < 2; ++ai)
#pragma unroll
            for (int m = 0; m < 4; ++m) { const int r = row0 + ai * HALF + m * 16;
                float ssq = 0.f;
#pragma unroll
                for (int bj = 0; bj < 2; ++bj) { const int c = col0 + bj * 32;
                    f32x4 x0, x1;
                    if (RB) { const u32x4 rw = *(const u32x4*)(RB + (size_t)r * 1024 + c); x0 = (f32x4){bflo(rw.x), bfhi(rw.x), bflo(rw.y), bfhi(rw.y)}; x1 = (f32x4){bflo(rw.z), bfhi(rw.z), bflo(rw.w), bfhi(rw.w)}; }
                    else { const float* rp = resP + (size_t)r * 1024; x0 = __builtin_nontemporal_load((const f32x4*)(rp + c)); x1 = __builtin_nontemporal_load((const f32x4*)(rp + c + 4)); }
                    x0 = x0 + acc[ai][bj][m][0] + bv[bj][0]; x1 = x1 + acc[ai][bj][m][1] + bv[bj][1];
                    if (X) { *(f32x4*)(X + (size_t)r * 1024 + c) = x0; *(f32x4*)(X + (size_t)r * 1024 + c + 4) = x1; }
                    if (XB) { u32x4 w; w.x = cvt_pk_bf16(x0[0], x0[1]); w.y = cvt_pk_bf16(x0[2], x0[3]); w.z = cvt_pk_bf16(x1[0], x1[1]); w.w = cvt_pk_bf16(x1[2], x1[3]); *(u32x4*)(XB + (size_t)r * 1024 + c) = w; }
                    ssq += (x0[0] * x0[0] + x0[1] * x0[1]) + (x0[2] * x0[2] + x0[3] * x0[3]) + (x1[0] * x1[0] + x1[1] * x1[1]) + (x1[2] * x1[2] + x1[3] * x1[3]); }
                ssq += __shfl_xor(ssq, 16); ssq += __shfl_xor(ssq, 32);
                if (fq == 0) SS[(size_t)r * 16 + u.pn * 4 + wc] = ssq;
                asm volatile("" ::: "memory"); }
    }
    __device__ __forceinline__ void tail_cols(int cb, int& w0, int& w1) const { w0 = 64 * cb; w1 = w0 + 32; }
    __device__ __forceinline__ void tail(const f32x4& a0, const f32x4& a1, int row, int cb, int coff, int wm, int wn, int fr, int fq, PG8_LAS unsigned char* red) const {
        float ssq = 0.f;
#pragma unroll
        for (int sg = 0; sg < 2; ++sg) { const int col = 64 * cb + 32 * sg + coff;
            f32x4 x;
            if (RB) { const u32x2 rw = *(const u32x2*)(RB + (size_t)row * 1024 + col); x = (f32x4){bflo(rw.x), bfhi(rw.x), bflo(rw.y), bfhi(rw.y)}; }
            else x = __builtin_nontemporal_load((const f32x4*)(resS + (size_t)(row - MP) * 1024 + col));
            x = x + (sg ? a1 : a0); if (bias) x = x + *(const f32x4*)(bias + col);
            if (X) *(f32x4*)(X + (size_t)row * 1024 + col) = x;
            if (XB) { u32x2 w; w.x = cvt_pk_bf16(x[0], x[1]); w.y = cvt_pk_bf16(x[2], x[3]); *(u32x2*)(XB + (size_t)row * 1024 + col) = w; }
            ssq += (x[0] * x[0] + x[1] * x[1]) + (x[2] * x[2] + x[3] * x[3]); }
        ssq += __shfl_xor(ssq, 16); ssq += __shfl_xor(ssq, 32);
        PG8_LAS float* rd = (PG8_LAS float*)red;
        if (fq == 0) rd[wn * 64 + 16 * wm + fr] = ssq;
        asm volatile("s_waitcnt lgkmcnt(0)" ::: "memory"); __builtin_amdgcn_s_barrier(); asm volatile("" ::: "memory");
        if (wn == 0 && fq == 0) SS[(size_t)row * 16 + cb] = rd[16 * wm + fr] + rd[64 + 16 * wm + fr];
    }
};
struct EpiFF1 {
    static constexpr bool PERM = true;
    bf16_t* H; const float* SS;
    __device__ __forceinline__ void operator()(const f32x4 (&acc)[2][2][4][2], const Unit& u, int wr, int wc, int fr, int fq, const PG8_LAS float* rs) const {
        const int row0 = u.pm * BM + wr * 64 + fr; const int col0 = u.pn * BM + wc * 64 + 8 * fq;
#pragma unroll
        for (int ai = 0; ai < 2; ++ai)
#pragma unroll
            for (int m = 0; m < 4; ++m) { const int r = row0 + ai * HALF + m * 16; const float rsv = rs[wr * 64 + ai * HALF + m * 16 + fr];
#pragma unroll
                for (int bj = 0; bj < 2; ++bj) { f32x4 v0 = acc[ai][bj][m][0] * rsv, v1 = acc[ai][bj][m][1] * rsv;
#pragma unroll
                    for (int j = 0; j < 4; ++j) { const float a = fmaxf(v0[j], 0.f), b = fmaxf(v1[j], 0.f); v0[j] = a * a; v1[j] = b * b; }
                    u32x4 w; w.x = cvt_pk_bf16(v0[0], v0[1]); w.y = cvt_pk_bf16(v0[2], v0[3]); w.z = cvt_pk_bf16(v1[0], v1[1]); w.w = cvt_pk_bf16(v1[2], v1[3]);
                    *(u32x4*)(H + (size_t)r * FF + col0 + bj * 32) = w; } }
    }
    __device__ __forceinline__ void tail_cols(int cb, int& w0, int& w1) const { w0 = 64 * cb; w1 = w0 + 32; }
    __device__ __forceinline__ void tail(const f32x4& a0, const f32x4& a1, int row, int cb, int coff, int wm, int wn, int fr, int fq, PG8_LAS unsigned char* red) const {
        const float rs = row_rstd(SS, row);
#pragma unroll
        for (int sg = 0; sg < 2; ++sg) { const int col = 64 * cb + 32 * sg + coff; f32x4 v = (sg ? a1 : a0) * rs;
#pragma unroll
            for (int j = 0; j < 4; ++j) { const float a = fmaxf(v[j], 0.f); v[j] = a * a; }
            u32x2 w; w.x = cvt_pk_bf16(v[0], v[1]); w.y = cvt_pk_bf16(v[2], v[3]);
            *(u32x2*)(H + (size_t)row * FF + col) = w; }
    }
};
struct EpiPw1 {
    static constexpr bool PERM = true;
    bf16_t* G; const float* SS; const float* bias; float* out;
    __device__ __forceinline__ void operator()(const f32x4 (&acc)[2][2][4][2], const Unit& u, int wr, int wc, int fr, int fq, const PG8_LAS float* rs) const {
        const int row0 = u.pm * BM + wr * 64 + fr; const int col0 = u.pn * HALF + wc * 32 + 8 * fq;
        f32x4 bv[2][2];
#pragma unroll
        for (int bj = 0; bj < 2; ++bj)
#pragma unroll
            for (int n = 0; n < 2; ++n) bv[bj][n] = *(const f32x4*)(bias + bj * 1024 + col0 + 4 * n);
#pragma unroll
        for (int ai = 0; ai < 2; ++ai)
#pragma unroll
            for (int m = 0; m < 4; ++m) { const int r = row0 + ai * HALF + m * 16; const float rsv = rs[wr * 64 + ai * HALF + m * 16 + fr];
                f32x4 o0, o1;
#pragma unroll
                for (int j = 0; j < 4; ++j) { o0[j] = (acc[ai][0][m][0][j] * rsv + bv[0][0][j]) * sigmoidf_(acc[ai][1][m][0][j] * rsv + bv[1][0][j]);
                                              o1[j] = (acc[ai][0][m][1][j] * rsv + bv[0][1][j]) * sigmoidf_(acc[ai][1][m][1][j] * rsv + bv[1][1][j]); }
                u32x4 w; w.x = cvt_pk_bf16(o0[0], o0[1]); w.y = cvt_pk_bf16(o0[2], o0[3]); w.z = cvt_pk_bf16(o1[0], o1[1]); w.w = cvt_pk_bf16(o1[2], o1[3]);
                *(u32x4*)(G + (size_t)r * 1024 + col0) = w;
                float* st = nullptr;
                if (r < MP) { const int t = r & 2047; if (t >= 2018) st = out + O_PCC + ((size_t)(r >> 11) * 30 + (t - 2018)) * 1024; }
                else { const int rr = r - MP; st = out + O_SCC + ((size_t)(rr >> 3) * 30 + 22 + (rr & 7)) * 1024; }
                if (st) { __builtin_nontemporal_store(o0, (f32x4*)(st + col0)); __builtin_nontemporal_store(o1, (f32x4*)(st + col0 + 4)); } }
    }
    __device__ __forceinline__ void tail_cols(int cb, int& w0, int& w1) const { w0 = 256 * (cb >> 2) + 64 * (cb & 3); w1 = w0 + 32; }
    __device__ __forceinline__ void tail(const f32x4& a0, const f32x4& a1, int row, int cb, int coff, int wm, int wn, int fr, int fq, PG8_LAS unsigned char* red) const {
        const float rs = row_rstd(SS, row); const int oc = 32 * cb + coff, rr = row - MP;
        const f32x4 bv = *(const f32x4*)(bias + oc), bg = *(const f32x4*)(bias + 1024 + oc);
        f32x4 o;
#pragma unroll
        for (int j = 0; j < 4; ++j) o[j] = (a0[j] * rs + bv[j]) * sigmoidf_(a1[j] * rs + bg[j]);
        u32x2 w; w.x = cvt_pk_bf16(o[0], o[1]); w.y = cvt_pk_bf16(o[2], o[3]);
        *(u32x2*)(G + (size_t)row * 1024 + oc) = w;
        *(f32x4*)(out + O_SCC + ((size_t)(rr >> 3) * 30 + 22 + (rr & 7)) * 1024 + oc) = o;
    }
};
}
namespace pg8 {
constexpr int TL_STAGE = 32768, TL_RED = 3 * TL_STAGE;
template <class Epi>
__device__ __forceinline__ void gemm_tail(PG8_LAS unsigned char* lds, const bf16_t* A  , int lda, const bf16_t* Bt, int K, int ntiles_n  , const Epi& E, int bx, int G, int i_begin, int i_end) {
    const int tid = threadIdx.x, wid = __builtin_amdgcn_readfirstlane(tid >> 6), lane = tid & 63, wm = wid >> 1, wn = wid & 1, fr = lane & 15, fq = lane >> 4;
    const int nk = K / 128, ntiles = 16 * ntiles_n;
    const int lrow = lane >> 4, lch = lane & 15;
    for (int ii = i_begin; ii < i_end; ++ii) { const int ti = bx + G * ii; if (ti >= ntiles) break;
        const int rb = ti & 15, cb = ti >> 4;
        int wrow0, wrow1; E.tail_cols(cb, wrow0, wrow1);
        const char* srcA[2]; const char* srcB[2];
#pragma unroll
        for (int i = 0; i < 2; ++i) {
            const int r = 8 * wid + 4 * i + lrow;
            srcA[i] = (const char*)(A + (size_t)(rb * 64 + r) * lda) + ((lch ^ (r & 15)) << 4);
            const int wr_ = (r < 32) ? (wrow0 + r) : (wrow1 + r - 32);
            srcB[i] = (const char*)(Bt + (size_t)wr_ * K) + ((lch ^ (r & 15)) << 4);
        }
#define TL_ISSUE(kt, st) do { _Pragma("unroll") for (int _i = 0; _i < 2; ++_i) { \
            __builtin_amdgcn_global_load_lds((const unsigned*)(srcA[_i] + (size_t)(kt) * 256), (PG8_LAS unsigned*)(lds + (st) * TL_STAGE + (8 * wid + 4 * _i) * 256), 16, 0, 0); \
            __builtin_amdgcn_global_load_lds((const unsigned*)(srcB[_i] + (size_t)(kt) * 256), (PG8_LAS unsigned*)(lds + (st) * TL_STAGE + 16384 + (8 * wid + 4 * _i) * 256), 16, 0, 0); } } while (0)
        f32x4 acc[2] = {(f32x4){0.f, 0.f, 0.f, 0.f}, (f32x4){0.f, 0.f, 0.f, 0.f}};
        TL_ISSUE(0, 0); TL_ISSUE(1, 1);
        for (int kt = 0; kt < nk; ++kt) {
            const int st = kt % 3;
            if (kt + 1 < nk) asm volatile("s_waitcnt vmcnt(4)" ::: "memory"); else asm volatile("s_waitcnt vmcnt(0)" ::: "memory");
            asm volatile("s_waitcnt lgkmcnt(0)" ::: "memory"); __builtin_amdgcn_s_barrier(); asm volatile("" ::: "memory");
            if (kt + 2 < nk) TL_ISSUE(kt + 2, (kt + 2) % 3);
            const PG8_LAS unsigned char* sa = lds + st * TL_STAGE + (16 * wm + fr) * 256;
            const PG8_LAS unsigned char* sb0 = lds + st * TL_STAGE + 16384 + (16 * wn + fr) * 256;
            const PG8_LAS unsigned char* sb1 = sb0 + 32 * 256;
#pragma unroll
            for (int ks = 0; ks < 4; ++ks) {
                const int co = ((4 * ks + fq) ^ fr) << 4;
                const bf16x8 a = *(const PG8_LAS bf16x8*)(sa + co), b0 = *(const PG8_LAS bf16x8*)(sb0 + co), b1 = *(const PG8_LAS bf16x8*)(sb1 + co);
                acc[0] = __builtin_amdgcn_mfma_f32_16x16x32_bf16(b0, a, acc[0], 0, 0, 0);
                acc[1] = __builtin_amdgcn_mfma_f32_16x16x32_bf16(b1, a, acc[1], 0, 0, 0);
            }
        }
#undef TL_ISSUE
        E.tail(acc[0], acc[1], MP + rb * 64 + 16 * wm + fr, cb, 16 * wn + 4 * fq, wm, wn, fr, fq, lds + TL_RED);
        asm volatile("s_waitcnt lgkmcnt(0)" ::: "memory"); __builtin_amdgcn_s_barrier(); asm volatile("" ::: "memory");
    }
}
template <int NCB, class Epi>
__device__ __forceinline__ void gemm_tail_wide(PG8_LAS unsigned char* lds, const bf16_t* A  , int lda, const bf16_t* Bt, int K, const Epi& E, int bx, int G) {
    static_assert(NCB == 2 || NCB == 4, "NCB");
    constexpr int STAGE = 8192 * (1 + NCB), CJ = (NCB == 4) ? 4 : 2;
    const int tid = threadIdx.x, wid = __builtin_amdgcn_readfirstlane(tid >> 6), lane = tid & 63, wm2 = wid >> 2, wn4 = wid & 3, fr = lane & 15, fq = lane >> 4;
    const int nk = K / 64;
    const int lrow = lane >> 3, lch = lane & 7;
    for (int s = bx; s < 256; s += G) {
        const int rb = s & 15, cb0 = s >> 4;
        const char* srcA = (const char*)(A + (size_t)(rb * 64 + 8 * wid + lrow) * lda) + ((lch ^ lrow) << 4);
        const char* srcB[NCB];
#pragma unroll
        for (int i = 0; i < NCB; ++i) { int w0, w1; E.tail_cols(cb0 + 16 * i, w0, w1);
            const int wr_ = ((wid >> 2) ? w1 : w0) + ((8 * wid + lrow) & 31);
            srcB[i] = (const char*)(Bt + (size_t)wr_ * K) + ((lch ^ lrow) << 4); }
#define TW_ISSUE(kt, st) do { \
            __builtin_amdgcn_global_load_lds((const unsigned*)(srcA + (size_t)(kt) * 128), (PG8_LAS unsigned*)(lds + (st) * STAGE + (8 * wid) * 128), 16, 0, 0); \
            _Pragma("unroll") for (int _i = 0; _i < NCB; ++_i) \
                __builtin_amdgcn_global_load_lds((const unsigned*)(srcB[_i] + (size_t)(kt) * 128), (PG8_LAS unsigned*)(lds + (st) * STAGE + 8192 + (64 * _i + 8 * wid) * 128), 16, 0, 0); } while (0)
        f32x4 acc[2][CJ];
#pragma unroll
        for (int ri = 0; ri < 2; ++ri)
#pragma unroll
            for (int j = 0; j < CJ; ++j) acc[ri][j] = (f32x4){0.f, 0.f, 0.f, 0.f};
        const int brow0 = (NCB == 4) ? 64 * wn4 : (64 * (wn4 >> 1) + 16 * (wn4 & 1));
        TW_ISSUE(0, 0); TW_ISSUE(1, 1);
        for (int kt = 0; kt < nk; ++kt) {
            const int st = kt % 3;
            if (kt + 1 < nk) { if (NCB == 4) asm volatile("s_waitcnt vmcnt(5)" ::: "memory"); else asm volatile("s_waitcnt vmcnt(3)" ::: "memory"); }
            else asm volatile("s_waitcnt vmcnt(0)" ::: "memory");
            asm volatile("s_waitcnt lgkmcnt(0)" ::: "memory"); __builtin_amdgcn_s_barrier(); asm volatile("" ::: "memory");
            if (kt + 2 < nk) TW_ISSUE(kt + 2, (kt + 2) % 3);
            const PG8_LAS unsigned char* sa = lds + st * STAGE + (32 * wm2 + fr) * 128;
            const PG8_LAS unsigned char* sb = lds + st * STAGE + 8192 + (brow0 + fr) * 128;
#pragma unroll
            for (int ks = 0; ks < 2; ++ks) {
                const int co = ((4 * ks + fq) ^ (fr & 7)) << 4;
                const bf16x8 a0 = *(const PG8_LAS bf16x8*)(sa + co), a1 = *(const PG8_LAS bf16x8*)(sa + 16 * 128 + co);
#pragma unroll
                for (int j = 0; j < CJ; ++j) {
                    const bf16x8 b = *(const PG8_LAS bf16x8*)(sb + ((NCB == 4) ? 16 : 32) * j * 128 + co);
                    acc[0][j] = __builtin_amdgcn_mfma_f32_16x16x32_bf16(b, a0, acc[0][j], 0, 0, 0);
                    acc[1][j] = __builtin_amdgcn_mfma_f32_16x16x32_bf16(b, a1, acc[1][j], 0, 0, 0);
                }
            }
        }
#undef TW_ISSUE
#pragma unroll
        for (int ri = 0; ri < 2; ++ri) {
            const int row = MP + rb * 64 + 32 * wm2 + 16 * ri + fr;
            if (NCB == 4) {
#pragma unroll
                for (int wn = 0; wn < 2; ++wn) E.tail(acc[ri][wn], acc[ri][2 + wn], row, cb0 + 16 * wn4, 16 * wn + 4 * fq, 2 * wm2 + ri, wn, fr, fq, nullptr);
            } else {
                const int wn = wn4 & 1;
                E.tail(acc[ri][0], acc[ri][1], row, cb0 + 16 * (wn4 >> 1), 16 * wn + 4 * fq, 2 * wm2 + ri, wn, fr, fq, nullptr);
            }
        }
        asm volatile("s_waitcnt lgkmcnt(0)" ::: "memory"); __builtin_amdgcn_s_barrier(); asm volatile("" ::: "memory");
    }
}
}
__device__ __forceinline__ void p0_transpose_item(const float* W, int ldw, int K, bf16* WT, int dst_row0, const float* kscale, LAS float* scr, int k0, int n0, int lane) {
    float tv[32];
#pragma unroll
    for (int i = 0; i < 32; ++i) { const int kk = 2 * i + (lane >> 5); tv[i] = W[(size_t)(k0 + kk) * ldw + n0 + (lane & 31)]; }
    if (kscale) {
#pragma unroll
        for (int i = 0; i < 32; ++i) tv[i] *= kscale[k0 + 2 * i + (lane >> 5)];
    }
#pragma unroll
    for (int i = 0; i < 32; ++i) { const int kk = 2 * i + (lane >> 5); scr[kk * 33 + (lane & 31)] = tv[i]; }
    LDS_WAIT(); asm volatile("" ::: "memory");
    const int c = lane & 7;
#pragma unroll
    for (int j = 0; j < 4; ++j) { const int n = (lane >> 3) + 8 * j; const LAS float* s = scr + (8 * c) * 33 + n;
        v4u o; o.x = pk2(s[0 * 33], s[1 * 33]); o.y = pk2(s[2 * 33], s[3 * 33]); o.z = pk2(s[4 * 33], s[5 * 33]); o.w = pk2(s[6 * 33], s[7 * 33]);
        *(GAS v4u*)(WT + (size_t)(dst_row0 + n) * K + k0 + 8 * c) = o; }
    LDS_WAIT(); asm volatile("" ::: "memory");
}
__device__ __forceinline__ void p0_mat(const float* W, int ldw, int K, int ncols, bf16* WT, int row_off, const float* kscale, LAS float* scr, int item, int lane, int glu_map) {
    const int nblk = ncols / 32, kb = item / nblk, nb = item % nblk, n0 = 32 * nb;
    int dst = row_off + n0;
    if (glu_map) dst = (n0 < 1024) ? (256 * (n0 >> 7) + 64 * ((n0 & 127) >> 5)) : (256 * ((n0 - 1024) >> 7) + 64 * (((n0 - 1024) & 127) >> 5) + 32);
    p0_transpose_item(W, ldw, K, WT, dst, kscale, scr, 64 * kb, n0, lane);
}
constexpr int P0_SCR_STRIDE = 8704;
constexpr int P0_WD_OFF = NWAVES * P0_SCR_STRIDE;
constexpr int P0_WD_LD = 1028, P0_WDB_PITCH = 2064;
static_assert(P0_WD_OFF + 16 * P0_WD_LD * 4 <= LDSCTL_OFF, "P0 LDS");

constexpr int P0_WIN_ITEMS = 16 * 96 + 16 * 32, P0_L0_ITEMS = P0_WIN_ITEMS + 16 * 32 + 32 * 32 + 16 * 128 + 64 * 32  , P0_PW1_ITEMS = P0_L0_ITEMS + 16 * 64  , P0_ALL_ITEMS = 16 * 96 + 16 * 32 + 16 * 32 + 32 * 32 + 2 * 16 * 128 + 2 * 64 * 32 + 16 * 64 + 16 * 32;
__device__ __forceinline__ void p0_weights(Frame& F, int lo, int hi, int gw_ = -1  , int NGW_ = 0) {
    LAS float* scr = (LAS float*)(F.lds + F.wave * P0_SCR_STRIDE);
    const int gw = gw_ >= 0 ? gw_ : F.vcu * NWAVES + F.wave, NGW = gw_ >= 0 ? NGW_ : F.G * NWAVES;
    const float* w_in = F.inp(10); const float* nmix = F.inp(7); const float* nff = F.inp(8);
    bf16* Win = (bf16*)(F.ws + WS_WIN); bf16* Wglu = (bf16*)(F.ws + WS_WGLU); bf16* Wout = (bf16*)(F.ws + WS_WOUT);
    bf16* Wff1 = (bf16*)(F.ws + WS_WFF1); bf16* Wff2 = (bf16*)(F.ws + WS_WFF2); bf16* Wpw1 = (bf16*)(F.ws + WS_WPW1); bf16* Wpw2 = (bf16*)(F.ws + WS_WPW2);
    constexpr int I1 = 16 * 96, I2 = 16 * 32, I3 = 16 * 32, I4 = 32 * 32, I5 = 16 * 128, I6 = 64 * 32, I7 = 16 * 64, I8 = 16 * 32;
    constexpr int NITEMS = I1 + I2 + I3 + I4 + 2 * I5 + 2 * I6 + I7 + I8;
#define P0_DECODE(it_, src_, ldw_, dst_, K_, ks_) do { \
        const float* W_; int ncols_, roff_ = 0, glu_ = 0; bf16* WT_; const float* ksc_ = nullptr; int r_ = (it_); \
        if (r_ < I1) { W_ = w_in; ldw_ = INC; K_ = 1024; ncols_ = 3072; WT_ = Win; ksc_ = nmix; } \
        else if ((r_ -= I1) < I2) { W_ = w_in + 3088; ldw_ = INC; K_ = 1024; ncols_ = 1024; WT_ = Win; roff_ = 3072; ksc_ = nmix; } \
        else if ((r_ -= I2) < I3) { W_ = F.inp(25); ldw_ = 1024; K_ = 1024; ncols_ = 1024; WT_ = Wglu; } \
        else if ((r_ -= I3) < I4) { W_ = F.inp(27); ldw_ = 1024; K_ = 2048; ncols_ = 1024; WT_ = Wout; } \
        else if ((r_ -= I4) < I5) { W_ = F.inp(36); ldw_ = 4096; K_ = 1024; ncols_ = 4096; WT_ = Wff1; ksc_ = nff; } \
        else if ((r_ -= I5) < I6) { W_ = F.inp(37); ldw_ = 1024; K_ = 4096; ncols_ = 1024; WT_ = Wff2; } \
        else if ((r_ -= I6) < I7) { W_ = F.inp(28); ldw_ = 2048; K_ = 1024; ncols_ = 2048; WT_ = Wpw1; ksc_ = nmix + 1024; glu_ = 1; } \
        else if ((r_ -= I7) < I5) { W_ = F.inp(36) + (size_t)1024 * 4096; ldw_ = 4096; K_ = 1024; ncols_ = 4096; WT_ = Wff1 + (size_t)4096 * 1024; ksc_ = nff + 1024; } \
        else if ((r_ -= I5) < I6) { W_ = F.inp(37) + (size_t)4096 * 1024; ldw_ = 1024; K_ = 4096; ncols_ = 1024; WT_ = Wff2 + (size_t)1024 * 4096; } \
        else { r_ -= I6; W_ = F.inp(34); ldw_ = 1024; K_ = 1024; ncols_ = 1024; WT_ = Wpw2; } \
        const int nblk_ = ncols_ >> 5, kb_ = r_ / nblk_, n0_ = 32 * (r_ - kb_ * nblk_); \
        int drow_ = roff_ + n0_; \
        if (glu_) drow_ = (n0_ < 1024) ? (256 * (n0_ >> 7) + 64 * ((n0_ & 127) >> 5)) : (256 * ((n0_ - 1024) >> 7) + 64 * (((n0_ - 1024) & 127) >> 5) + 32); \
        src_ = W_ + (size_t)(64 * kb_ + (F.lane >> 5)) * ldw_ + n0_ + (F.lane & 31); \
        dst_ = WT_ + (size_t)drow_ * K_ + 64 * kb_; ks_ = ksc_ ? ksc_ + 64 * kb_ : nullptr; } while (0)
    {
        float tv[32];
        const float* src; int ldw = 0, K = 0; bf16* dst; const float* ks;
        if (lo + gw < hi) { P0_DECODE(lo + gw, src, ldw, dst, K, ks);
#pragma unroll
            for (int i = 0; i < 32; ++i) tv[i] = __builtin_nontemporal_load(&src[(size_t)(2 * i) * ldw]); }
        for (int it = lo + gw; it < hi; it += NGW) {
            float nv_[32]; const float* nsrc; int nldw = 0, nK = 0; bf16* ndst = nullptr; const float* nks = nullptr;
            const bool more = it + NGW < hi;
            if (more) { P0_DECODE(it + NGW, nsrc, nldw, ndst, nK, nks);
#pragma unroll
                for (int i = 0; i < 32; ++i) nv_[i] = __builtin_nontemporal_load(&nsrc[(size_t)(2 * i) * nldw]); }
            const int c = F.lane & 7;
            f32x4 k0v = (f32x4){1.f, 1.f, 1.f, 1.f}, k1v = k0v;
            if (ks) { k0v = *(const f32x4*)(ks + 8 * c); k1v = *(const f32x4*)(ks + 8 * c + 4); }
#pragma unroll
            for (int i = 0; i < 32; ++i) { const int kk = 2 * i + (F.lane >> 5); scr[kk * 33 + (F.lane & 31)] = tv[i]; }
            LDS_WAIT(); asm volatile("" ::: "memory");
#pragma unroll
            for (int j = 0; j < 4; ++j) { const int n = (F.lane >> 3) + 8 * j; const LAS float* sp = scr + (8 * c) * 33 + n;
                v4u o; o.x = pk2(sp[0 * 33] * k0v.x, sp[1 * 33] * k0v.y); o.y = pk2(sp[2 * 33] * k0v.z, sp[3 * 33] * k0v.w); o.z = pk2(sp[4 * 33] * k1v.x, sp[5 * 33] * k1v.y); o.w = pk2(sp[6 * 33] * k1v.z, sp[7 * 33] * k1v.w);
                if (lo >= P0_WIN_ITEMS) __builtin_nontemporal_store(o, (GAS v4u*)(dst + (size_t)n * K + 8 * c));
                else *(GAS v4u*)(dst + (size_t)n * K + 8 * c) = o; }
            LDS_WAIT(); asm volatile("" ::: "memory");
            if (more) {
#pragma unroll
                for (int i = 0; i < 32; ++i) tv[i] = nv_[i];
                dst = ndst; K = nK; ks = nks; }
        }
    }
#undef P0_DECODE
}
__device__ __forceinline__ void p0_prologue(Frame& F) {
    LAS float* scr = (LAS float*)(F.lds + F.wave * P0_SCR_STRIDE);
    const int gw = F.vcu * NWAVES + F.wave, NGW = F.G * NWAVES;
    const float* w_in = F.inp(10); const float* nmix = F.inp(7); const float* nff = F.inp(8);
    { LAS unsigned char* WD = F.lds + P0_WD_OFF;
      for (int k = F.tid; k < 1024; k += NWAVES * 64) { const float nk = nmix[k]; const f32x4* wp = (const f32x4*)(w_in + (size_t)k * INC + 3072);
#pragma unroll
          for (int q = 0; q < 4; ++q) { const f32x4 w4 = wp[q];
              *(LAS unsigned short*)(WD + (4 * q) * P0_WDB_PITCH + k * 2) = (unsigned short)f2bf(w4.x * nk); *(LAS unsigned short*)(WD + (4 * q + 1) * P0_WDB_PITCH + k * 2) = (unsigned short)f2bf(w4.y * nk);
              *(LAS unsigned short*)(WD + (4 * q + 2) * P0_WDB_PITCH + k * 2) = (unsigned short)f2bf(w4.z * nk); *(LAS unsigned short*)(WD + (4 * q + 3) * P0_WDB_PITCH + k * 2) = (unsigned short)f2bf(w4.w * nk); } } }
    { float* WT = (float*)(F.ws + (235u << 20)); const float* wd = F.inp(30);
      for (int idx = (int)blockIdx.x * (NWAVES * 64) + F.tid; idx < 1024 * 32; idx += F.G * NWAVES * 64) { const int ch = idx >> 5, k = idx & 31; WT[idx] = (k < 31) ? wd[k * 1024 + ch] : 0.f; } }
    p0_weights(F, 0, P0_WIN_ITEMS);
    FSTAMP(F);
    bf16* CAT = (bf16*)(F.ws + WS_CAT); float* SS = (float*)(F.ws + WS_SS); float* DT = (float*)(F.ws + WS_DT); float* DA = (float*)(F.ws + WS_DA);
    typedef __bf16 p0_bf2 __attribute__((ext_vector_type(2)));
    __syncthreads();
    unsigned wdt[16][8];
#pragma unroll
    for (int h = 0; h < 16; ++h)
#pragma unroll
        for (int j = 0; j < 4; ++j) { const v2u w2 = *(const LAS v2u*)(F.lds + P0_WD_OFF + h * P0_WDB_PITCH + (4 * F.lane + 256 * j) * 2); wdt[h][2 * j] = w2.x; wdt[h][2 * j + 1] = w2.y; }
    const float dt_bias = F.inp(13)[F.lane & 15], dt_a = -__expf(F.inp(14)[F.lane & 15]);
    f32x4 nv[4];
    { const int m0 = gw < MT ? gw : 0; const float* xrow = (m0 < MP) ? F.inp(0) + (size_t)m0 * DM : F.inp(1) + (size_t)(m0 - MP) * DM; const GAS f32x4* xr = (const GAS f32x4*)xrow + F.lane;
#pragma unroll
      for (int j = 0; j < 4; ++j) nv[j] = __builtin_nontemporal_load(&xr[64 * j]); }
    for (int m = gw; m < MT; m += NGW) {
        f32x4 v[4]; float s = 0.f;
#pragma unroll
        for (int j = 0; j < 4; ++j) { v[j] = nv[j]; s += (v[j].x * v[j].x + v[j].y * v[j].y) + (v[j].z * v[j].z + v[j].w * v[j].w); }
        { const int mn = (m + NGW < MT) ? m + NGW : m; const float* xrow = (mn < MP) ? F.inp(0) + (size_t)mn * DM : F.inp(1) + (size_t)(mn - MP) * DM; const GAS f32x4* xr = (const GAS f32x4*)xrow + F.lane;
#pragma unroll
          for (int j = 0; j < 4; ++j) nv[j] = __builtin_nontemporal_load(&xr[64 * j]); }
        s = wave_sum(s);
        GAS unsigned long long* o8 = (GAS unsigned long long*)(CAT + (size_t)m * 2048 + 1024) + F.lane;
        unsigned xp[8];
#pragma unroll
        for (int j = 0; j < 4; ++j) { xp[2 * j] = pk2(v[j].x, v[j].y); xp[2 * j + 1] = pk2(v[j].z, v[j].w); o8[64 * j] = (unsigned long long)xp[2 * j] | ((unsigned long long)xp[2 * j + 1] << 32); }
        if (F.lane < 16) SS[(size_t)m * 16 + F.lane] = (F.lane == 0) ? s : 0.f;
        float dd[16];
#pragma unroll
        for (int h = 0; h < 16; ++h) {
            float d = 0.f;
#pragma unroll
            for (int q = 0; q < 8; ++q) d = __builtin_amdgcn_fdot2_f32_bf16(__builtin_bit_cast(p0_bf2, xp[q]), __builtin_bit_cast(p0_bf2, wdt[h][q]), d, false);
            dd[h] = d;
        }
        float dsel = row16_reduce_scatter(dd, F.lane);
        dsel += __shfl_xor(dsel, 16); dsel += __shfl_xor(dsel, 32);
        if (F.lane < 16) {
            const float xr_ = dsel * __builtin_amdgcn_rsqf(s * (1.0f / 1024.0f) + EPS) + dt_bias;
            const float dtv = xr_ > 20.f ? xr_ : log1pf(__expf(xr_));
            DT[(size_t)m * 16 + F.lane] = dtv; DA[(size_t)m * 16 + F.lane] = dtv * dt_a;
        }
    }
}
constexpr int DT_WPITCH = 2064;
__device__ __forceinline__ void dt_phase(Frame& F) {
    typedef short dt_bf16x8 __attribute__((ext_vector_type(8)));
    const bf16* WDT = (const bf16*)(F.ws + WS_WDT); const bf16* CAT = (const bf16*)(F.ws + WS_CAT); const float* SS = (const float*)(F.ws + WS_SS);
    float* DT = (float*)(F.ws + WS_DT); float* DA = (float*)(F.ws + WS_DA);
    LAS unsigned char* WL = F.lds;
    for (int pc = F.tid; pc < 16 * 128; pc += NWAVES * 64) { const int h = pc >> 7, q = pc & 127; *(LAS v4u*)(WL + h * DT_WPITCH + q * 16) = *(const v4u*)(WDT + (size_t)h * 1024 + q * 8); }
    __syncthreads();
    const int fr = F.lane & 15, fq = F.lane >> 4;
    const int gw = F.vcu * NWAVES + F.wave;
    if (gw < MT / 16) {
        const int row = gw * 16 + fr;
        const bf16* xp = CAT + (size_t)row * 2048 + 1024 + 8 * fq;
        f32x4 acc = (f32x4){0.f, 0.f, 0.f, 0.f};
#pragma unroll
        for (int s8 = 0; s8 < 4; ++s8) {
            dt_bf16x8 xf[8];
#pragma unroll
            for (int k = 0; k < 8; ++k) xf[k] = *(const dt_bf16x8*)(xp + 32 * (8 * s8 + k));
#pragma unroll
            for (int k = 0; k < 8; ++k) { const dt_bf16x8 wf = *(const LAS dt_bf16x8*)(WL + fr * DT_WPITCH + (32 * (8 * s8 + k) + 8 * fq) * 2);
                acc = __builtin_amdgcn_mfma_f32_16x16x32_bf16(wf, xf[k], acc, 0, 0, 0); }
        }
        const float rstd = row_rstd(SS, row);
        const f32x4 bias = *(const f32x4*)(F.inp(13) + 4 * fq), al = *(const f32x4*)(F.inp(14) + 4 * fq);
        f32x4 dtv, dav;
#pragma unroll
        for (int j = 0; j < 4; ++j) { const float xr_ = acc[j] * rstd + bias[j]; dtv[j] = xr_ > 20.f ? xr_ : log1pf(__expf(xr_)); dav[j] = -dtv[j] * __expf(al[j]); }
        *(f32x4*)(DT + (size_t)row * 16 + 4 * fq) = dtv; *(f32x4*)(DA + (size_t)row * 16 + 4 * fq) = dav;
    }
    __syncthreads();
}
typedef short s5_bf16x8 __attribute__((ext_vector_type(8)));
constexpr int S5_HB_ROW = 272;
constexpr int S5_HB_WAVE = 2 * 16 * S5_HB_ROW;
constexpr int S5_HE_OFF = NWAVES * S5_HB_WAVE;
constexpr int S5_YT_OFF = S5_HE_OFF + NWAVES * 2 * 64 * 2 * 4;
constexpr int S5_LDS_END = S5_YT_OFF + NWAVES * 1024;
static_assert(S5_LDS_END <= LDSCTL_OFF, "S5 LDS");
constexpr int S5_PROMPT_UNITS = 256, S5_SAMPLE_UNITS = 256, S5_UNITS = S5_PROMPT_UNITS + S5_SAMPLE_UNITS;

__device__ __forceinline__ float gelu_tanh(float x) {
    const float arg = x * __builtin_fmaf(x * x, 0.10294324f, 2.3022082f);
    const float r = frcp_(__builtin_amdgcn_exp2f(arg) + 1.0f);
    return __builtin_fmaf(-x, r, x);
}

struct S5Consts {
    float lr[2], li[2];
    s5_bf16x8 bfr[2][2];
    s5_bf16x8 cm[4];
    s5_bf16x8 dm;
};
__device__ __forceinline__ void s5_setup(const Frame& F, int g, S5Consts& K) {
    const int lane = F.lane, r = lane & 31, hh = lane >> 5;
    const float step = expf(F.inp(19)[g]);
#pragma unroll
    for (int pt = 0; pt < 2; ++pt) {
        const int p = 32 * pt + r;
        const float lr = F.inp(17)[g * 64 + p], li = F.inp(18)[g * 64 + p];
        const float mag = expf(lr * step), ar = mag * cosf(li * step), ai = mag * sinf(li * step);
        const float den = lr * lr + li * li;
        const float kr = ((ar - 1.0f) * lr + ai * li) / den, ki = (ai * lr - (ar - 1.0f) * li) / den;
        K.lr[pt] = ar; K.li[pt] = ai;
        const float* br = F.inp(20) + ((size_t)(g * 64 + p) * 16 + 8 * hh); const float* bi = F.inp(21) + ((size_t)(g * 64 + p) * 16 + 8 * hh);
        unsigned wr_[4], wi_[4];
#pragma unroll
        for (int j = 0; j < 4; ++j) {
            const float b0r = br[2 * j], b0i = bi[2 * j], b1r = br[2 * j + 1], b1i = bi[2 * j + 1];
            wr_[j] = pk2(kr * b0r - ki * b0i, kr * b1r - ki * b1i);
            wi_[j] = pk2(kr * b0i + ki * b0r, kr * b1i + ki * b1r);
        }
        K.bfr[pt][0] = __builtin_bit_cast(s5_bf16x8, (v4u){wr_[0], wr_[1], wr_[2], wr_[3]});
        K.bfr[pt][1] = __builtin_bit_cast(s5_bf16x8, (v4u){wi_[0], wi_[1], wi_[2], wi_[3]});
    }
    const int c = lane & 15, q = lane >> 4;
#pragma unroll
    for (int s = 0; s < 4; ++s) {
        const int p0 = 16 * s + 4 * q;
        const float* cr = F.inp(22) + ((size_t)(g * 16 + c) * 64 + p0); const float* ci = F.inp(23) + ((size_t)(g * 16 + c) * 64 + p0);
        unsigned w[4];
#pragma unroll
        for (int j = 0; j < 4; ++j) w[j] = pk2(cr[j], -ci[j]);
        K.cm[s] = __builtin_bit_cast(s5_bf16x8, (v4u){w[0], w[1], w[2], w[3]});
    }
    { const float dv = F.inp(24)[g * 16 + c]; unsigned w[4];
#pragma unroll
      for (int j = 0; j < 4; ++j) { const int k0 = 8 * q + 2 * j; w[j] = pk2((q < 2 && k0 == c) ? dv : 0.f, (q < 2 && k0 + 1 == c) ? dv : 0.f); }
      K.dm = __builtin_bit_cast(s5_bf16x8, (v4u){w[0], w[1], w[2], w[3]}); }
}

struct S5Frags { s5_bf16x8 a, u0, u1; };
template <bool WITH_Y>
__device__ __forceinline__ S5Frags s5_load_a(const Frame& F, const bf16* U, int g, int base0, int base1) {
    S5Frags fr;
    const int r = F.lane & 31, hh = F.lane >> 5, h = (r >> 2) & 1, i = (r & 3) + 4 * (r >> 3);
    const int arow = (h ? base1 : base0) + i;
    fr.a = *(const GAS s5_bf16x8*)(U + (size_t)arow * 1024 + g * 16 + 8 * hh);
    const s5_bf16x8 zz = (s5_bf16x8){0, 0, 0, 0, 0, 0, 0, 0};
    fr.u0 = zz; fr.u1 = zz;
    if (WITH_Y) {
        const int t = F.lane & 15, q = F.lane >> 4;
        if (q < 2) { fr.u0 = *(const GAS s5_bf16x8*)(U + (size_t)(base0 + t) * 1024 + g * 16 + 8 * q); fr.u1 = *(const GAS s5_bf16x8*)(U + (size_t)(base1 + t) * 1024 + g * 16 + 8 * q); }
    }
    return fr;
}

template <int SEGLEN, bool WITH_Y>
__device__ __forceinline__ void s5_step(const Frame& F, const S5Consts& K, bf16* U, int g, int base0, int base1, const S5Frags& fg,
                                        float (&hr)[2][2], float (&hi)[2][2]  , LAS unsigned char* hb, LAS unsigned char* yt) {
    const s5_bf16x8 afrag = fg.a;
    const int lane = F.lane, hh = lane >> 5, r = lane & 31;
    f32x16 bu[2][2];
#pragma unroll
    for (int pt = 0; pt < 2; ++pt)
#pragma unroll
        for (int ri = 0; ri < 2; ++ri) {
            f32x16 z;
#pragma unroll
            for (int i = 0; i < 16; ++i) z[i] = 0.f;
            bu[pt][ri] = __builtin_amdgcn_mfma_f32_32x32x16_bf16(afrag, K.bfr[pt][ri], z, 0, 0, 0);
        }
#pragma unroll
    for (int i = 0; i < 16; ++i) {
        constexpr int dummy = 0; (void)dummy;
        const int cs = (SEGLEN == 8) ? (i >> 3) : 0;
#pragma unroll
        for (int pt = 0; pt < 2; ++pt) {
            const float nr = __builtin_fmaf(K.lr[pt], hr[cs][pt], __builtin_fmaf(-K.li[pt], hi[cs][pt], bu[pt][0][i]));
            const float ni = __builtin_fmaf(K.lr[pt], hi[cs][pt], __builtin_fmaf(K.li[pt], hr[cs][pt], bu[pt][1][i]));
            hr[cs][pt] = nr; hi[cs][pt] = ni;
            if (WITH_Y) *(LAS unsigned*)(hb + (hh * 16 + i) * S5_HB_ROW + (2 * (32 * pt + r)) * 2) = pk2(nr, ni);
        }
    }
    if (WITH_Y) {
        LDS_WAIT(); asm volatile("" ::: "memory");
        const int c = lane & 15, q = lane >> 4;
#pragma unroll
        for (int hf = 0; hf < 2; ++hf) {
            f32x4 y = (f32x4){0.f, 0.f, 0.f, 0.f};
#pragma unroll
            for (int s = 0; s < 4; ++s) {
                const s5_bf16x8 a = *(const LAS s5_bf16x8*)(hb + (hf * 16 + c) * S5_HB_ROW + (32 * s + 8 * q) * 2);
                y = __builtin_amdgcn_mfma_f32_16x16x32_bf16(a, K.cm[s], y, 0, 0, 0);
            }
            y = __builtin_amdgcn_mfma_f32_16x16x32_bf16(hf ? fg.u1 : fg.u0, K.dm, y, 0, 0, 0);
#pragma unroll
            for (int j = 0; j < 4; ++j) *(LAS unsigned short*)(yt + ((hf * 16 + 4 * q + j) * 16 + c) * 2) = (unsigned short)f2bf(gelu_tanh(y[j]));
        }
        {
            const int hf2 = lane >> 5, t = (lane & 31) >> 1, ck = lane & 1;
            const v4u o = *(const LAS v4u*)(yt + ((hf2 * 16 + t) * 16 + 8 * ck) * 2);
            *(GAS v4u*)(U + (size_t)((hf2 ? base1 : base0) + t) * 1024 + g * 16 + 8 * ck) = o;
        }
        LDS_WAIT(); asm volatile("" ::: "memory");
    }
}

__device__ __forceinline__ void s5_block_unit(Frame& F, int unit, S5Consts& K, int& kg  ) {
    bf16* U = (bf16*)(F.ws + WS_U);
    LAS unsigned char* hb = F.lds + F.wave * S5_HB_WAVE;
    LAS unsigned char* yt = F.lds + S5_YT_OFF + F.wave * 1024;
    LAS float* HE = (LAS float*)(F.lds + S5_HE_OFF);
    const int lane = F.lane, hh = lane >> 5, r = lane & 31, w = F.wave;
    if (unit < S5_PROMPT_UNITS) {
        const int g = unit & 63, bp = unit >> 6;
        FSTAMP(F);
        const int rb0 = bp * SEQ + 256 * w, rb1 = (bp + 4) * SEQ + 256 * w;
        S5Frags pf0 = s5_load_a<false>(F, U, g, rb0, rb1), pf1 = s5_load_a<false>(F, U, g, rb0 + 16, rb1 + 16);
        if (kg != g) { s5_setup(F, g, K); kg = g; }
        FSTAMP(F);
        float hr[2][2], hi[2][2];
#pragma unroll
        for (int a = 0; a < 2; ++a)
#pragma unroll
            for (int b = 0; b < 2; ++b) { hr[a][b] = 0.f; hi[a][b] = 0.f; }
        if (w < 7) {
            S5Frags af = pf0, af1 = pf1;
            for (int s = 0; s < 16; ++s) {
                const int s2 = (s + 2) & 15;
                const S5Frags af2 = s5_load_a<false>(F, U, g, rb0 + 16 * s2, rb1 + 16 * s2);
                s5_step<16, false>(F, K, U, g, rb0 + 16 * s, rb1 + 16 * s, af, hr, hi, hb, yt);
                af = af1; af1 = af2;
            }
        }
        S5Frags qf0 = s5_load_a<true>(F, U, g, rb0, rb1), qf1 = s5_load_a<true>(F, U, g, rb0 + 16, rb1 + 16);
#pragma unroll
        for (int pt = 0; pt < 2; ++pt) { HE[((w * 2 + hh) * 64 + 32 * pt + r) * 2 + 0] = hr[0][pt]; HE[((w * 2 + hh) * 64 + 32 * pt + r) * 2 + 1] = hi[0][pt]; }
        FSTAMP(F);
        __syncthreads();
        FSTAMP(F);
        float l256r[2], l256i[2];
#pragma unroll
        for (int pt = 0; pt < 2; ++pt) { float ar = K.lr[pt], ai = K.li[pt];
#pragma unroll
            for (int k = 0; k < 8; ++k) { const float nr = ar * ar - ai * ai, ni = 2.0f * ar * ai; ar = nr; ai = ni; }
            l256r[pt] = ar; l256i[pt] = ai; hr[0][pt] = 0.f; hi[0][pt] = 0.f; }
        for (int cp = 0; cp < w; ++cp) {
#pragma unroll
            for (int pt = 0; pt < 2; ++pt) {
                const float er = HE[((cp * 2 + hh) * 64 + 32 * pt + r) * 2 + 0], ei = HE[((cp * 2 + hh) * 64 + 32 * pt + r) * 2 + 1];
                const float nr = l256r[pt] * hr[0][pt] - l256i[pt] * hi[0][pt] + er, ni = l256r[pt] * hi[0][pt] + l256i[pt] * hr[0][pt] + ei;
                hr[0][pt] = nr; hi[0][pt] = ni; }
        }
        FSTAMP(F);
        {
            if (w >= 4) __builtin_amdgcn_s_sleep(12);
            S5Frags af = qf0, af1 = qf1;
            for (int s = 0; s < 16; ++s) {
                const int s2 = (s + 2 < 16) ? s + 2 : 15;
                const S5Frags af2 = s5_load_a<true>(F, U, g, rb0 + 16 * s2, rb1 + 16 * s2);
                s5_step<16, true>(F, K, U, g, rb0 + 16 * s, rb1 + 16 * s, af, hr, hi, hb, yt);
                af = af1; af1 = af2;
            }
        }
        FSTAMP(F);
        if (w == 7) {
            const int b = hh ? bp + 4 : bp;
#pragma unroll
            for (int pt = 0; pt < 2; ++pt) { F.out[O_PBR + (size_t)(b * 64 + g) * 64 + 32 * pt + r] = hr[0][pt]; F.out[O_PBI + (size_t)(b * 64 + g) * 64 + 32 * pt + r] = hi[0][pt]; }
        }
        __syncthreads();
    } else {
        const int su = unit - S5_PROMPT_UNITS, g = su & 63, quarter = su >> 6;
        if (kg != g) { s5_setup(F, g, K); kg = g; }
        for (int qq = 0; qq < 1; ++qq) {
            const int quad = quarter * 8 + w, sb0 = 4 * quad;
            const int base0 = MP + sb0 * 8, base1 = base0 + 16;
            float hr[2][2], hi[2][2];
#pragma unroll
            for (int cs = 0; cs < 2; ++cs)
#pragma unroll
                for (int pt = 0; pt < 2; ++pt) { const int seq = sb0 + 2 * hh + cs; const size_t o = (size_t)(seq * 64 + g) * 64 + 32 * pt + r; hr[cs][pt] = F.inp(4)[o]; hi[cs][pt] = F.inp(5)[o]; }
            const S5Frags af = s5_load_a<true>(F, U, g, base0, base1);
            s5_step<8, true>(F, K, U, g, base0, base1, af, hr, hi, hb, yt);
#pragma unroll
            for (int cs = 0; cs < 2; ++cs)
#pragma unroll
                for (int pt = 0; pt < 2; ++pt) { const int seq = sb0 + 2 * hh + cs; const size_t o = (size_t)(seq * 64 + g) * 64 + 32 * pt + r; F.out[O_SBR + o] = hr[cs][pt]; F.out[O_SBI + o] = hi[cs][pt]; }
        }
    }
}
constexpr size_t WS_HALO = 230 * MiB;
constexpr size_t WS_CDEC = 234 * MiB;
typedef short ssd_bf16x8 __attribute__((ext_vector_type(8)));
constexpr int SSD_PITCH = 272;

constexpr int SSDS_XS = 0, SSDS_BS = SSDS_XS + 8 * 256 * 4, SSDS_CS = SSDS_BS + 8 * 128 * 4, SSDS_YS = SSDS_CS + 8 * 128 * 4, SSDS_END = SSDS_YS + 8 * 256 * 4;
__device__ __forceinline__ void ssd_sample_unit(Frame& F, int unit) {
    const int b = unit >> 2, g = unit & 3, tid = F.tid, lane = F.lane;
    const bf16* XBC = (const bf16*)(F.ws + WS_XBC); bf16* CAT = (bf16*)(F.ws + WS_CAT);
    const float* DT = (const float*)(F.ws + WS_DT); const float* DA = (const float*)(F.ws + WS_DA);
    LAS float* xs = (LAS float*)(F.lds + SSDS_XS); LAS float* Bs = (LAS float*)(F.lds + SSDS_BS); LAS float* Cs = (LAS float*)(F.lds + SSDS_CS); LAS float* ys = (LAS float*)(F.lds + SSDS_YS);
    const int row0 = MP + b * 8;
    const int p = tid >> 3, ns = tid & 7;
    f32x4 hst[4][4];
#pragma unroll
    for (int e = 0; e < 4; ++e) { const float* sp = F.inp(3) + ((size_t)(b * 16 + 4 * g + e) * 64 + p) * 128 + ns * 4;
#pragma unroll
        for (int k = 0; k < 4; ++k) hst[e][k] = __builtin_nontemporal_load((const f32x4*)(sp + 32 * k)); }
    f32x4 dt4[8], da4[8];
#pragma unroll
    for (int t = 0; t < 8; ++t) { dt4[t] = *(const f32x4*)(DT + (size_t)(row0 + t) * 16 + 4 * g); da4[t] = *(const f32x4*)(DA + (size_t)(row0 + t) * 16 + 4 * g); }
    bf16* zp = CAT + (size_t)(row0 + F.wave) * 2048 + g * 256 + 4 * lane;
    const v2u zw = *(const v2u*)zp;
    {
        const int col = (tid < 256) ? (g * 256 + tid) : ((tid < 384) ? (1024 + g * 128 + (tid - 256)) : (1536 + g * 128 + (tid - 384)));
        const float* cw = F.inp(11); const float w0 = cw[col], w1 = cw[2048 + col], w2 = cw[4096 + col], w3 = cw[6144 + col], bias = F.inp(12)[col];
        const float* st = F.inp(2) + (size_t)b * 3 * 2048 + col;
        float x0 = st[0], x1 = st[2048], x2 = st[4096];
        float xr[8];
#pragma unroll
        for (int t = 0; t < 8; ++t) xr[t] = bf2f(XBC[(size_t)(row0 + t) * 2048 + col]);
#pragma unroll
        for (int t = 0; t < 8; ++t) {
            const float x3 = xr[t];
            const float o = siluf_(bias + w0 * x0 + w1 * x1 + w2 * x2 + w3 * x3);
            if (tid < 256) xs[t * 256 + tid] = o; else if (tid < 384) Bs[t * 128 + (tid - 256)] = o; else Cs[t * 128 + (tid - 384)] = o;
            x0 = x1; x1 = x2; x2 = x3;
        }
    }
    __syncthreads();
#pragma unroll
    for (int e = 0; e < 4; ++e) {
        const int head = 4 * g + e;
        const size_t so = ((size_t)(b * 16 + head) * 64 + p) * 128 + ns * 4;
        const float dsk = F.inp(15)[head];
#pragma unroll
        for (int t = 0; t < 8; ++t) {
            const float dec = __expf(da4[t][e]);
            const float xv = xs[t * 256 + e * 64 + p], dtx = dt4[t][e] * xv;
            float yp = 0.f, yq = 0.f;
#pragma unroll
            for (int k = 0; k < 4; ++k) {
                const f32x4 bv = *(const LAS f32x4*)(Bs + t * 128 + ns * 4 + 32 * k), cv = *(const LAS f32x4*)(Cs + t * 128 + ns * 4 + 32 * k);
                hst[e][k] = hst[e][k] * dec + bv * dtx;
                yp = __builtin_fmaf(cv.x, hst[e][k].x, yp); yq = __builtin_fmaf(cv.y, hst[e][k].y, yq);
                yp = __builtin_fmaf(cv.z, hst[e][k].z, yp); yq = __builtin_fmaf(cv.w, hst[e][k].w, yq);
            }
            yp = dpp_sum8(yp + yq);
            if (ns == 0) ys[t * 256 + e * 64 + p] = yp + dsk * xv;
            asm volatile("" ::: "memory");
        }
#pragma unroll
        for (int k = 0; k < 4; ++k) __builtin_nontemporal_store(hst[e][k], (f32x4*)(F.out + O_SAS + so + 32 * k));
    }
    __syncthreads();
    {
        const int t = F.wave, ch = 4 * lane;
        const f32x4 yv = *(const LAS f32x4*)(ys + t * 256 + ch);
        f32x4 gv; gv.x = yv.x * siluf_(bflo(zw.x)); gv.y = yv.y * siluf_(bfhi(zw.x)); gv.z = yv.z * siluf_(bflo(zw.y)); gv.w = yv.w * siluf_(bfhi(zw.y));
        const float ssq = wave_sum((gv.x * gv.x + gv.y * gv.y) + (gv.z * gv.z + gv.w * gv.w));
        const float rs = __builtin_amdgcn_rsqf(ssq * (1.0f / 256.0f) + EPS);
        const f32x4 nw = *(const f32x4*)(F.inp(16) + g * 256 + ch);
        v2u o; o.x = pk2(gv.x * rs * nw.x, gv.y * rs * nw.y); o.y = pk2(gv.z * rs * nw.z, gv.w * rs * nw.w);
        *(v2u*)zp = o;
    }
    __syncthreads();
}

__device__ __forceinline__ void ssd_cum(Frame& F, int rowc  , int g, LAS float* cum, LAS float* dtl) {
    if (F.wave < 4) {
        const int e = F.wave, l = F.lane; const float* DT = (const float*)(F.ws + WS_DT); const float* DA = (const float*)(F.ws + WS_DA);
        const float a0 = DA[(size_t)(rowc + 2 * l) * 16 + 4 * g + e], a1 = DA[(size_t)(rowc + 2 * l + 1) * 16 + 4 * g + e];
        dtl[e * 128 + 2 * l] = DT[(size_t)(rowc + 2 * l) * 16 + 4 * g + e]; dtl[e * 128 + 2 * l + 1] = DT[(size_t)(rowc + 2 * l + 1) * 16 + 4 * g + e];
        float s = a0 + a1;
#pragma unroll
        for (int o = 1; o < 64; o <<= 1) { const float t = __shfl_up(s, o); if (l >= o) s += t; }
        cum[e * 128 + 2 * l + 1] = s * 1.4426950408889634f; cum[e * 128 + 2 * l] = (s - a1) * 1.4426950408889634f;
    }
}

constexpr int SSD2_XT = 0, SSD2_BT = SSD2_XT + 256 * SSD_PITCH, SSD2_CUM = SSD2_BT + 128 * SSD_PITCH, SSD2_DT = SSD2_CUM + 4 * 128 * 4, SSD2_W = SSD2_DT + 4 * 128 * 4, SSD2_END = SSD2_W + 4 * 128 * 4;
static_assert(SSD2_END <= LDSCTL_OFF, "SSD2 LDS");
__device__ __forceinline__ void ssd_state_unit(Frame& F, int unit) {
    const int g = unit & 3, c = (unit >> 2) & 15, b = unit >> 6, tid = F.tid, lane = F.lane;
    bf16* XBC = (bf16*)(F.ws + WS_XBC); const bf16* HALO = (const bf16*)(F.ws + WS_HALO);
    bf16* SSTB = (bf16*)(F.out + O_Y); float* CDEC = (float*)(F.ws + WS_CDEC);
    LAS unsigned char* XT = F.lds + SSD2_XT; LAS unsigned char* BT = F.lds + SSD2_BT;
    LAS float* cum = (LAS float*)(F.lds + SSD2_CUM); LAS float* dtl = (LAS float*)(F.lds + SSD2_DT); LAS float* wl = (LAS float*)(F.lds + SSD2_W);
    const int rowc = b * SEQ + c * 128;
    {
        const int cp = tid & 255, th = tid >> 8;
        const int kind = (cp < 128) ? 0 : ((cp < 192) ? 1 : 2);
        const int lc = (kind == 0) ? 2 * cp : ((kind == 1) ? 2 * (cp - 128) : 2 * (cp - 192));
        const int col = (kind == 0) ? (g * 256 + lc) : ((kind == 1) ? (1024 + g * 128 + lc) : (1536 + g * 128 + lc));
        const float* cw = F.inp(11);
        const float wa0 = cw[col], wa1 = cw[2048 + col], wa2 = cw[4096 + col], wa3 = cw[6144 + col], ba = F.inp(12)[col];
        const float wb0 = cw[col + 1], wb1 = cw[2048 + col + 1], wb2 = cw[4096 + col + 1], wb3 = cw[6144 + col + 1], bb = F.inp(12)[col + 1];
        const int seg = c * 2 + th;
        float xa0 = 0.f, xa1 = 0.f, xa2 = 0.f, xb0 = 0.f, xb1 = 0.f, xb2 = 0.f;
        if (seg > 0) { const bf16* hp = HALO + ((size_t)(b * 32 + seg - 1) * 3) * 2048 + col;
            const unsigned h0 = *(const unsigned*)hp, h1 = *(const unsigned*)(hp + 2048), h2 = *(const unsigned*)(hp + 4096);
            xa0 = bflo(h0); xb0 = bfhi(h0); xa1 = bflo(h1); xb1 = bfhi(h1); xa2 = bflo(h2); xb2 = bfhi(h2); }
        const int e = lc >> 6;
        bf16* xp = XBC + (size_t)(rowc + 64 * th) * 2048 + col;
        unsigned nxt[8], nx2[8];
#pragma unroll
        for (int k = 0; k < 8; ++k) { nxt[k] = __builtin_nontemporal_load((const unsigned*)(xp + (size_t)k * 2048)); nx2[k] = __builtin_nontemporal_load((const unsigned*)(xp + (size_t)(8 + k) * 2048)); }
        ssd_cum(F, rowc, g, cum, dtl);
        __syncthreads();
        { const int e2 = tid >> 7, j = tid & 127; wl[e2 * 128 + j] = __builtin_amdgcn_exp2f(cum[e2 * 128 + 127] - cum[e2 * 128 + j]) * dtl[e2 * 128 + j];
          if (j == 127) CDEC[(b * 16 + c) * 16 + 4 * g + e2] = __builtin_amdgcn_exp2f(cum[e2 * 128 + 127]); }
        __syncthreads();
        for (int t8 = 0; t8 < 8; ++t8) {
            unsigned raw[8];
#pragma unroll
            for (int k = 0; k < 8; ++k) { raw[k] = nxt[k]; nxt[k] = nx2[k]; }
            if (t8 < 6) {
#pragma unroll
                for (int k = 0; k < 8; ++k) nx2[k] = __builtin_nontemporal_load((const unsigned*)(xp + (size_t)(t8 * 8 + 16 + k) * 2048));
            }
            unsigned oa[4], ob[4]; float pa = 0.f, pb = 0.f;
#pragma unroll
            for (int k = 0; k < 8; ++k) {
                const float xa3 = bflo(raw[k]), xb3 = bfhi(raw[k]);
                const float va = siluf_(ba + wa0 * xa0 + wa1 * xa1 + wa2 * xa2 + wa3 * xa3), vb = siluf_(bb + wb0 * xb0 + wb1 * xb1 + wb2 * xb2 + wb3 * xb3);
                xa0 = xa1; xa1 = xa2; xa2 = xa3; xb0 = xb1; xb1 = xb2; xb2 = xb3;
                *(unsigned*)(xp + (size_t)(t8 * 8 + k) * 2048) = pk2(va, vb);
                float sa = va, sb = vb;
                if (kind == 0) { const float ww = wl[e * 128 + 64 * th + t8 * 8 + k]; sa *= ww; sb *= ww; }
                if (k & 1) { oa[k >> 1] = pk2(pa, sa); ob[k >> 1] = pk2(pb, sb); } else { pa = sa; pb = sb; }
            }
            if (kind == 0) { *(LAS v4u*)(XT + lc * SSD_PITCH + (64 * th + t8 * 8) * 2) = (v4u){oa[0], oa[1], oa[2], oa[3]}; *(LAS v4u*)(XT + (lc + 1) * SSD_PITCH + (64 * th + t8 * 8) * 2) = (v4u){ob[0], ob[1], ob[2], ob[3]}; }
            else if (kind == 1) { *(LAS v4u*)(BT + lc * SSD_PITCH + (64 * th + t8 * 8) * 2) = (v4u){oa[0], oa[1], oa[2], oa[3]}; *(LAS v4u*)(BT + (lc + 1) * SSD_PITCH + (64 * th + t8 * 8) * 2) = (v4u){ob[0], ob[1], ob[2], ob[3]}; }
        }
    }
    __syncthreads();
    {
        const int e = F.wave >> 1, ph = F.wave & 1, r = lane & 31, hh = lane >> 5;
        f32x16 acc[4];
#pragma unroll
        for (int nt = 0; nt < 4; ++nt)
#pragma unroll
            for (int i = 0; i < 16; ++i) acc[nt][i] = 0.f;
#pragma unroll
        for (int s = 0; s < 8; ++s) {
            const ssd_bf16x8 a = *(const LAS ssd_bf16x8*)(XT + (e * 64 + 32 * ph + r) * SSD_PITCH + (16 * s + 8 * hh) * 2);
#pragma unroll
            for (int nt = 0; nt < 4; ++nt) {
                const ssd_bf16x8 bq = *(const LAS ssd_bf16x8*)(BT + (32 * nt + r) * SSD_PITCH + (16 * s + 8 * hh) * 2);
                acc[nt] = __builtin_amdgcn_mfma_f32_32x32x16_bf16(a, bq, acc[nt], 0, 0, 0);
            }
        }
        bf16* sp = SSTB + ((size_t)((b * 16 + c) * 16 + 4 * g + e) * 64 + 32 * ph) * 128;
#pragma unroll
        for (int nt = 0; nt < 4; ++nt)
#pragma unroll
            for (int i = 0; i < 16; ++i) { const int prow = (i & 3) + 8 * (i >> 2) + 4 * hh; sp[(size_t)prow * 128 + 32 * nt + r] = (bf16)f2bf_int(acc[nt][i]); }
    }
    __syncthreads();
}

__device__ __forceinline__ void ssd_carry(Frame& F) {
    bf16* SSTB = (bf16*)(F.out + O_Y); const float* CDEC = (const float*)(F.ws + WS_CDEC);
    const int gt = (int)blockIdx.x * 512 + F.tid, NT = F.G * 512;
    for (int idx = gt; idx < 8 * 16 * 1024; idx += NT) {
        const int q8 = idx & 1023, head = (idx >> 10) & 15, b = idx >> 14;
        float h[8];
#pragma unroll
        for (int k = 0; k < 8; ++k) h[k] = 0.f;
        v4u cur = __builtin_nontemporal_load((const v4u*)(SSTB + ((size_t)((b * 16 + 0) * 16 + head)) * 8192) + q8);
        for (int c = 0; c < 16; ++c) {
            v4u* sp = (v4u*)(SSTB + ((size_t)((b * 16 + c) * 16 + head)) * 8192) + q8;
            const v4u sv = cur;
            if (c < 15) cur = __builtin_nontemporal_load((const v4u*)(SSTB + ((size_t)((b * 16 + c + 1) * 16 + head)) * 8192) + q8);
            *sp = (v4u){pk2(h[0], h[1]), pk2(h[2], h[3]), pk2(h[4], h[5]), pk2(h[6], h[7])};
            const float d = CDEC[(b * 16 + c) * 16 + head];
            h[0] = h[0] * d + bflo(sv.x); h[1] = h[1] * d + bfhi(sv.x); h[2] = h[2] * d + bflo(sv.y); h[3] = h[3] * d + bfhi(sv.y);
            h[4] = h[4] * d + bflo(sv.z); h[5] = h[5] * d + bfhi(sv.z); h[6] = h[6] * d + bflo(sv.w); h[7] = h[7] * d + bfhi(sv.w);
        }
        f32x4* op = (f32x4*)(F.out + O_PAS + (size_t)(b * 16 + head) * 8192) + 2 * q8;
        __builtin_nontemporal_store((f32x4){h[0], h[1], h[2], h[3]}, &op[0]); __builtin_nontemporal_store((f32x4){h[4], h[5], h[6], h[7]}, &op[1]);
    }
}

constexpr int SSD4_ZP = 144, SSD4_OP = 528;
constexpr int SSD4_CS = 0, SSD4_BS = SSD4_CS + 128 * SSD_PITCH, SSD4_L = SSD4_BS + 128 * SSD_PITCH, SSD4_XT = SSD4_L + 128 * SSD_PITCH, SSD4_HIN = SSD4_XT + 64 * SSD_PITCH,
              SSD4_CUM = SSD4_HIN + 64 * SSD_PITCH, SSD4_DT = SSD4_CUM + 4 * 128 * 4, SSD4_RED = SSD4_DT + 4 * 128 * 4, SSD4_END = SSD4_RED + 2 * 128 * 4;
static_assert(SSD4_END <= LDSCTL_OFF && 128 * SSD4_ZP <= 128 * SSD_PITCH && 128 * SSD4_OP <= SSD4_XT, "SSD4 LDS");
__device__ __forceinline__ void ssd_y_unit(Frame& F, int unit) {
    const int g = unit & 3, c = (unit >> 2) & 15, b = unit >> 6, tid = F.tid, lane = F.lane, wv = F.wave, r = lane & 31, hh = lane >> 5;
    const bf16* XBC = (const bf16*)(F.ws + WS_XBC); bf16* CAT = (bf16*)(F.ws + WS_CAT); const bf16* HINB = (const bf16*)(F.out + O_Y);
    LAS unsigned char* Cs = F.lds + SSD4_CS; LAS unsigned char* Bs = F.lds + SSD4_BS; LAS unsigned char* Lm = F.lds + SSD4_L; LAS unsigned char* XT = F.lds + SSD4_XT; LAS unsigned char* Hn = F.lds + SSD4_HIN;
    LAS float* cum = (LAS float*)(F.lds + SSD4_CUM); LAS float* dtl = (LAS float*)(F.lds + SSD4_DT); LAS float* red = (LAS float*)(F.lds + SSD4_RED);
    const int rowc = b * SEQ + c * 128;
    const bool stp = unit < 256;
    if (stp) FSTAMP(F);
    unsigned pre_raw[8]; v4u pre_z[2]; v4u pre_h[2];
#define SSD4_PREFETCH(EE) do { const int _e = (EE); \
        { const int cp = tid & 31, tb = tid >> 5; _Pragma("unroll") for (int k = 0; k < 8; ++k) pre_raw[k] = __builtin_nontemporal_load((const unsigned*)(XBC + (size_t)(rowc + tb * 8 + k) * 2048 + g * 256 + _e * 64 + 2 * cp)); } \
        _Pragma("unroll") for (int k = 0; k < 2; ++k) { const int pc = tid + 512 * k, row = pc >> 3, q = pc & 7; pre_z[k] = __builtin_nontemporal_load((const v4u*)(CAT + (size_t)(rowc + row) * 2048 + g * 256 + _e * 64 + q * 8)); } \
        { const int p = tid >> 3, n0 = (tid & 7) * 16; const v4u* hp = (const v4u*)(HINB + ((size_t)((b * 16 + c) * 16 + 4 * g + _e) * 64 + p) * 128 + n0); \
          pre_h[0] = __builtin_nontemporal_load(&hp[0]); pre_h[1] = __builtin_nontemporal_load(&hp[1]); } } while (0)
    v4u bcb[4], bcc[4];
#pragma unroll
    for (int k = 0; k < 4; ++k) { const int pc = tid + 512 * k, row = pc >> 4, q = pc & 15;
        bcb[k] = __builtin_nontemporal_load((const v4u*)(XBC + (size_t)(rowc + row) * 2048 + 1024 + g * 128 + q * 8)); bcc[k] = __builtin_nontemporal_load((const v4u*)(XBC + (size_t)(rowc + row) * 2048 + 1536 + g * 128 + q * 8)); }
    SSD4_PREFETCH(0);
    ssd_cum(F, rowc, g, cum, dtl);
#pragma unroll
    for (int k = 0; k < 4; ++k) { const int pc = tid + 512 * k, row = pc >> 4, q = pc & 15;
        *(LAS v4u*)(Bs + row * SSD_PITCH + q * 16) = bcb[k]; *(LAS v4u*)(Cs + row * SSD_PITCH + q * 16) = bcc[k]; }
    __syncthreads();
    if (stp) FSTAMP(F);
    const int pw = (0x50317642 >> (4 * wv)) & 7;
    f32x16 G[2];
#pragma unroll
    for (int tt = 0; tt < 2; ++tt) {
        const int idx = 2 * pw + tt, it = idx >> 2, jt = idx & 3;
#pragma unroll
        for (int i = 0; i < 16; ++i) G[tt][i] = 0.f;
        if (jt <= it) {
#pragma unroll
            for (int s = 0; s < 8; ++s) {
                const ssd_bf16x8 a = *(const LAS ssd_bf16x8*)(Cs + (32 * it + r) * SSD_PITCH + (16 * s + 8 * hh) * 2);
                const ssd_bf16x8 bq = *(const LAS ssd_bf16x8*)(Bs + (32 * jt + r) * SSD_PITCH + (16 * s + 8 * hh) * 2);
                G[tt] = __builtin_amdgcn_mfma_f32_32x32x16_bf16(a, bq, G[tt], 0, 0, 0);
            }
        }
    }
    __syncthreads();
    if (stp) FSTAMP(F);
    const int yit = wv >> 1, ypt = wv & 1;
    v4u ya0, yb0, ya1, yb1, ya2, yb2, ya3, yb3;
    float ssq_acc = 0.f;
    for (int e = 0; e < 4; ++e) {
        asm volatile("" ::: "memory");
#pragma unroll
        for (int tt = 0; tt < 2; ++tt) {
            const int idx = 2 * pw + tt, it = idx >> 2, jt = idx & 3;
            const int j = 32 * jt + r;
            if (jt > it) {
                if (e == 0) {
#pragma unroll
                    for (int i16 = 0; i16 < 16; ++i16) { const int i = 32 * it + (i16 & 3) + 8 * (i16 >> 2) + 4 * hh; *(LAS unsigned short*)(Lm + i * SSD_PITCH + j * 2) = (unsigned short)0; }
                }
                continue;
            }
            const float cj = cum[e * 128 + j], dj = dtl[e * 128 + j];
#pragma unroll
            for (int a4 = 0; a4 < 4; ++a4) {
                const f32x4 ci = *(const LAS f32x4*)(cum + e * 128 + 32 * it + 8 * a4 + 4 * hh);
#pragma unroll
                for (int b4 = 0; b4 < 4; ++b4) {
                    const int i16 = 4 * a4 + b4, i = 32 * it + b4 + 8 * a4 + 4 * hh;
                    float v = 0.f;
                    if (j <= i) v = G[tt][i16] * __builtin_amdgcn_exp2f(ci[b4] - cj) * dj;
                    *(LAS unsigned short*)(Lm + i * SSD_PITCH + j * 2) = (unsigned short)f2bf(v);
                }
            }
        }
        { const int cp = tid & 31, tb = tid >> 5;
          v4u oa, ob;
          oa.x = (pre_raw[0] & 0xffffu) | (pre_raw[1] << 16); oa.y = (pre_raw[2] & 0xffffu) | (pre_raw[3] << 16); oa.z = (pre_raw[4] & 0xffffu) | (pre_raw[5] << 16); oa.w = (pre_raw[6] & 0xffffu) | (pre_raw[7] << 16);
          ob.x = (pre_raw[0] >> 16) | (pre_raw[1] & 0xffff0000u); ob.y = (pre_raw[2] >> 16) | (pre_raw[3] & 0xffff0000u); ob.z = (pre_raw[4] >> 16) | (pre_raw[5] & 0xffff0000u); ob.w = (pre_raw[6] >> 16) | (pre_raw[7] & 0xffff0000u);
          *(LAS v4u*)(XT + (2 * cp) * SSD_PITCH + tb * 16) = oa; *(LAS v4u*)(XT + (2 * cp + 1) * SSD_PITCH + tb * 16) = ob; }
#pragma unroll
        for (int k = 0; k < 2; ++k) { const int pc = tid + 512 * k, row = pc >> 3, q = pc & 7; *(LAS v4u*)(Bs + row * SSD4_ZP + q * 16) = pre_z[k]; }
        { const int p = tid >> 3, n0 = (tid & 7) * 16;
          *(LAS v4u*)(Hn + p * SSD_PITCH + n0 * 2) = pre_h[0]; *(LAS v4u*)(Hn + p * SSD_PITCH + n0 * 2 + 16) = pre_h[1]; }
        if (stp && e == 0) FSTAMP(F);
        __syncthreads();
        if (stp && e == 0) FSTAMP(F);
        if (e < 3) SSD4_PREFETCH(e + 1);
        f32x16 yd;
#pragma unroll
        for (int i = 0; i < 16; ++i) yd[i] = 0.f;
#pragma unroll
        for (int s = 0; s < 8; ++s) {
            const ssd_bf16x8 ah = *(const LAS ssd_bf16x8*)(Hn + (32 * ypt + r) * SSD_PITCH + (16 * s + 8 * hh) * 2);
            const ssd_bf16x8 bc = *(const LAS ssd_bf16x8*)(Cs + (32 * yit + r) * SSD_PITCH + (16 * s + 8 * hh) * 2);
            yd = __builtin_amdgcn_mfma_f32_32x32x16_bf16(ah, bc, yd, 0, 0, 0);
        }
        const float dsk = F.inp(15)[4 * g + e];
        const int ti = 32 * yit + r;
        const float ec = __builtin_amdgcn_exp2f(cum[e * 128 + ti]);
#pragma unroll
        for (int i16 = 0; i16 < 16; ++i16) {
            const int pl = 32 * ypt + (i16 & 3) + 8 * (i16 >> 2) + 4 * hh;
            const float xv = bf2f(*(const LAS unsigned short*)(XT + pl * SSD_PITCH + ti * 2));
            yd[i16] = ec * yd[i16] + dsk * xv;
        }
#pragma unroll
        for (int s = 0; s < 8; ++s) {
            const ssd_bf16x8 ax = *(const LAS ssd_bf16x8*)(XT + (32 * ypt + r) * SSD_PITCH + (16 * s + 8 * hh) * 2);
            const ssd_bf16x8 bl = *(const LAS ssd_bf16x8*)(Lm + (32 * yit + r) * SSD_PITCH + (16 * s + 8 * hh) * 2);
            yd = __builtin_amdgcn_mfma_f32_32x32x16_bf16(ax, bl, yd, 0, 0, 0);
        }
#pragma unroll
        for (int g4 = 0; g4 < 4; ++g4) {
            const v2u zw = *(const LAS v2u*)(Bs + ti * SSD4_ZP + (32 * ypt + 8 * g4 + 4 * hh) * 2);
            const float g0 = yd[4 * g4] * siluf_(bflo(zw.x)), g1 = yd[4 * g4 + 1] * siluf_(bfhi(zw.x)), g2 = yd[4 * g4 + 2] * siluf_(bflo(zw.y)), g3 = yd[4 * g4 + 3] * siluf_(bfhi(zw.y));
            yd[4 * g4] = g0; yd[4 * g4 + 1] = g1; yd[4 * g4 + 2] = g2; yd[4 * g4 + 3] = g3;
            ssq_acc += (g0 * g0 + g1 * g1) + (g2 * g2 + g3 * g3);
        }
        { const v4u pa = (v4u){pk2(yd[0], yd[1]), pk2(yd[2], yd[3]), pk2(yd[4], yd[5]), pk2(yd[6], yd[7])}, pb = (v4u){pk2(yd[8], yd[9]), pk2(yd[10], yd[11]), pk2(yd[12], yd[13]), pk2(yd[14], yd[15])};
          if (e == 0) { ya0 = pa; yb0 = pb; } else if (e == 1) { ya1 = pa; yb1 = pb; } else if (e == 2) { ya2 = pa; yb2 = pb; } else { ya3 = pa; yb3 = pb; } }
        __syncthreads();
    }
#undef SSD4_PREFETCH
    const int ti = 32 * yit + r;
    ssq_acc += __shfl_xor(ssq_acc, 32);
    if (hh == 0) red[ypt * 128 + ti] = ssq_acc;
    __syncthreads();
    LAS unsigned char* Ot = F.lds;
    {
        const float rs = __builtin_amdgcn_rsqf((red[ti] + red[128 + ti]) * (1.0f / 256.0f) + EPS);
        const float* nwp = F.inp(16) + g * 256 + 32 * ypt + 4 * hh;
#pragma unroll
        for (int g4 = 0; g4 < 4; ++g4) {
            const unsigned w00 = (g4 == 0) ? ya0.x : (g4 == 1) ? ya0.z : (g4 == 2) ? yb0.x : yb0.z, w01 = (g4 == 0) ? ya0.y : (g4 == 1) ? ya0.w : (g4 == 2) ? yb0.y : yb0.w;
            const unsigned w10 = (g4 == 0) ? ya1.x : (g4 == 1) ? ya1.z : (g4 == 2) ? yb1.x : yb1.z, w11 = (g4 == 0) ? ya1.y : (g4 == 1) ? ya1.w : (g4 == 2) ? yb1.y : yb1.w;
            const unsigned w20 = (g4 == 0) ? ya2.x : (g4 == 1) ? ya2.z : (g4 == 2) ? yb2.x : yb2.z, w21 = (g4 == 0) ? ya2.y : (g4 == 1) ? ya2.w : (g4 == 2) ? yb2.y : yb2.w;
            const unsigned w30 = (g4 == 0) ? ya3.x : (g4 == 1) ? ya3.z : (g4 == 2) ? yb3.x : yb3.z, w31 = (g4 == 0) ? ya3.y : (g4 == 1) ? ya3.w : (g4 == 2) ? yb3.y : yb3.w;
            const f32x4 n0 = *(const f32x4*)(nwp + 8 * g4), n1 = *(const f32x4*)(nwp + 64 + 8 * g4), n2 = *(const f32x4*)(nwp + 128 + 8 * g4), n3 = *(const f32x4*)(nwp + 192 + 8 * g4);
            LAS unsigned char* op = Ot + ti * SSD4_OP + (32 * ypt + 8 * g4 + 4 * hh) * 2;
            *(LAS v2u*)(op)       = (v2u){pk2(bflo(w00) * rs * n0.x, bfhi(w00) * rs * n0.y), pk2(bflo(w01) * rs * n0.z, bfhi(w01) * rs * n0.w)};
            *(LAS v2u*)(op + 128) = (v2u){pk2(bflo(w10) * rs * n1.x, bfhi(w10) * rs * n1.y), pk2(bflo(w11) * rs * n1.z, bfhi(w11) * rs * n1.w)};
            *(LAS v2u*)(op + 256) = (v2u){pk2(bflo(w20) * rs * n2.x, bfhi(w20) * rs * n2.y), pk2(bflo(w21) * rs * n2.z, bfhi(w21) * rs * n2.w)};
            *(LAS v2u*)(op + 384) = (v2u){pk2(bflo(w30) * rs * n3.x, bfhi(w30) * rs * n3.y), pk2(bflo(w31) * rs * n3.z, bfhi(w31) * rs * n3.w)};
        }
    }
    __syncthreads();
#pragma unroll
    for (int k = 0; k < 8; ++k) { const int pc = tid + 512 * k, row = pc >> 5, q = pc & 31;
        *(v4u*)(CAT + (size_t)(rowc + row) * 2048 + g * 256 + q * 8) = *(const LAS v4u*)(Ot + row * SSD4_OP + q * 16); }
    __syncthreads();
}
constexpr size_t WS_WDWT = 235 * MiB;
typedef float cf32x2 __attribute__((ext_vector_type(2)));
template <int T, int NT, bool SAMPLE>
__device__ __forceinline__ void cconv_run(Frame& F, int row0  , bool has_hist  , const float* state  ) {
    const bf16* G = (const bf16*)(F.ws + WS_G); bf16* CV = (bf16*)(F.ws + WS_CV); const float* WT = (const float*)(F.ws + WS_WDWT);
    const int tid = F.tid, lane = F.lane;
    constexpr int ROWS = T + 30;
    const unsigned* gp = (const unsigned*)(G + (size_t)row0 * 1024) + tid;
    cf32x2 xv[ROWS], wv[31];
    {
        unsigned cur[T];
        if (SAMPLE) {
            cf32x2 sv[30];
#pragma unroll
            for (int k = 0; k < 30; ++k) sv[k] = *(const cf32x2*)(state + (size_t)k * 1024 + 2 * tid);
#pragma unroll
            for (int k = 0; k < T; ++k) cur[k] = __builtin_nontemporal_load(&gp[k * 512]);
#pragma unroll
            for (int k = 0; k < 30; ++k) xv[k] = sv[k];
        } else {
            unsigned xr[30];
#pragma unroll
            for (int k = 0; k < 30; ++k) xr[k] = 0u;
            if (has_hist) {
#pragma unroll
                for (int k = 0; k < 30; ++k) xr[k] = __builtin_nontemporal_load(&gp[(k - 30) * 512]);
            }
#pragma unroll
            for (int k = 0; k < T; ++k) cur[k] = __builtin_nontemporal_load(&gp[k * 512]);
#pragma unroll
            for (int k = 0; k < 30; ++k) xv[k] = (cf32x2){bflo(xr[k]), bfhi(xr[k])};
        }
        { const f32x4* wp = (const f32x4*)(WT + (size_t)(2 * tid) * 32);
#pragma unroll
          for (int k4 = 0; k4 < 8; ++k4) { const f32x4 t4 = wp[k4], u4 = wp[8 + k4];
              wv[4 * k4] = (cf32x2){t4.x, u4.x}; wv[4 * k4 + 1] = (cf32x2){t4.y, u4.y}; wv[4 * k4 + 2] = (cf32x2){t4.z, u4.z}; if (k4 < 7) wv[4 * k4 + 3] = (cf32x2){t4.w, u4.w}; } }
#pragma unroll
        for (int k = 0; k < T; ++k) xv[30 + k] = (cf32x2){bflo(cur[k]), bfhi(cur[k])};
    }
    const cf32x2 bias2 = *(const cf32x2*)(F.inp(31) + 2 * tid);
    const cf32x2 lw = *(const cf32x2*)(F.inp(32) + 2 * tid), lb = *(const cf32x2*)(F.inp(33) + 2 * tid);
    LAS float* red = (LAS float*)(F.lds);
#pragma unroll 1
    for (int tile = 0; tile < NT; ++tile) {
        unsigned nx[T];
        if (tile + 1 < NT) {
#pragma unroll
            for (int k = 0; k < T; ++k) nx[k] = __builtin_nontemporal_load(&gp[((tile + 1) * T + k) * 512]);
        }
        float o0[T], o1[T];
#pragma unroll
        for (int t = 0; t < T; ++t) {
            cf32x2 a0 = bias2, a1 = (cf32x2){0.f, 0.f};
#pragma unroll
            for (int k = 0; k < 30; k += 2) { a0 += wv[k] * xv[t + k]; a1 += wv[k + 1] * xv[t + k + 1]; }
            a0 += wv[30] * xv[t + 30];
            a0 += a1;
            o0[t] = a0.x; o1[t] = a0.y;
        }
        LAS float* rb = red + (tile & 1) * 256;
        if constexpr (T == 16) {
            float rs, rq;
            { float sa[16];
#pragma unroll
              for (int t = 0; t < 16; ++t) sa[t] = o0[t] + o1[t];
              rs = row16_reduce_scatter(sa, lane); }
            asm volatile("" ::: "memory");
            { float qa[16];
#pragma unroll
              for (int t = 0; t < 16; ++t) qa[t] = o0[t] * o0[t] + o1[t] * o1[t];
              rq = row16_reduce_scatter(qa, lane); }
            rs += __shfl_xor(rs, 16); rq += __shfl_xor(rq, 16); rs += __shfl_xor(rs, 32); rq += __shfl_xor(rq, 32);
            if (lane < 16) { rb[lane * 16 + F.wave] = rs; rb[lane * 16 + 8 + F.wave] = rq; }
        } else {
#pragma unroll
            for (int t = 0; t < T; ++t) { const float s = wave_sum(o0[t] + o1[t]), q = wave_sum(o0[t] * o0[t] + o1[t] * o1[t]); if (lane == 0) { rb[t * 16 + F.wave] = s; rb[t * 16 + 8 + F.wave] = q; } }
        }
        __syncthreads();
        bf16* cvp = CV + (size_t)(row0 + tile * T) * 1024 + 2 * tid;
        float meanv, rstdv;
        { const int tl = lane & (T - 1);
          const f32x4 s0 = *(const LAS f32x4*)(rb + tl * 16), s1 = *(const LAS f32x4*)(rb + tl * 16 + 4), q0 = *(const LAS f32x4*)(rb + tl * 16 + 8), q1 = *(const LAS f32x4*)(rb + tl * 16 + 12);
          const float s = ((s0.x + s0.y) + (s0.z + s0.w)) + ((s1.x + s1.y) + (s1.z + s1.w)), q = ((q0.x + q0.y) + (q0.z + q0.w)) + ((q1.x + q1.y) + (q1.z + q1.w));
          meanv = s * (1.0f / 1024.0f); const float var = fmaxf(q * (1.0f / 1024.0f) - meanv * meanv, 0.f); rstdv = __builtin_amdgcn_rsqf(var + EPS); }
#pragma unroll
        for (int t = 0; t < T; ++t) {
            const float mean = __builtin_bit_cast(float, __builtin_amdgcn_readlane(__builtin_bit_cast(int, meanv), t)), rstd = __builtin_bit_cast(float, __builtin_amdgcn_readlane(__builtin_bit_cast(int, rstdv), t));
            *(unsigned*)(cvp + (size_t)t * 1024) = pk2(siluf_((o0[t] - mean) * rstd * lw.x + lb.x), siluf_((o1[t] - mean) * rstd * lw.y + lb.y));
            asm volatile("" ::: "memory");
        }
        if (tile + 1 < NT) {
#pragma unroll
            for (int k = 0; k < 30; ++k) xv[k] = xv[k + T];
#pragma unroll
            for (int k = 0; k < T; ++k) xv[30 + k] = (cf32x2){bflo(nx[k]), bfhi(nx[k])};
        }
    }
    __syncthreads();
}
constexpr int CCONV_RUNS = NBP * (SEQ / 64);
__device__ __forceinline__ void cconv_phase(Frame& F) {
    for (int b = (int)blockIdx.x; b < NBS; b += F.G) cconv_run<8, 1, true>(F, MP + 8 * b, false, F.inp(6) + (size_t)b * 30 * 1024);
    for (int u = F.vcu; u < CCONV_RUNS; u += F.G) { const int b = u >> 5, j = u & 31; cconv_run<16, 4, false>(F, b * SEQ + 64 * j, j > 0, nullptr); }
    { const bool split = (int)F.G >= 2 * NBS;
      constexpr int P9_SMALL = NBS * NWAVES;
      __syncthreads();
      if (!split) p0_weights(F, P0_PW1_ITEMS, P0_ALL_ITEMS);
      else if ((int)blockIdx.x < NBS) p0_weights(F, P0_PW1_ITEMS, P0_PW1_ITEMS + P9_SMALL, (int)blockIdx.x * NWAVES + F.wave, NBS * NWAVES);
      else p0_weights(F, P0_PW1_ITEMS + P9_SMALL, P0_ALL_ITEMS, ((int)blockIdx.x - NBS) * NWAVES + F.wave, ((int)F.G - NBS) * NWAVES);
      __syncthreads(); }
    for (int b = (int)F.G - 1 - (int)blockIdx.x; b < NBS; b += F.G) { const float* st = F.inp(6) + (size_t)b * 30 * 1024;
        for (int i = F.tid; i < 22 * 256; i += NWAVES * 64) __builtin_nontemporal_store(__builtin_nontemporal_load(&((const f32x4*)(st + 8 * 1024))[i]), &((f32x4*)(F.out + O_SCC + (size_t)b * 30 * 1024))[i]);
    }
}
#define P2_WEIGHTS() do { __syncthreads(); p0_weights(F, P0_WIN_ITEMS, P0_L0_ITEMS); __syncthreads(); } while (0)
#define PHASE2_BODY { \
    const bool wfirst = ((bx >> 4) & 1) != 0; \
    if (wfirst) P2_WEIGHTS(); \
    if ((bx >> 3) & 1) { for (int u = bx; u < 512; u += F.G) ssd_sample_unit(F, u); TSTAMP(); } \
    { S5Consts K5; int kg = -1; for (int u = bx; u < S5_UNITS; u += F.G) s5_block_unit(F, u, K5, kg); } \
    __syncthreads(); TSTAMP(); \
    if (!wfirst) P2_WEIGHTS(); \
    for (int u = bx; u < 512; u += F.G) ssd_state_unit(F, u); TSTAMP(); \
    if (!((bx >> 3) & 1)) { for (int u = bx; u < 512; u += F.G) ssd_sample_unit(F, u); TSTAMP(); } }
#define PHASE3_BODY { ssd_carry(F); }
#define PHASE4_GLU() do { \
        { const int _pre = (F.vcu & 1); pg8::gemm_tail<pg8::EpiGlu>(lds_s + RING_OFF, g.A + (size_t)MP * g.lda, g.lda, g.Bt, g.K, g.N / 64, E, F.vcu, F.G, 0, _pre); } \
        pg8::gemm_phase<pg8::EpiGlu, pg8::StaticOrder, true, true>(lds_s + RING_OFF, g, S, E); \
        { const int _pre = (F.vcu & 1); pg8::gemm_tail<pg8::EpiGlu>(lds_s + RING_OFF, g.A + (size_t)MP * g.lda, g.lda, g.Bt, g.K, g.N / 64, E, F.vcu, F.G, _pre, 1); } } while (0)
#define PHASE4_BODY { \
    pg8::Gemm g{U, (const bf16*)(F.ws + WS_WGLU), MT, 1024, 1024, 1024}; pg8::StaticOrder S; S.init(MP, 1024, F.G, bx); \
    pg8::EpiGlu E{U, CAT, F.inp(26)}; \
    const bool glu_first = ((F.vcu >> 1) & 1) != 0;                        \
    if (!glu_first) { __syncthreads(); p0_weights(F, P0_L0_ITEMS, P0_PW1_ITEMS); __syncthreads(); }        \
    if (glu_first) PHASE4_GLU(); \
    for (int u = bx; u < 512; u += F.G) ssd_y_unit(F, u); TSTAMP(); \
    if (glu_first) { __syncthreads(); p0_weights(F, P0_L0_ITEMS, P0_PW1_ITEMS); __syncthreads(); } \
    if (!glu_first) PHASE4_GLU(); \
    TSTAMP(); }
#define PHASE9_BODY { cconv_phase(F); }
struct Args { const float* in[38]; float* out; unsigned char* ws; int ph_lo, ph_hi; };
constexpr int N_PHASES = 14;

__global__ void __launch_bounds__(NWAVES * 64, 2) hybrid_fwd(Args args) {
    extern __shared__ __attribute__((aligned(16))) unsigned char lds[];
    Frame F;
    { unsigned vz; asm volatile("v_mov_b32 %0, 0" : "=v"(vz)); F.lds = (LAS unsigned char*)lds + vz; }
    LAS unsigned char* const lds_s = (LAS unsigned char*)lds;
    F.MISC = (volatile LAS unsigned*)(F.lds + MISC_OFF);
    F.tid = threadIdx.x; F.lane = F.tid & 63; F.wave = __builtin_amdgcn_readfirstlane(F.tid >> 6);
    F.G = gridDim.x; { const int bx = blockIdx.x; F.vcu = (F.G % 8 == 0) ? (bx % 8) * (F.G / 8) + bx / 8 : bx; }
    F.ws = args.ws; F.out = args.out; F.ctl = (gu32*)(args.ws + WS_CTL);
    F.in = (LAS cfp*)(F.lds + PTRTAB_OFF);
    for (int u = F.tid; u < (LDS_BYTES - LDSCTL_OFF) / 4; u += NWAVES * 64) ((LAS unsigned*)(F.lds + LDSCTL_OFF))[u] = 0u;
    __syncthreads();
    if (F.tid < 38) F.in[F.tid] = args.in[F.tid];
    __syncthreads();
    XcdBarrier bar = xcd_barrier_post((unsigned*)(F.ctl + CW_BAR), F.MISC + 8);
    const int lo = args.ph_lo, hi = args.ph_hi;
#define IN(k) (lo <= (k) && (k) < hi)
#if defined(MK_TIMING)
    volatile LAS unsigned* TS = (volatile LAS unsigned*)(F.lds + LDSCTL_OFF);
    F.nts = 0;
#define TSTAMP() FSTAMP(F)
#define SEAM(k) do { if (IN(k) && IN((k) + 1)) xcd_barrier(bar); TSTAMP(); } while (0)
    TSTAMP();
#else
#define TSTAMP() do {} while (0)
#define SEAM(k) do { if (IN(k) && IN((k) + 1)) xcd_barrier(bar); } while (0)
#endif

    bf16* CAT = (bf16*)(F.ws + WS_CAT); bf16* XBC = (bf16*)(F.ws + WS_XBC); bf16* U = (bf16*)(F.ws + WS_U); bf16* XB = (bf16*)(F.ws + WS_XB);
    bf16* H = (bf16*)(F.ws + WS_H); bf16* Gb = (bf16*)(F.ws + WS_G); bf16* CV = (bf16*)(F.ws + WS_CV);
    float* SS = (float*)(F.ws + WS_SS); float* X = F.out + O_Y;
    const int bx = (int)blockIdx.x;

    if (IN(0)) { p0_prologue(F); } SEAM(0);
    if (IN(1)) {
        pg8::Gemm g{CAT + 1024, (const bf16*)(F.ws + WS_WIN), MT, 4096, 1024, 2048}; pg8::StaticOrder S; S.init(MP, 4096, F.G, bx);
        pg8::EpiInProj E{CAT, XBC, U, SS, F.out, (bf16*)(F.ws + WS_HALO)};
        if ((F.vcu & 1)) pg8::gemm_tail_wide<4, pg8::EpiInProj>(lds_s + RING_OFF, g.A + (size_t)MP * g.lda, g.lda, g.Bt, g.K, E, F.vcu, F.G);
        pg8::gemm_phase<pg8::EpiInProj, pg8::StaticOrder, true, true>(lds_s + RING_OFF, g, S, E, SS); TSTAMP();
        if (!(F.vcu & 1)) pg8::gemm_tail_wide<4, pg8::EpiInProj>(lds_s + RING_OFF, g.A + (size_t)MP * g.lda, g.lda, g.Bt, g.K, E, F.vcu, F.G);
    } SEAM(1);
    if (IN(2)) { PHASE2_BODY } SEAM(2);
    if (IN(3)) { PHASE3_BODY } SEAM(3);
    if (IN(4)) { PHASE4_BODY } SEAM(4);
    if (IN(5)) {
        pg8::Gemm g{CAT, (const bf16*)(F.ws + WS_WOUT), MT, 1024, 2048, 2048}; pg8::StaticOrder S; S.init(MP, 1024, F.G, bx);
        pg8::EpiRes E{F.inp(0), F.inp(1), nullptr, nullptr, XB, SS, nullptr};
        { const int _n = (g.N / 64) * 16 / F.G, _pre = (_n == 1) ? (F.vcu & 1) : ((_n * (F.vcu & 3)) >> 2); pg8::gemm_tail<pg8::EpiRes>(lds_s + RING_OFF, g.A + (size_t)MP * g.lda, g.lda, g.Bt, g.K, g.N / 64, E, F.vcu, F.G, 0, _pre); }
        pg8::gemm_phase<pg8::EpiRes, pg8::StaticOrder, true, true>(lds_s + RING_OFF, g, S, E); TSTAMP();
        { const int _n = (g.N / 64) * 16 / F.G, _pre = (_n == 1) ? (F.vcu & 1) : ((_n * (F.vcu & 3)) >> 2); pg8::gemm_tail<pg8::EpiRes>(lds_s + RING_OFF, g.A + (size_t)MP * g.lda, g.lda, g.Bt, g.K, g.N / 64, E, F.vcu, F.G, _pre, _n); }
    } SEAM(5);
    if (IN(6)) {
        pg8::Gemm g{XB, (const bf16*)(F.ws + WS_WFF1), MT, FF, 1024, 1024}; pg8::StaticOrder S; S.init(MP, FF, F.G, bx);
        pg8::EpiFF1 E{H, SS};
        if ((F.vcu & 1)) pg8::gemm_tail_wide<4, pg8::EpiFF1>(lds_s + RING_OFF, g.A + (size_t)MP * g.lda, g.lda, g.Bt, g.K, E, F.vcu, F.G);
        pg8::gemm_phase<pg8::EpiFF1, pg8::StaticOrder, true, true>(lds_s + RING_OFF, g, S, E, SS); TSTAMP();
        if (!(F.vcu & 1)) pg8::gemm_tail_wide<4, pg8::EpiFF1>(lds_s + RING_OFF, g.A + (size_t)MP * g.lda, g.lda, g.Bt, g.K, E, F.vcu, F.G);
    } SEAM(6);
    if (IN(7)) {
        pg8::Gemm g{H, (const bf16*)(F.ws + WS_WFF2), MT, 1024, FF, FF}; pg8::StaticOrder S; S.init(MP, 1024, F.G, bx);
        pg8::EpiRes E{nullptr, nullptr, XB, nullptr, XB, SS, nullptr};
        { const int _n = (g.N / 64) * 16 / F.G, _pre = (_n == 1) ? (F.vcu & 1) : ((_n * (F.vcu & 3)) >> 2); pg8::gemm_tail<pg8::EpiRes>(lds_s + RING_OFF, g.A + (size_t)MP * g.lda, g.lda, g.Bt, g.K, g.N / 64, E, F.vcu, F.G, 0, _pre); }
        pg8::gemm_phase<pg8::EpiRes, pg8::StaticOrder, true, true>(lds_s + RING_OFF, g, S, E); TSTAMP();
        { const int _n = (g.N / 64) * 16 / F.G, _pre = (_n == 1) ? (F.vcu & 1) : ((_n * (F.vcu & 3)) >> 2); pg8::gemm_tail<pg8::EpiRes>(lds_s + RING_OFF, g.A + (size_t)MP * g.lda, g.lda, g.Bt, g.K, g.N / 64, E, F.vcu, F.G, _pre, _n); }
    } SEAM(7);
    if (IN(8)) {
        pg8::Gemm g{XB, (const bf16*)(F.ws + WS_WPW1), MT, 2048, 1024, 1024}; pg8::StaticOrder S; S.init(MP, 2048, F.G, bx);
        pg8::EpiPw1 E{Gb, SS, F.inp(29), F.out};
        if ((F.vcu & 1)) pg8::gemm_tail_wide<2, pg8::EpiPw1>(lds_s + RING_OFF, g.A + (size_t)MP * g.lda, g.lda, g.Bt, g.K, E, F.vcu, F.G);
        pg8::gemm_phase<pg8::EpiPw1, pg8::StaticOrder, true, true>(lds_s + RING_OFF, g, S, E, SS); TSTAMP();
        if (!(F.vcu & 1)) pg8::gemm_tail_wide<2, pg8::EpiPw1>(lds_s + RING_OFF, g.A + (size_t)MP * g.lda, g.lda, g.Bt, g.K, E, F.vcu, F.G);
    } SEAM(8);
    if (IN(9)) { PHASE9_BODY } SEAM(9);
    if (IN(10)) {
        pg8::Gemm g{CV, (const bf16*)(F.ws + WS_WPW2), MT, 1024, 1024, 1024}; pg8::StaticOrder S; S.init(MP, 1024, F.G, bx);
        pg8::EpiRes E{nullptr, nullptr, XB, nullptr, XB, SS, F.inp(35)};
        { const int _n = (g.N / 64) * 16 / F.G, _pre = (_n == 1) ? (F.vcu & 1) : ((_n * (F.vcu & 3)) >> 2); pg8::gemm_tail<pg8::EpiRes>(lds_s + RING_OFF, g.A + (size_t)MP * g.lda, g.lda, g.Bt, g.K, g.N / 64, E, F.vcu, F.G, 0, _pre); }
        pg8::gemm_phase<pg8::EpiRes, pg8::StaticOrder, true, true>(lds_s + RING_OFF, g, S, E); TSTAMP();
        { const int _n = (g.N / 64) * 16 / F.G, _pre = (_n == 1) ? (F.vcu & 1) : ((_n * (F.vcu & 3)) >> 2); pg8::gemm_tail<pg8::EpiRes>(lds_s + RING_OFF, g.A + (size_t)MP * g.lda, g.lda, g.Bt, g.K, g.N / 64, E, F.vcu, F.G, _pre, _n); }
    } SEAM(10);
    if (IN(11)) {
        pg8::Gemm g{XB, (const bf16*)(F.ws + WS_WFF1) + (size_t)FF * 1024, MT, FF, 1024, 1024}; pg8::StaticOrder S; S.init(MP, FF, F.G, bx);
        pg8::EpiFF1 E{H, SS};
        if ((F.vcu & 1)) pg8::gemm_tail_wide<4, pg8::EpiFF1>(lds_s + RING_OFF, g.A + (size_t)MP * g.lda, g.lda, g.Bt, g.K, E, F.vcu, F.G);
        pg8::gemm_phase<pg8::EpiFF1, pg8::StaticOrder, true, true>(lds_s + RING_OFF, g, S, E, SS); TSTAMP();
        if (!(F.vcu & 1)) pg8::gemm_tail_wide<4, pg8::EpiFF1>(lds_s + RING_OFF, g.A + (size_t)MP * g.lda, g.lda, g.Bt, g.K, E, F.vcu, F.G);
    } SEAM(11);
    if (IN(12)) {
        pg8::Gemm g{H, (const bf16*)(F.ws + WS_WFF2) + (size_t)1024 * FF, MT, 1024, FF, FF}; pg8::StaticOrder S; S.init(MP, 1024, F.G, bx);
        pg8::EpiRes E{nullptr, nullptr, XB, nullptr, XB, SS, nullptr};
        { const int _n = (g.N / 64) * 16 / F.G, _pre = (_n == 1) ? (F.vcu & 1) : ((_n * (F.vcu & 3)) >> 2); pg8::gemm_tail<pg8::EpiRes>(lds_s + RING_OFF, g.A + (size_t)MP * g.lda, g.lda, g.Bt, g.K, g.N / 64, E, F.vcu, F.G, 0, _pre); }
        pg8::gemm_phase<pg8::EpiRes, pg8::StaticOrder, true, true>(lds_s + RING_OFF, g, S, E); TSTAMP();
        { const int _n = (g.N / 64) * 16 / F.G, _pre = (_n == 1) ? (F.vcu & 1) : ((_n * (F.vcu & 3)) >> 2); pg8::gemm_tail<pg8::EpiRes>(lds_s + RING_OFF, g.A + (size_t)MP * g.lda, g.lda, g.Bt, g.K, g.N / 64, E, F.vcu, F.G, _pre, _n); }
    } SEAM(12);
    if (IN(13)) {
        const int gw = F.vcu * NWAVES + F.wave, NGW = F.G * NWAVES; const float* nf = F.inp(9);
        f32x4 wv[4];
#pragma unroll
        for (int j = 0; j < 2; ++j) { wv[2 * j] = ((const f32x4*)nf)[128 * j + 2 * F.lane]; wv[2 * j + 1] = ((const f32x4*)nf)[128 * j + 2 * F.lane + 1]; }
        for (int m = gw; m < MT; m += NGW) {
            const float rs = row_rstd(SS, m);
            const v4u* xb = (const v4u*)(XB + (size_t)m * DM) + F.lane;
            f32x4* yr = (f32x4*)(X + (size_t)m * DM) + 2 * F.lane;
#pragma unroll
            for (int j = 0; j < 2; ++j) { const v4u w = __builtin_nontemporal_load(&xb[64 * j]);
                __builtin_nontemporal_store((f32x4){bflo(w.x), bfhi(w.x), bflo(w.y), bfhi(w.y)} * rs * wv[2 * j], &yr[128 * j]);
                __builtin_nontemporal_store((f32x4){bflo(w.z), bfhi(w.z), bflo(w.w), bfhi(w.w)} * rs * wv[2 * j + 1], &yr[128 * j + 1]); }
        }
    }
#if defined(MK_TIMING)
    TSTAMP();
    xcd_barrier(bar);
    if (blockIdx.x == 0) {
        __syncthreads();
#if defined(MK_COLDPROBE)
        { volatile unsigned* cwp = (volatile unsigned*)(F.ws + 65536 + 256); volatile unsigned* store = (volatile unsigned*)(F.ws + 65536 + 512);
          const bool cold = (*cwp == 0xAAAAAAAAu);
          __syncthreads();
          if (F.tid < 64) { if (cold) store[F.tid] = TS[F.tid]; else TS[F.tid] = store[F.tid]; }
          __syncthreads();
          if (F.tid == 0) *cwp = 0x12345678u;
          __syncthreads(); }
#endif
        const size_t offs[12] = {O_Y, O_Y + (size_t)MP * 1024, O_PAC, O_PAS, O_PBR, O_PBI, O_PCC, O_SAC, O_SAS, O_SBR, O_SBI, O_SCC};
#pragma unroll
        for (int k = 0; k < 12; ++k) {
            const unsigned t0 = TS[MK_TIMING + k], t1 = (MK_TIMING + k + 1 < F.nts) ? TS[MK_TIMING + k + 1] : t0;
#if defined(MK_DEBUGCNT)
            const unsigned us = __hip_atomic_load((unsigned*)(F.ws + WS_CTL) + 2048 + k, __ATOMIC_RELAXED, __HIP_MEMORY_SCOPE_AGENT);
#else
            const unsigned us = (t1 - t0) / 100u;
#endif
            for (unsigned i = F.tid; i < us; i += NWAVES * 64) ((unsigned*)F.out)[offs[k] + i] = 0xAAAAAAAAu;
        }
    }
#endif
#undef IN
#undef SEAM
}

extern "C" void kernel_launch(void* const* d_in, const int* in_sizes, int n_in, void* d_out, int out_size, void* d_ws, size_t ws_size, hipStream_t stream) {
    static int grid = 0;
    if (grid == 0) {
        if (n_in != 38 || out_size != (int)O_END || ws_size < WS_END) { fprintf(stderr, "kernel_launch: unexpected shapes: n_in %d out %d ws %zu\n", n_in, out_size, ws_size); grid = -1; return; }
        int dev = 0, cus = 0, per_cu = 0;
        if (hipGetDevice(&dev) != hipSuccess || hipDeviceGetAttribute(&cus, hipDeviceAttributeMultiprocessorCount, dev) != hipSuccess) { grid = -1; return; }
        if (hipFuncSetAttribute((const void*)hybrid_fwd, hipFuncAttributeMaxDynamicSharedMemorySize, LDS_BYTES) != hipSuccess) { fprintf(stderr, "kernel_launch: hipFuncSetAttribute failed\n"); grid = -1; return; }
        if (hipOccupancyMaxActiveBlocksPerMultiprocessor(&per_cu, (const void*)hybrid_fwd, NWAVES * 64, LDS_BYTES) != hipSuccess || per_cu < 1)
            fprintf(stderr, "kernel_launch: note: occupancy query reports %d blocks per CU\n", per_cu);
        (void)hipGetLastError();
        grid = cus;
    }
    if (grid < 0) return;
    if (hipMemsetAsync((char*)d_ws + WS_CTL, 0, CTL_ZERO_BYTES, stream) != hipSuccess) { fprintf(stderr, "kernel_launch: memset failed\n"); return; }
    Args a{};
    for (int i = 0; i < 38; ++i) a.in[i] = (const float*)d_in[i];
    a.out = (float*)d_out; a.ws = (unsigned char*)d_ws;
#if MK_N_LAUNCHES == 1
    a.ph_lo = 0; a.ph_hi = N_PHASES;
    hipLaunchKernelGGL(hybrid_fwd, dim3(grid), dim3(NWAVES * 64), LDS_BYTES, stream, a);
#else
    for (int p = 0; p < N_PHASES; ++p) { a.ph_lo = p; a.ph_hi = p + 1; hipLaunchKernelGGL(hybrid_fwd, dim3(grid), dim3(NWAVES * 64), LDS_BYTES, stream, a); }
#endif
    const hipError_t le = hipPeekAtLastError();
    if (le != hipSuccess) fprintf(stderr, "kernel_launch: launch failed: %s\n", hipGetErrorName(le));
}
```

```cpp
#include <hip/hip_runtime.h>
#include <cstdio>
#include <cstdint>
#ifndef MK_N_LAUNCHES
#define MK_N_LAUNCHES 1
#endif
__device__ __forceinline__ float row_rstd(const float* SS, int r);
namespace pg8 {
#define PG8_LAS __attribute__((address_space(3)))
typedef unsigned short bf16_t;
typedef short bf16x8 __attribute__((ext_vector_type(8)));
typedef float f32x4 __attribute__((ext_vector_type(4)));
typedef unsigned u32x4 __attribute__((ext_vector_type(4)));
typedef unsigned u32x2 __attribute__((ext_vector_type(2)));
constexpr int BM = 256, BK = 64, HALF = 128, HTB = HALF * BK * 2  , STAGE_BYTES = 8 * HTB, NXCD = 8, WGM = 8;

__host__ __device__ __forceinline__ int lds_byte(int r, int c) { const int st = (r >> 4) * 2 + (c >> 5), rr = r & 15, cc = c & 31, ob = rr * 64 + cc * 2; return st * 1024 + (ob ^ (((ob >> 9) & 1) << 5)); }
__host__ __device__ __forceinline__ void stage_rc(int b, int& R, int& C) { const int st = b / 1024, sb = b % 1024, swz = sb ^ (((sb >> 9) & 1) << 5); R = (st >> 1) * 16 + swz / 64; C = (st & 1) * 32 + (swz % 64) / 2; }
__host__ __device__ __forceinline__ int perm32(int rho) { const int n = rho >> 4, i = rho & 15; return 8 * (i >> 2) + 4 * n + (i & 3); }

struct Unit { int pm, pn; };
struct Gemm { const bf16_t* A; const bf16_t* Bt; int M, N, K, lda; };

struct StaticOrder {
    int nM, nN, nwg, G, c;
    __host__ __device__ void init(int M, int N, int G_, int c_) { nM = M / BM; nN = N / BM; nwg = nM * nN; G = G_; c = c_; }
    __host__ __device__ bool next(int i, Unit& u) const {
        const long L = (long)i * G + c; if (L >= nwg) return false;
        int wgid = (int)L; { const int q = nwg / NXCD, r = nwg % NXCD, xcd = wgid % NXCD, off = wgid / NXCD; wgid = (xcd < r ? xcd * (q + 1) : r * (q + 1) + (xcd - r) * q) + off; }
        const int nig = WGM * nN, gid = wgid / nig, fm = gid * WGM, gsz = (nM - fm) < WGM ? (nM - fm) : WGM;
        u.pm = fm + ((wgid % nig) % gsz); u.pn = (wgid % nig) / gsz; return true;
    }
};

__device__ __forceinline__ unsigned cvt_pk_bf16(float lo, float hi) { unsigned r; asm volatile("v_cvt_pk_bf16_f32 %0, %1, %2" : "=v"(r) : "v"(lo), "v"(hi)); return r; }

template <class Epi, class Sched, bool ALIGN_EPI = false, bool SP2 = false>
__device__ __forceinline__ void gemm_phase(PG8_LAS unsigned char* lds, const Gemm g, const Sched& S, const Epi& E, const float* SSp = nullptr) {
    const int tid = threadIdx.x, wid = __builtin_amdgcn_readfirstlane(tid >> 6), lane = tid & 63, wr = wid >> 2, wc = wid & 3, fr = lane & 15, fq = lane >> 4;
    const int K = g.K, nt = K / BK, lda = g.lda;
    unsigned voffA[2], voffB[2];
#pragma unroll
    for (int i = 0; i < 2; ++i) { int R, C; stage_rc(tid * 16 + i * 8192, R, C); const int Rb = (R >> 5) * 64 + perm32(R & 31);
        voffA[i] = (unsigned)(R * lda + C) * 2u; voffB[i] = (unsigned)(Rb * K + C) * 2u; }
    static_assert(Epi::PERM, "the column map assumes PERM epilogues");
    const size_t kstep = (size_t)(BK * 2);
    const size_t hA = (size_t)HALF * lda * 2, hB = (size_t)32 * K * 2;
    const size_t tA = 2 * hA, tB = (size_t)BM * K * 2;
    const unsigned ldsw = (unsigned)wid * 1024u;
    const int aoff = lds_byte(wr * 64 + fr, fq * 8), boff = lds_byte(wc * 32 + fr, fq * 8);
#define PG8_SA(b, h) (((b) * 2 + (h)) * HTB)
#define PG8_SB(b, h) ((4 + (b) * 2 + (h)) * HTB)
#define PG8_STAGE(bufoff, gbase, voff) do { _Pragma("unroll") for (int _i = 0; _i < 2; ++_i) \
        __builtin_amdgcn_global_load_lds((const unsigned*)((const char*)(gbase) + (voff)[_i]), (PG8_LAS unsigned*)(lds + (bufoff) + ldsw + _i * 8192), 16, 0, 0); } while (0)
#define PG8_LDA(dst, b, h) do { _Pragma("unroll") for (int m = 0; m < 4; ++m) _Pragma("unroll") for (int k = 0; k < 2; ++k) dst[m][k] = *(const PG8_LAS bf16x8*)(lds + PG8_SA(b, h) + aoff + m * 2048 + k * 1024); } while (0)
#define PG8_LDB(dst, b, h) do { _Pragma("unroll") for (int n = 0; n < 2; ++n) _Pragma("unroll") for (int k = 0; k < 2; ++k) dst[n][k] = *(const PG8_LAS bf16x8*)(lds + PG8_SB(b, h) + boff + n * 2048 + k * 1024); } while (0)
#define PG8_MMA(ai, bj, At, Bt) do { __builtin_amdgcn_s_setprio(1); _Pragma("unroll") for (int m = 0; m < 4; ++m) _Pragma("unroll") for (int n = 0; n < 2; ++n) _Pragma("unroll") for (int k = 0; k < 2; ++k) \
        acc[ai][bj][m][n] = __builtin_amdgcn_mfma_f32_16x16x32_bf16(Bt[n][k], At[m][k], acc[ai][bj][m][n], 0, 0, 0); __builtin_amdgcn_s_setprio(0); } while (0)
#define PG8_WAIT_V(n) asm volatile("s_waitcnt vmcnt(" #n ")" ::: "memory")
#define PG8_WAIT_L(n) asm volatile("s_waitcnt lgkmcnt(" #n ")" ::: "memory")
#define PG8_BAR __builtin_amdgcn_s_barrier()
#define PG8_SCHED __builtin_amdgcn_sched_barrier(0)
    Unit cur, nxt; int ui = 0;
    if (!S.next(0, cur)) return;
    PG8_LAS float* RS = (PG8_LAS float*)(lds + STAGE_BYTES);
    if (SSp) {
#pragma unroll
        for (int j = 0; j < 2; ++j) { const int uj = (tid >> 8) + 2 * j; Unit uu;
            if (S.next(uj, uu)) RS[uj * 256 + (tid & 255)] = row_rstd(SSp, uu.pm * BM + (tid & 255)); }
        asm volatile("s_waitcnt vmcnt(0) lgkmcnt(0)" ::: "memory"); __builtin_amdgcn_s_barrier(); asm volatile("" ::: "memory");
    }
    f32x4 acc[2][2][4][2];
#pragma unroll
    for (int a = 0; a < 2; ++a)
#pragma unroll
        for (int b = 0; b < 2; ++b)
#pragma unroll
            for (int m = 0; m < 4; ++m)
#pragma unroll
                for (int n = 0; n < 2; ++n) acc[a][b][m][n] = (f32x4){0.f, 0.f, 0.f, 0.f};
    bf16x8 At[4][2], B0[2][2], B1[2][2];
    const char* cA = (const char*)g.A + (size_t)cur.pm * tA; const char* cB = (const char*)g.Bt + (size_t)cur.pn * tB;
    if constexpr (SP2) {
        PG8_STAGE(PG8_SB(0, 0), cB, voffB); PG8_STAGE(PG8_SB(0, 1), cB + hB, voffB); PG8_STAGE(PG8_SA(0, 0), cA, voffA); PG8_STAGE(PG8_SA(0, 1), cA + hA, voffA);
        if (wr == 1) PG8_BAR;
        PG8_WAIT_V(2); PG8_BAR;
        PG8_STAGE(PG8_SB(1, 0), cB + kstep, voffB); PG8_STAGE(PG8_SA(1, 0), cA + kstep, voffA); PG8_STAGE(PG8_SB(1, 1), cB + hB + kstep, voffB);
        PG8_WAIT_V(6); PG8_BAR;
    } else {
        PG8_STAGE(PG8_SB(0, 0), cB, voffB); PG8_STAGE(PG8_SA(0, 0), cA, voffA); PG8_STAGE(PG8_SB(0, 1), cB + hB, voffB); PG8_STAGE(PG8_SA(0, 1), cA + hA, voffA);
        if (wr == 1) PG8_BAR;
        PG8_WAIT_V(4); PG8_BAR;
        PG8_STAGE(PG8_SB(1, 0), cB + kstep, voffB); PG8_STAGE(PG8_SA(1, 0), cA + kstep, voffA); PG8_STAGE(PG8_SB(1, 1), cB + hB + kstep, voffB);
        PG8_WAIT_V(6); PG8_BAR;
    }
    for (;;) {
        const bool has_next = S.next(ui + 1, nxt);
        const char* nA = has_next ? (const char*)g.A + (size_t)nxt.pm * tA : cA; const char* nB = has_next ? (const char*)g.Bt + (size_t)nxt.pn * tB : cB;
        for (int t = 0; t < nt; t += 2) {
            const bool last = (t == nt - 2);
            const char* a1 = cA + (size_t)(t + 1) * kstep;
            const char* a2 = last ? nA : cA + (size_t)(t + 2) * kstep; const char* b2 = last ? nB : cB + (size_t)(t + 2) * kstep;
            const char* a3 = a2 + kstep; const char* b3 = b2 + kstep;
            if constexpr (SP2) {
            PG8_LDB(B0, 0, 0); PG8_LDB(B1, 0, 1); PG8_SCHED; PG8_LDA(At, 0, 0); PG8_STAGE(PG8_SA(1, 1), a1 + hA, voffA);
            PG8_WAIT_V(8); PG8_WAIT_L(0); PG8_BAR; PG8_MMA(0, 0, At, B0); PG8_MMA(0, 1, At, B1); PG8_BAR; PG8_SCHED;
            PG8_LDA(At, 0, 1); PG8_STAGE(PG8_SB(0, 0), b2, voffB); PG8_STAGE(PG8_SB(0, 1), b2 + hB, voffB); PG8_STAGE(PG8_SA(0, 0), a2, voffA);
            PG8_WAIT_V(8); PG8_WAIT_L(0); PG8_BAR; PG8_MMA(1, 0, At, B0); PG8_MMA(1, 1, At, B1); PG8_BAR; PG8_SCHED;
            PG8_LDB(B0, 1, 0); PG8_LDB(B1, 1, 1); PG8_SCHED; PG8_LDA(At, 1, 0); PG8_STAGE(PG8_SA(0, 1), a2 + hA, voffA);
            PG8_WAIT_V(8); PG8_WAIT_L(0); PG8_BAR; PG8_MMA(0, 0, At, B0); PG8_MMA(0, 1, At, B1); PG8_BAR; PG8_SCHED;
            PG8_LDA(At, 1, 1); PG8_STAGE(PG8_SB(1, 0), b3, voffB); PG8_STAGE(PG8_SB(1, 1), b3 + hB, voffB); PG8_STAGE(PG8_SA(1, 0), a3, voffA);
            PG8_WAIT_V(8); PG8_WAIT_L(0); PG8_BAR; PG8_MMA(1, 0, At, B0); PG8_MMA(1, 1, At, B1); PG8_BAR; PG8_SCHED;
            } else {
            PG8_LDB(B0, 0, 0); PG8_SCHED; PG8_LDA(At, 0, 0); PG8_STAGE(PG8_SA(1, 1), a1 + hA, voffA);
            PG8_WAIT_L(8); PG8_BAR; PG8_WAIT_L(0); PG8_MMA(0, 0, At, B0); PG8_BAR; PG8_SCHED;
            PG8_LDB(B1, 0, 1); PG8_STAGE(PG8_SB(0, 0), b2, voffB);
            PG8_BAR; PG8_WAIT_L(0); PG8_MMA(0, 1, At, B1); PG8_BAR;
            PG8_LDA(At, 0, 1); PG8_STAGE(PG8_SA(0, 0), a2, voffA);
            PG8_BAR; PG8_WAIT_L(0); PG8_MMA(1, 0, At, B0); PG8_BAR; PG8_SCHED;
            PG8_STAGE(PG8_SB(0, 1), b2 + hB, voffB);
            PG8_WAIT_V(6); PG8_BAR; PG8_MMA(1, 1, At, B1); PG8_BAR;
            PG8_LDB(B0, 1, 0); PG8_SCHED; PG8_LDA(At, 1, 0); PG8_STAGE(PG8_SA(0, 1), a2 + hA, voffA);
            PG8_WAIT_L(8); PG8_BAR; PG8_WAIT_L(0); PG8_MMA(0, 0, At, B0); PG8_BAR; PG8_SCHED;
            PG8_LDB(B1, 1, 1); PG8_STAGE(PG8_SB(1, 0), b3, voffB);
            PG8_BAR; PG8_WAIT_L(0); PG8_MMA(0, 1, At, B1); PG8_BAR;
            PG8_LDA(At, 1, 1); PG8_STAGE(PG8_SA(1, 0), a3, voffA);
            PG8_BAR; PG8_WAIT_L(0); PG8_MMA(1, 0, At, B0); PG8_BAR; PG8_SCHED;
            PG8_STAGE(PG8_SB(1, 1), b3 + hB, voffB);
            PG8_WAIT_V(6); PG8_BAR; PG8_MMA(1, 1, At, B1); PG8_BAR;
            }
        }
        if constexpr (ALIGN_EPI) { if (wr == 0) PG8_BAR; }
        E(acc, cur, wr, wc, fr, fq, RS + (ui & 3) * 256);
        if (!has_next) break;
#pragma unroll
        for (int a = 0; a < 2; ++a)
#pragma unroll
            for (int b = 0; b < 2; ++b)
#pragma unroll
                for (int m = 0; m < 4; ++m)
#pragma unroll
                    for (int n = 0; n < 2; ++n) acc[a][b][m][n] = (f32x4){0.f, 0.f, 0.f, 0.f};
        cur = nxt; cA = nA; cB = nB; ++ui;
        if constexpr (ALIGN_EPI) { if (wr == 1) PG8_BAR; }
    }
    PG8_WAIT_V(0);
    if constexpr (!ALIGN_EPI) { if (wr == 0) PG8_BAR; }
    PG8_BAR;
#undef PG8_SA
#undef PG8_SB
#undef PG8_STAGE
#undef PG8_LDA
#undef PG8_LDB
#undef PG8_MMA
#undef PG8_WAIT_V
#undef PG8_WAIT_L
#undef PG8_BAR
#undef PG8_SCHED
}
}
constexpr int NWAVES = 8;
constexpr int DM = 1024, NBP = 8, SEQ = 2048, MP = NBP * SEQ, NBS = 128, DSEQ = 8, MS = NBS * DSEQ, MT = MP + MS;
constexpr int AH = 16, AP = 64, AG = 4, AN = 128, ACD = 2048, INC = 4112, FF = 4096, CWID = 31;
constexpr float EPS = 1e-6f;
constexpr size_t O_Y = 0, O_PAC = 17825792, O_PAS = 17874944, O_PBR = 18923520, O_PBI = 18956288, O_PCC = 18989056,
                 O_SAC = 19234816, O_SAS = 20021248, O_SBR = 36798464, O_SBI = 37322752, O_SCC = 37847040, O_END = 41779200;
constexpr size_t MiB = 1u << 20;
constexpr size_t WS_CTL = 0, CTL_ZERO_BYTES = 64 * 1024;
constexpr size_t WS_SS = 1 * MiB;
constexpr size_t WS_DT = 3 * MiB;
constexpr size_t WS_DA = 5 * MiB;
constexpr size_t WS_WDT = 7 * MiB;
constexpr size_t WS_W = 8 * MiB;
constexpr size_t WS_WIN = WS_W, WS_WGLU = WS_WIN + 8 * MiB, WS_WOUT = WS_WGLU + 2 * MiB, WS_WFF1 = WS_WOUT + 4 * MiB, WS_WFF2 = WS_WFF1 + 16 * MiB,
                 WS_WPW1 = WS_WFF2 + 16 * MiB, WS_WPW2 = WS_WPW1 + 4 * MiB, WS_WEND = WS_WPW2 + 2 * MiB;
constexpr size_t WS_CAT = 60 * MiB;
constexpr size_t WS_XBC = 128 * MiB;
constexpr size_t WS_U = 196 * MiB;
constexpr size_t WS_XB = WS_U;
constexpr size_t WS_H = 60 * MiB;
constexpr size_t WS_G = 60 * MiB;
constexpr size_t WS_CV = 94 * MiB;
constexpr size_t WS_END = 256 * MiB;
static_assert(WS_WEND == 60 * MiB, "weights end");
constexpr int CW_BAR = 4096;

constexpr int RING_OFF = 0, RING_BYTES = 131072;
constexpr int LDS_BYTES = 155648;
constexpr int LDSCTL_OFF = LDS_BYTES - 1024, MISC_OFF = LDSCTL_OFF + 320, PTRTAB_OFF = LDSCTL_OFF + 512;

#define GAS __attribute__((address_space(1)))
#define LAS __attribute__((address_space(3)))
typedef unsigned short bf16;
typedef unsigned v4u __attribute__((ext_vector_type(4)));
typedef unsigned v2u __attribute__((ext_vector_type(2)));
typedef float f32x4 __attribute__((ext_vector_type(4)));
typedef float f32x16 __attribute__((ext_vector_type(16)));
typedef short bf16x8 __attribute__((ext_vector_type(8)));
typedef GAS unsigned gu32;
#define RLX_AGENT __ATOMIC_RELAXED, __HIP_MEMORY_SCOPE_AGENT
#define LDS_WAIT() asm volatile("s_waitcnt lgkmcnt(0)" ::: "memory")
#define VM_WAIT() asm volatile("s_waitcnt vmcnt(0)" ::: "memory")
__device__ __forceinline__ unsigned f2bf(float f) { unsigned r; asm("v_cvt_pk_bf16_f32 %0, %1, %1" : "=v"(r) : "v"(f)); return r & 0xffffu; }
__device__ __forceinline__ unsigned pk2(float lo, float hi) { unsigned r; asm("v_cvt_pk_bf16_f32 %0, %1, %2" : "=v"(r) : "v"(lo), "v"(hi)); return r; }
__device__ __forceinline__ unsigned f2bf_int(float f) { const unsigned u = __builtin_bit_cast(unsigned, f); return (u + 0x7fffu + ((u >> 16) & 1u)) >> 16; }
__device__ __forceinline__ float bf2f(unsigned short b) { return __builtin_bit_cast(float, ((unsigned)b) << 16); }
__device__ __forceinline__ float bflo(unsigned w) { return __builtin_bit_cast(float, w << 16); }
__device__ __forceinline__ float bfhi(unsigned w) { return __builtin_bit_cast(float, w & 0xffff0000u); }
__device__ __forceinline__ float frcp_(float x) { return __builtin_amdgcn_rcpf(x); }
__device__ __forceinline__ float sigmoidf_(float x) { return frcp_(1.0f + __builtin_amdgcn_exp2f(-1.4426950408889634f * x)); }
__device__ __forceinline__ float siluf_(float x) { return x * frcp_(1.0f + __builtin_amdgcn_exp2f(-1.4426950408889634f * x)); }

#define XB_TMO      128
#define XB_XCNT(j)  (256  + 64 * (j))
#define XB_XSUB(j)  (1280 + 64 * (j))
#define XB_XGEN(j)  (2304 + 64 * (j))
#define XB_TOP      3328
#define XB_TOPGEN   3392
#define XCD_BAR_WORDS 3456
#define XB_SPIN_CAP (1u << 20)
__device__ __forceinline__ unsigned xb_ld(unsigned* p)              { return __hip_atomic_load(p, __ATOMIC_RELAXED, __HIP_MEMORY_SCOPE_AGENT); }
__device__ __forceinline__ unsigned xb_add(unsigned* p, unsigned v) { return __hip_atomic_fetch_add(p, v, __ATOMIC_RELAXED, __HIP_MEMORY_SCOPE_AGENT); }
__device__ __forceinline__ unsigned xb_xcc_id() { return (unsigned)__builtin_amdgcn_s_getreg((3 << 11) | 20) & 0xFu; }
#define XB_SPIN(cond, bar) do { unsigned _sp = 0; while (cond) { __builtin_amdgcn_s_sleep(1); \
    if ((++_sp & 255u) == 0u) { if (xb_ld(&(bar)[XB_TMO])) break; if (_sp > XB_SPIN_CAP) { atomicAdd(&(bar)[XB_TMO], 1u); break; } } } } while (0)
struct XcdBarrier { unsigned* bar; unsigned x; volatile LAS unsigned* st; };
__device__ __forceinline__ XcdBarrier xcd_barrier_post(unsigned* bar, volatile LAS unsigned* st) {
    XcdBarrier b; b.bar = bar; b.x = xb_xcc_id(); b.st = st;
    if (threadIdx.x == 0) (void)xb_add(&bar[XB_XCNT(b.x)], 1u);
    return b;
}
__device__ __forceinline__ void xcd_barrier_complete(unsigned* bar, unsigned x, unsigned& nloc, unsigned& nx) {
    const unsigned G = gridDim.x * gridDim.y * gridDim.z;
    unsigned sum, cnt, mine, sp = 0u;
    for (;;) {
        sum = 0u; cnt = 0u; mine = 0u;
#pragma unroll
        for (unsigned j = 0; j < 16; ++j) { const unsigned c = xb_ld(&bar[XB_XCNT(j)]); sum += c; cnt += (c > 0u) ? 1u : 0u; mine = (j == x) ? c : mine; }
        if (sum == G) break;
        __builtin_amdgcn_s_sleep(1);
        if ((++sp & 255u) == 0u) { if (xb_ld(&bar[XB_TMO])) break; if (sp > XB_SPIN_CAP) { atomicAdd(&bar[XB_TMO], 1u); break; } }
    }
    nloc = mine > 0u ? mine : 1u; nx = cnt > 0u ? cnt : 1u;
}
__device__ __forceinline__ void xcd_barrier(const XcdBarrier& b) {
    asm volatile("s_waitcnt vmcnt(0)" ::: "memory");
    __syncthreads();
    if (threadIdx.x == 0) {
        unsigned* bar = b.bar;
        __builtin_amdgcn_s_waitcnt(0);
        unsigned nloc = b.st[0], nx = b.st[1];
        if (nloc == 0u) { xcd_barrier_complete(bar, b.x, nloc, nx); b.st[0] = nloc; b.st[1] = nx; }
        const unsigned old = xb_add(&bar[XB_XSUB(b.x)], 1u);
        const unsigned gen = old / nloc;
        if (old + 1u == (gen + 1u) * nloc) {
            __builtin_amdgcn_fence(__ATOMIC_RELEASE, "agent");
            asm volatile("s_waitcnt vmcnt(0)" ::: "memory");
            const unsigned og = xb_add(&bar[XB_TOP], 1u);
            const unsigned tg = og / nx;
            if (og + 1u == (tg + 1u) * nx) xb_add(&bar[XB_TOPGEN], 1u);
            else XB_SPIN(xb_ld(&bar[XB_TOPGEN]) == tg, bar);
            __builtin_amdgcn_fence(__ATOMIC_ACQUIRE, "agent");
            xb_add(&bar[XB_XGEN(b.x)], 1u);
            asm volatile("s_waitcnt vmcnt(0)" ::: "memory");
        } else {
            XB_SPIN(xb_ld(&bar[XB_XGEN(b.x)]) == gen, bar);
            __builtin_amdgcn_fence(__ATOMIC_ACQUIRE, "agent");
            asm volatile("s_waitcnt vmcnt(0)" ::: "memory");
        }
    }
    __syncthreads();
}

typedef const float* cfp;
struct Frame {
    LAS unsigned char* lds;
    volatile LAS unsigned* MISC;
    gu32* ctl;
    int tid, lane, wave;
    int vcu, G;
    LAS cfp* in;
    float* out;
    unsigned char* ws;
    int nts;
    __device__ __forceinline__ const float* inp(int k) const { return (const float*)(const GAS float*)in[k]; }
};
#if defined(MK_DEBUGCNT)
#define DBG_COUNT(F, k) do { __hip_atomic_fetch_add((unsigned*)((F).ws + WS_CTL) + 2048 + (k), 1u, __ATOMIC_RELAXED, __HIP_MEMORY_SCOPE_AGENT); } while (0)
#else
#define DBG_COUNT(F, k) do {} while (0)
#endif
#if defined(MK_TIMING)
#define FSTAMP(F) do { if (blockIdx.x == 0 && (F).tid == 0 && (F).nts < 62) ((volatile LAS unsigned*)((F).lds + LDSCTL_OFF))[(F).nts] = (unsigned)__builtin_amdgcn_s_memrealtime(); ++(F).nts; } while (0)
#else
#define FSTAMP(F) do {} while (0)
#endif
template <int CTRL, int ROWMASK> __device__ __forceinline__ float dpp_get(float v) {
    return __builtin_bit_cast(float, __builtin_amdgcn_update_dpp(0, __builtin_bit_cast(int, v), CTRL, ROWMASK, 0xF, false));
}
__device__ __forceinline__ float dpp_sum8(float v) { v += dpp_get<0xB1, 0xF>(v); v += dpp_get<0x4E, 0xF>(v); v += dpp_get<0x141, 0xF>(v); return v; }
__device__ __forceinline__ float dpp_sum16(float v) { v = dpp_sum8(v); v += dpp_get<0x140, 0xF>(v); return v; }
__device__ __forceinline__ float dpp_sum32_hi(float v) { v = dpp_sum16(v); v += dpp_get<0x142, 0xA>(v); return v; }
__device__ __forceinline__ float wave_sum(float v) {
    v = dpp_sum32_hi(v); v += dpp_get<0x143, 0xC>(v);
    return __builtin_bit_cast(float, __builtin_amdgcn_readlane(__builtin_bit_cast(int, v), 63));
}
__device__ __forceinline__ float row16_reduce_scatter(const float (&d)[16], int lane) {
    const bool s3 = (lane & 8) != 0, s2 = (lane & 4) != 0, s1 = (lane & 2) != 0, s0 = (lane & 1) != 0;
    float a[8], b[4], c[2];
#pragma unroll
    for (int h = 0; h < 8; ++h) { const float keep = s3 ? d[h + 8] : d[h], give = s3 ? d[h] : d[h + 8]; a[h] = keep + dpp_get<0x140, 0xF>(give); }
#pragma unroll
    for (int h = 0; h < 4; ++h) { const float keep = s2 ? a[h + 4] : a[h], give = s2 ? a[h] : a[h + 4]; b[h] = keep + dpp_get<0x141, 0xF>(give); }
#pragma unroll
    for (int h = 0; h < 2; ++h) { const float keep = s1 ? b[h + 2] : b[h], give = s1 ? b[h] : b[h + 2]; c[h] = keep + dpp_get<0x4E, 0xF>(give); }
    const float keep = s0 ? c[1] : c[0], give = s0 ? c[0] : c[1];
    return keep + dpp_get<0xB1, 0xF>(give);
}
__device__ __forceinline__ float row_rstd(const float* SS, int r) {
    const f32x4* p = (const f32x4*)(SS + (size_t)r * 16);
    const f32x4 a = p[0], b = p[1], c = p[2], d = p[3];
    const float s = ((a.x + a.y) + (a.z + a.w)) + ((b.x + b.y) + (b.z + b.w)) + ((c.x + c.y) + (c.z + c.w)) + ((d.x + d.y) + (d.z + d.w));
    return __builtin_amdgcn_rsqf(s * (1.0f / DM) + EPS);
}
namespace pg8 {
struct EpiInProj {
    static constexpr bool PERM = true;
    bf16_t* CAT; bf16_t* XBC; bf16_t* U; const float* SS; float* out; bf16_t* HALO;
    __device__ __forceinline__ void operator()(const f32x4 (&acc)[2][2][4][2], const Unit& u, int wr, int wc, int fr, int fq, const PG8_LAS float* rs) const {
        const int row0 = u.pm * BM + wr * 64 + fr; const int colt = u.pn * BM;
        bf16_t* base; int ldc, c0; const bool isx = (colt >= 1024 && colt < 3072);
        if (colt < 1024) { base = CAT; ldc = 2048; c0 = colt; } else if (colt < 3072) { base = XBC; ldc = 2048; c0 = colt - 1024; } else { base = U; ldc = 1024; c0 = colt - 3072; }
        const int col0 = c0 + wc * 64 + 8 * fq;
#pragma unroll
        for (int ai = 0; ai < 2; ++ai)
#pragma unroll
            for (int m = 0; m < 4; ++m) {
                const int r = row0 + ai * HALF + m * 16; const float rsv = rs[wr * 64 + ai * HALF + m * 16 + fr];
                bf16_t* rowp = base + (size_t)r * ldc + col0;
                float* st = nullptr; bf16_t* hl = nullptr;
                if (isx) { if (r < MP) { const int t = r & 2047; if (t >= 2045) st = out + O_PAC + ((size_t)(r >> 11) * 3 + (t - 2045)) * 2048;
                                         if ((t & 63) >= 61) hl = HALO + ((size_t)((r >> 11) * 32 + (t >> 6)) * 3 + ((t & 63) - 61)) * 2048; }
                           else { const int rr = r - MP, t = rr & 7; if (t >= 5) st = out + O_SAC + ((size_t)(rr >> 3) * 3 + (t - 5)) * 2048; } }
#pragma unroll
                for (int bj = 0; bj < 2; ++bj) { const f32x4 v0 = acc[ai][bj][m][0] * rsv, v1 = acc[ai][bj][m][1] * rsv;
                    u32x4 w; w.x = cvt_pk_bf16(v0[0], v0[1]); w.y = cvt_pk_bf16(v0[2], v0[3]); w.z = cvt_pk_bf16(v1[0], v1[1]); w.w = cvt_pk_bf16(v1[2], v1[3]);
                    if (colt < 1024) __builtin_nontemporal_store(w, (u32x4*)(rowp + bj * 32));
                    else *(u32x4*)(rowp + bj * 32) = w;
                    if (hl) *(u32x4*)(hl + col0 + bj * 32) = w;
                    if (st) { __builtin_nontemporal_store(v0, (f32x4*)(st + col0 + bj * 32)); __builtin_nontemporal_store(v1, (f32x4*)(st + col0 + bj * 32 + 4)); } } }
    }
    __device__ __forceinline__ void tail_cols(int cb, int& w0, int& w1) const { w0 = 64 * cb; w1 = w0 + 32; }
    __device__ __forceinline__ void tail(const f32x4& a0, const f32x4& a1, int row, int cb, int coff, int wm, int wn, int fr, int fq, PG8_LAS unsigned char* red) const {
        const float rs = row_rstd(SS, row); const int rr = row - MP, t = rr & 7;
#pragma unroll
        for (int sg = 0; sg < 2; ++sg) { const int col = 64 * cb + 32 * sg + coff; const f32x4 v = (sg ? a1 : a0) * rs;
            u32x2 w; w.x = cvt_pk_bf16(v[0], v[1]); w.y = cvt_pk_bf16(v[2], v[3]);
            if (col < 1024) *(u32x2*)(CAT + (size_t)row * 2048 + col) = w;
            else if (col < 3072) { *(u32x2*)(XBC + (size_t)row * 2048 + (col - 1024)) = w; if (t >= 5) *(f32x4*)(out + O_SAC + ((size_t)(rr >> 3) * 3 + (t - 5)) * 2048 + (col - 1024)) = v; }
            else *(u32x2*)(U + (size_t)row * 1024 + (col - 3072)) = w; }
    }
};
struct EpiGlu {
    static constexpr bool PERM = true;
    const bf16_t* YS; bf16_t* CAT; const float* bias;
    __device__ __forceinline__ void operator()(const f32x4 (&acc)[2][2][4][2], const Unit& u, int wr, int wc, int fr, int fq, const PG8_LAS float* rs) const {
        const int row0 = u.pm * BM + wr * 64 + fr; const int col0 = u.pn * BM + wc * 64 + 8 * fq;
        f32x4 bv[2][2];
#pragma unroll
        for (int bj = 0; bj < 2; ++bj)
#pragma unroll
            for (int n = 0; n < 2; ++n) bv[bj][n] = *(const f32x4*)(bias + col0 + bj * 32 + 4 * n);
#pragma unroll
        for (int ai = 0; ai < 2; ++ai)
#pragma unroll
            for (int m = 0; m < 4; ++m) { const int r = row0 + ai * HALF + m * 16;
#pragma unroll
                for (int bj = 0; bj < 2; ++bj) { const u32x4 yw = *(const u32x4*)(YS + (size_t)r * 1024 + col0 + bj * 32);
                    const f32x4 g0 = acc[ai][bj][m][0] + bv[bj][0], g1 = acc[ai][bj][m][1] + bv[bj][1];
                    float o[8]; o[0] = bflo(yw.x) * sigmoidf_(g0[0]); o[1] = bfhi(yw.x) * sigmoidf_(g0[1]); o[2] = bflo(yw.y) * sigmoidf_(g0[2]); o[3] = bfhi(yw.y) * sigmoidf_(g0[3]);
                    o[4] = bflo(yw.z) * sigmoidf_(g1[0]); o[5] = bfhi(yw.z) * sigmoidf_(g1[1]); o[6] = bflo(yw.w) * sigmoidf_(g1[2]); o[7] = bfhi(yw.w) * sigmoidf_(g1[3]);
                    u32x4 w; w.x = cvt_pk_bf16(o[0], o[1]); w.y = cvt_pk_bf16(o[2], o[3]); w.z = cvt_pk_bf16(o[4], o[5]); w.w = cvt_pk_bf16(o[6], o[7]);
                    *(u32x4*)(CAT + (size_t)r * 2048 + 1024 + col0 + bj * 32) = w; }
                asm volatile("" ::: "memory"); }
    }
    __device__ __forceinline__ void tail_cols(int cb, int& w0, int& w1) const { w0 = 64 * cb; w1 = w0 + 32; }
    __device__ __forceinline__ void tail(const f32x4& a0, const f32x4& a1, int row, int cb, int coff, int wm, int wn, int fr, int fq, PG8_LAS unsigned char* red) const {
#pragma unroll
        for (int sg = 0; sg < 2; ++sg) { const int col = 64 * cb + 32 * sg + coff; const f32x4 g = (sg ? a1 : a0) + *(const f32x4*)(bias + col);
            const u32x2 yw = *(const u32x2*)(YS + (size_t)row * 1024 + col);
            u32x2 w; w.x = cvt_pk_bf16(bflo(yw.x) * sigmoidf_(g[0]), bfhi(yw.x) * sigmoidf_(g[1])); w.y = cvt_pk_bf16(bflo(yw.y) * sigmoidf_(g[2]), bfhi(yw.y) * sigmoidf_(g[3]));
            *(u32x2*)(CAT + (size_t)row * 2048 + 1024 + col) = w; }
    }
};
struct EpiRes {
    static constexpr bool PERM = true;
    const float* resP; const float* resS; const bf16_t* RB; float* X; bf16_t* XB; float* SS; const float* bias;
    __device__ __forceinline__ void operator()(const f32x4 (&acc)[2][2][4][2], const Unit& u, int wr, int wc, int fr, int fq, const PG8_LAS float* rs) const {
        const int row0 = u.pm * BM + wr * 64 + fr; const int col0 = u.pn * BM + wc * 64 + 8 * fq;
        f32x4 bv[2][2];
#pragma unroll
        for (int bj = 0; bj < 2; ++bj)
#pragma unroll
            for (int n = 0; n < 2; ++n) bv[bj][n] = bias ? *(const f32x4*)(bias + col0 + bj * 32 + 4 * n) : (f32x4){0.f, 0.f, 0.f, 0.f};
#pragma unroll
        for (int ai = 0; ai < 2; ++ai)
#pragma unroll
            for (int m = 0; m < 4; ++m) { const int r = row0 + ai * HALF + m * 16;
                float ssq = 0.f;
#pragma unroll
                for (int bj = 0; bj < 2; ++bj) { const int c = col0 + bj * 32;
                    f32x4 x0, x1;
                    if (RB) { const u32x4 rw = *(const u32x4*)(RB + (size_t)r * 1024 + c); x0 = (f32x4){bflo(rw.x), bfhi(rw.x), bflo(rw.y), bfhi(rw.y)}; x1 = (f32x4){bflo(rw.z), bfhi(rw.z), bflo(rw.w), bfhi(rw.w)}; }
                    else { const float* rp = resP + (size_t)r * 1024; x0 = __builtin_nontemporal_load((const f32x4*)(rp + c)); x1 = __builtin_nontemporal_load((const f32x4*)(rp + c + 4)); }
                    x0 = x0 + acc[ai][bj][m][0] + bv[bj][0]; x1 = x1 + acc[ai][bj][m][1] + bv[bj][1];
                    if (X) { *(f32x4*)(X + (size_t)r * 1024 + c) = x0; *(f32x4*)(X + (size_t)r * 1024 + c + 4) = x1; }
                    if (XB) { u32x4 w; w.x = cvt_pk_bf16(x0[0], x0[1]); w.y = cvt_pk_bf16(x0[2], x0[3]); w.z = cvt_pk_bf16(x1[0], x1[1]); w.w = cvt_pk_bf16(x1[2], x1[3]); *(u32x4*)(XB + (size_t)r * 1024 + c) = w; }
                    ssq += (x0[0] * x0[0] + x0[1] * x0[1]) + (x0[2] * x0[2] + x0[3] * x0[3]) + (x1[0] * x1[0] + x1[1] * x1[1]) + (x1[2] * x1[2] + x1[3] * x1[3]); }
                ssq += __shfl_xor(ssq, 16); ssq += __shfl_xor(ssq, 32);
                if (fq == 0) SS[(size_t)r * 16 + u.pn * 4 + wc] = ssq;
                asm volatile("" ::: "memory"); }
    }
    __device__ __forceinline__ void tail_cols(int cb, int& w0, int& w1) const { w0 = 64 * cb; w1 = w0 + 32; }
    __device__ __forceinline__ void tail(const f32x4& a0, const f32x4& a1, int row, int cb, int coff, int wm, int wn, int fr, int fq, PG8_LAS unsigned char* red) const {
        float ssq = 0.f;
#pragma unroll
        for (int sg = 0; sg < 2; ++sg) { const int col = 64 * cb + 32 * sg + coff;
            f32x4 x;
            if (RB) { const u32x2 rw = *(const u32x2*)(RB + (size_t)row * 1024 + col); x = (f32x4){bflo(rw.x), bfhi(rw.x), bflo(rw.y), bfhi(rw.y)}; }
            else x = __builtin_nontemporal_load((const f32x4*)(resS + (size_t)(row - MP) * 1024 + col));
            x = x + (sg ? a1 : a0); if (bias) x = x + *(const f32x4*)(bias + col);
            if (X) *(f32x4*)(X + (size_t)row * 1024 + col) = x;
            if (XB) { u32x2 w; w.x = cvt_pk_bf16(x[0], x[1]); w.y = cvt_pk_bf16(x[2], x[3]); *(u32x2*)(XB + (size_t)row * 1024 + col) = w; }
            ssq += (x[0] * x[0] + x[1] * x[1]) + (x[2] * x[2] + x[3] * x[3]); }
        ssq += __shfl_xor(ssq, 16); ssq += __shfl_xor(ssq, 32);
        PG8_LAS float* rd = (PG8_LAS float*)red;
        if (fq == 0) rd[wn * 64 + 16 * wm + fr] = ssq;
        asm volatile("s_waitcnt lgkmcnt(0)" ::: "memory"); __builtin_amdgcn_s_barrier(); asm volatile("" ::: "memory");
        if (wn == 0 && fq == 0) SS[(size_t)row * 16 + cb] = rd[16 * wm + fr] + rd[64 + 16 * wm + fr];
    }
};
struct EpiFF1 {
    static constexpr bool PERM = true;
    bf16_t* H; const float* SS;
    __device__ __forceinline__ void operator()(const f32x4 (&acc)[2][2][4][2], const Unit& u, int wr, int wc, int fr, int fq, const PG8_LAS float* rs) const {
        const int row0 = u.pm * BM + wr * 64 + fr; const int col0 = u.pn * BM + wc * 64 + 8 * fq;
#pragma unroll
        for (int ai = 0; ai < 2; ++ai)
#pragma unroll
            for (int m = 0; m < 4; ++m) { const int r = row0 + ai * HALF + m * 16; const float rsv = rs[wr * 64 + ai * HALF + m * 16 + fr];
#pragma unroll
                for (int bj = 0; bj < 2; ++bj) { f32x4 v0 = acc[ai][bj][m][0] * rsv, v1 = acc[ai][bj][m][1] * rsv;
#pragma unroll
                    for (int j = 0; j < 4; ++j) { const float a = fmaxf(v0[j], 0.f), b = fmaxf(v1[j], 0.f); v0[j] = a * a; v1[j] = b * b; }
                    u32x4 w; w.x = cvt_pk_bf16(v0[0], v0[1]); w.y = cvt_pk_bf16(v0[2], v0[3]); w.z = cvt_pk_bf16(v1[0], v1[1]); w.w = cvt_pk_bf16(v1[2], v1[3]);
                    *(u32x4*)(H + (size_t)r * FF + col0 + bj * 32) = w; } }
    }
    __device__ __forceinline__ void tail_cols(int cb, int& w0, int& w1) const { w0 = 64 * cb; w1 = w0 + 32; }
    __device__ __forceinline__ void tail(const f32x4& a0, const f32x4& a1, int row, int cb, int coff, int wm, int wn, int fr, int fq, PG8_LAS unsigned char* red) const {
        const float rs = row_rstd(SS, row);
#pragma unroll
        for (int sg = 0; sg < 2; ++sg) { const int col = 64 * cb + 32 * sg + coff; f32x4 v = (sg ? a1 : a0) * rs;
#pragma unroll
            for (int j = 0; j < 4; ++j) { const float a = fmaxf(v[j], 0.f); v[j] = a * a; }
            u32x2 w; w.x = cvt_pk_bf16(v[0], v[1]); w.y = cvt_pk_bf16(v[2], v[3]);
            *(u32x2*)(H + (size_t)row * FF + col) = w; }
    }
};
struct EpiPw1 {
    static constexpr bool PERM = true;
    bf16_t* G; const float* SS; const float* bias; float* out;
    __device__ __forceinline__ void operator()(const f32x4 (&acc)[2][2][4][2], const Unit& u, int wr, int wc, int fr, int fq, const PG8_LAS float* rs) const {
        const int row0 = u.pm * BM + wr * 64 + fr; const int col0 = u.pn * HALF + wc * 32 + 8 * fq;
        f32x4 bv[2][2];
#pragma unroll
        for (int bj = 0; bj < 2; ++bj)
#pragma unroll
            for (int n = 0; n < 2; ++n) bv[bj][n] = *(const f32x4*)(bias + bj * 1024 + col0 + 4 * n);
#pragma unroll
        for (int ai = 0; ai < 2; ++ai)
#pragma unroll
            for (int m = 0; m < 4; ++m) { const int r = row0 + ai * HALF + m * 16; const float rsv = rs[wr * 64 + ai * HALF + m * 16 + fr];
                f32x4 o0, o1;
#pragma unroll
                for (int j = 0; j < 4; ++j) { o0[j] = (acc[ai][0][m][0][j] * rsv + bv[0][0][j]) * sigmoidf_(acc[ai][1][m][0][j] * rsv + bv[1][0][j]);
                                              o1[j] = (acc[ai][0][m][1][j] * rsv + bv[0][1][j]) * sigmoidf_(acc[ai][1][m][1][j] * rsv + bv[1][1][j]); }
                u32x4 w; w.x = cvt_pk_bf16(o0[0], o0[1]); w.y = cvt_pk_bf16(o0[2], o0[3]); w.z = cvt_pk_bf16(o1[0], o1[1]); w.w = cvt_pk_bf16(o1[2], o1[3]);
                *(u32x4*)(G + (size_t)r * 1024 + col0) = w;
                float* st = nullptr;
                if (r < MP) { const int t = r & 2047; if (t >= 2018) st = out + O_PCC + ((size_t)(r >> 11) * 30 + (t - 2018)) * 1024; }
                else { const int rr = r - MP; st = out + O_SCC + ((size_t)(rr >> 3) * 30 + 22 + (rr & 7)) * 1024; }
                if (st) { __builtin_nontemporal_store(o0, (f32x4*)(st + col0)); __builtin_nontemporal_store(o1, (f32x4*)(st + col0 + 4)); } }
    }
    __device__ __forceinline__ void tail_cols(int cb, int& w0, int& w1) const { w0 = 256 * (cb >> 2) + 64 * (cb & 3); w1 = w0 + 32; }
    __device__ __forceinline__ void tail(const f32x4& a0, const f32x4& a1, int row, int cb, int coff, int wm, int wn, int fr, int fq, PG8_LAS unsigned char* red) const {
        const float rs = row_rstd(SS, row); const int oc = 32 * cb + coff, rr = row - MP;
        const f32x4 bv = *(const f32x4*)(bias + oc), bg = *(const f32x4*)(bias + 1024 + oc);
        f32x4 o;
#pragma unroll
        for (int j = 0; j < 4; ++j) o[j] = (a0[j] * rs + bv[j]) * sigmoidf_(a1[j] * rs + bg[j]);
        u32x2 w; w.x = cvt_pk_bf16(o[0], o[1]); w.y = cvt_pk_bf16(o[2], o[3]);
        *(u32x2*)(G + (size_t)row * 1024 + oc) = w;
        *(f32x4*)(out + O_SCC + ((size_t)(rr >> 3) * 30 + 22 + (rr & 7)) * 1024 + oc) = o;
    }
};
}
namespace pg8 {
constexpr int TL_STAGE = 32768, TL_RED = 3 * TL_STAGE;
template <class Epi>
__device__ __forceinline__ void gemm_tail(PG8_LAS unsigned char* lds, const bf16_t* A  , int lda, const bf16_t* Bt, int K, int ntiles_n  , const Epi& E, int bx, int G, int i_begin, int i_end) {
    const int tid = threadIdx.x, wid = __builtin_amdgcn_readfirstlane(tid >> 6), lane = tid & 63, wm = wid >> 1, wn = wid & 1, fr = lane & 15, fq = lane >> 4;
    const int nk = K / 128, ntiles = 16 * ntiles_n;
    const int lrow = lane >> 4, lch = lane & 15;
    for (int ii = i_begin; ii < i_end; ++ii) { const int ti = bx + G * ii; if (ti >= ntiles) break;
        const int rb = ti & 15, cb = ti >> 4;
        int wrow0, wrow1; E.tail_cols(cb, wrow0, wrow1);
        const char* srcA[2]; const char* srcB[2];
#pragma unroll
        for (int i = 0; i < 2; ++i) {
            const int r = 8 * wid + 4 * i + lrow;
            srcA[i] = (const char*)(A + (size_t)(rb * 64 + r) * lda) + ((lch ^ (r & 15)) << 4);
            const int wr_ = (r < 32) ? (wrow0 + r) : (wrow1 + r - 32);
            srcB[i] = (const char*)(Bt + (size_t)wr_ * K) + ((lch ^ (r & 15)) << 4);
        }
#define TL_ISSUE(kt, st) do { _Pragma("unroll") for (int _i = 0; _i < 2; ++_i) { \
            __builtin_amdgcn_global_load_lds((const unsigned*)(srcA[_i] + (size_t)(kt) * 256), (PG8_LAS unsigned*)(lds + (st) * TL_STAGE + (8 * wid + 4 * _i) * 256), 16, 0, 0); \
            __builtin_amdgcn_global_load_lds((const unsigned*)(srcB[_i] + (size_t)(kt) * 256), (PG8_LAS unsigned*)(lds + (st) * TL_STAGE + 16384 + (8 * wid + 4 * _i) * 256), 16, 0, 0); } } while (0)
        f32x4 acc[2] = {(f32x4){0.f, 0.f, 0.f, 0.f}, (f32x4){0.f, 0.f, 0.f, 0.f}};
        TL_ISSUE(0, 0); TL_ISSUE(1, 1);
        for (int kt = 0; kt < nk; ++kt) {
            const int st = kt % 3;
            if (kt + 1 < nk) asm volatile("s_waitcnt vmcnt(4)" ::: "memory"); else asm volatile("s_waitcnt vmcnt(0)" ::: "memory");
            asm volatile("s_waitcnt lgkmcnt(0)" ::: "memory"); __builtin_amdgcn_s_barrier(); asm volatile("" ::: "memory");
            if (kt + 2 < nk) TL_ISSUE(kt + 2, (kt + 2) % 3);
            const PG8_LAS unsigned char* sa = lds + st * TL_STAGE + (16 * wm + fr) * 256;
            const PG8_LAS unsigned char* sb0 = lds + st * TL_STAGE + 16384 + (16 * wn + fr) * 256;
            const PG8_LAS unsigned char* sb1 = sb0 + 32 * 256;
#pragma unroll
            for (int ks = 0; ks < 4; ++ks) {
                const int co = ((4 * ks + fq) ^ fr) << 4;
                const bf16x8 a = *(const PG8_LAS bf16x8*)(sa + co), b0 = *(const PG8_LAS bf16x8*)(sb0 + co), b1 = *(const PG8_LAS bf16x8*)(sb1 + co);
                acc[0] = __builtin_amdgcn_mfma_f32_16x16x32_bf16(b0, a, acc[0], 0, 0, 0);
                acc[1] = __builtin_amdgcn_mfma_f32_16x16x32_bf16(b1, a, acc[1], 0, 0, 0);
            }
        }
#undef TL_ISSUE
        E.tail(acc[0], acc[1], MP + rb * 64 + 16 * wm + fr, cb, 16 * wn + 4 * fq, wm, wn, fr, fq, lds + TL_RED);
        asm volatile("s_waitcnt lgkmcnt(0)" ::: "memory"); __builtin_amdgcn_s_barrier(); asm volatile("" ::: "memory");
    }
}
template <int NCB, class Epi>
__device__ __forceinline__ void gemm_tail_wide(PG8_LAS unsigned char* lds, const bf16_t* A  , int lda, const bf16_t* Bt, int K, const Epi& E, int bx, int G) {
    static_assert(NCB == 2 || NCB == 4, "NCB");
    constexpr int STAGE = 8192 * (1 + NCB), CJ = (NCB == 4) ? 4 : 2;
    const int tid = threadIdx.x, wid = __builtin_amdgcn_readfirstlane(tid >> 6), lane = tid & 63, wm2 = wid >> 2, wn4 = wid & 3, fr = lane & 15, fq = lane >> 4;
    const int nk = K / 64;
    const int lrow = lane >> 3, lch = lane & 7;
    for (int s = bx; s < 256; s += G) {
        const int rb = s & 15, cb0 = s >> 4;
        const char* srcA = (const char*)(A + (size_t)(rb * 64 + 8 * wid + lrow) * lda) + ((lch ^ lrow) << 4);
        const char* srcB[NCB];
#pragma unroll
        for (int i = 0; i < NCB; ++i) { int w0, w1; E.tail_cols(cb0 + 16 * i, w0, w1);
            const int wr_ = ((wid >> 2) ? w1 : w0) + ((8 * wid + lrow) & 31);
            srcB[i] = (const char*)(Bt + (size_t)wr_ * K) + ((lch ^ lrow) << 4); }
#define TW_ISSUE(kt, st) do { \
            __builtin_amdgcn_global_load_lds((const unsigned*)(srcA + (size_t)(kt) * 128), (PG8_LAS unsigned*)(lds + (st) * STAGE + (8 * wid) * 128), 16, 0, 0); \
            _Pragma("unroll") for (int _i = 0; _i < NCB; ++_i) \
                __builtin_amdgcn_global_load_lds((const unsigned*)(srcB[_i] + (size_t)(kt) * 128), (PG8_LAS unsigned*)(lds + (st) * STAGE + 8192 + (64 * _i + 8 * wid) * 128), 16, 0, 0); } while (0)
        f32x4 acc[2][CJ];
#pragma unroll
        for (int ri = 0; ri < 2; ++ri)
#pragma unroll
            for (int j = 0; j < CJ; ++j) acc[ri][j] = (f32x4){0.f, 0.f, 0.f, 0.f};
        const int brow0 = (NCB == 4) ? 64 * wn4 : (64 * (wn4 >> 1) + 16 * (wn4 & 1));
        TW_ISSUE(0, 0); TW_ISSUE(1, 1);
        for (int kt = 0; kt < nk; ++kt) {
            const int st = kt % 3;
            if (kt + 1 < nk) { if (NCB == 4) asm volatile("s_waitcnt vmcnt(5)" ::: "memory"); else asm volatile("s_waitcnt vmcnt(3)" ::: "memory"); }
            else asm volatile("s_waitcnt vmcnt(0)" ::: "memory");
            asm volatile("s_waitcnt lgkmcnt(0)" ::: "memory"); __builtin_amdgcn_s_barrier(); asm volatile("" ::: "memory");
            if (kt + 2 < nk) TW_ISSUE(kt + 2, (kt + 2) % 3);
            const PG8_LAS unsigned char* sa = lds + st * STAGE + (32 * wm2 + fr) * 128;
            const PG8_LAS unsigned char* sb = lds + st * STAGE + 8192 + (brow0 + fr) * 128;
#pragma unroll
            for (int ks = 0; ks < 2; ++ks) {
                const int co = ((4 * ks + fq) ^ (fr & 7)) << 4;
                const bf16x8 a0 = *(const PG8_LAS bf16x8*)(sa + co), a1 = *(const PG8_LAS bf16x8*)(sa + 16 * 128 + co);
#pragma unroll
                for (int j = 0; j < CJ; ++j) {
                    const bf16x8 b = *(const PG8_LAS bf16x8*)(sb + ((NCB == 4) ? 16 : 32) * j * 128 + co);
                    acc[0][j] = __builtin_amdgcn_mfma_f32_16x16x32_bf16(b, a0, acc[0][j], 0, 0, 0);
                    acc[1][j] = __builtin_amdgcn_mfma_f32_16x16x32_bf16(b, a1, acc[1][j], 0, 0, 0);
                }
            }
        }
#undef TW_ISSUE
#pragma unroll
        for (int ri = 0; ri < 2; ++ri) {
            const int row = MP + rb * 64 + 32 * wm2 + 16 * ri + fr;
            if (NCB == 4) {
#pragma unroll
                for (int wn = 0; wn < 2; ++wn) E.tail(acc[ri][wn], acc[ri][2 + wn], row, cb0 + 16 * wn4, 16 * wn + 4 * fq, 2 * wm2 + ri, wn, fr, fq, nullptr);
            } else {
                const int wn = wn4 & 1;
                E.tail(acc[ri][0], acc[ri][1], row, cb0 + 16 * (wn4 >> 1), 16 * wn + 4 * fq, 2 * wm2 + ri, wn, fr, fq, nullptr);
            }
        }
        asm volatile("s_waitcnt lgkmcnt(0)" ::: "memory"); __builtin_amdgcn_s_barrier(); asm volatile("" ::: "memory");
    }
}
}
__device__ __forceinline__ void p0_transpose_item(const float* W, int ldw, int K, bf16* WT, int dst_row0, const float* kscale, LAS float* scr, int k0, int n0, int lane) {
    float tv[32];
#pragma unroll
    for (int i = 0; i < 32; ++i) { const int kk = 2 * i + (lane >> 5); tv[i] = W[(size_t)(k0 + kk) * ldw + n0 + (lane & 31)]; }
    if (kscale) {
#pragma unroll
        for (int i = 0; i < 32; ++i) tv[i] *= kscale[k0 + 2 * i + (lane >> 5)];
    }
#pragma unroll
    for (int i = 0; i < 32; ++i) { const int kk = 2 * i + (lane >> 5); scr[kk * 33 + (lane & 31)] = tv[i]; }
    LDS_WAIT(); asm volatile("" ::: "memory");
    const int c = lane & 7;
#pragma unroll
    for (int j = 0; j < 4; ++j) { const int n = (lane >> 3) + 8 * j; const LAS float* s = scr + (8 * c) * 33 + n;
        v4u o; o.x = pk2(s[0 * 33], s[1 * 33]); o.y = pk2(s[2 * 33], s[3 * 33]); o.z = pk2(s[4 * 33], s[5 * 33]); o.w = pk2(s[6 * 33], s[7 * 33]);
        *(GAS v4u*)(WT + (size_t)(dst_row0 + n) * K + k0 + 8 * c) = o; }
    LDS_WAIT(); asm volatile("" ::: "memory");
}
__device__ __forceinline__ void p0_mat(const float* W, int ldw, int K, int ncols, bf16* WT, int row_off, const float* kscale, LAS float* scr, int item, int lane, int glu_map) {
    const int nblk = ncols / 32, kb = item / nblk, nb = item % nblk, n0 = 32 * nb;
    int dst = row_off + n0;
    if (glu_map) dst = (n0 < 1024) ? (256 * (n0 >> 7) + 64 * ((n0 & 127) >> 5)) : (256 * ((n0 - 1024) >> 7) + 64 * (((n0 - 1024) & 127) >> 5) + 32);
    p0_transpose_item(W, ldw, K, WT, dst, kscale, scr, 64 * kb, n0, lane);
}
constexpr int P0_SCR_STRIDE = 8704;
constexpr int P0_WD_OFF = NWAVES * P0_SCR_STRIDE;
constexpr int P0_WD_LD = 1028, P0_WDB_PITCH = 2064;
static_assert(P0_WD_OFF + 16 * P0_WD_LD * 4 <= LDSCTL_OFF, "P0 LDS");

constexpr int P0_WIN_ITEMS = 16 * 96 + 16 * 32, P0_L0_ITEMS = P0_WIN_ITEMS + 16 * 32 + 32 * 32 + 16 * 128 + 64 * 32  , P0_PW1_ITEMS = P0_L0_ITEMS + 16 * 64  , P0_ALL_ITEMS = 16 * 96 + 16 * 32 + 16 * 32 + 32 * 32 + 2 * 16 * 128 + 2 * 64 * 32 + 16 * 64 + 16 * 32;
__device__ __forceinline__ void p0_weights(Frame& F, int lo, int hi, int gw_ = -1  , int NGW_ = 0) {
    LAS float* scr = (LAS float*)(F.lds + F.wave * P0_SCR_STRIDE);
    const int gw = gw_ >= 0 ? gw_ : F.vcu * NWAVES + F.wave, NGW = gw_ >= 0 ? NGW_ : F.G * NWAVES;
    const float* w_in = F.inp(10); const float* nmix = F.inp(7); const float* nff = F.inp(8);
    bf16* Win = (bf16*)(F.ws + WS_WIN); bf16* Wglu = (bf16*)(F.ws + WS_WGLU); bf16* Wout = (bf16*)(F.ws + WS_WOUT);
    bf16* Wff1 = (bf16*)(F.ws + WS_WFF1); bf16* Wff2 = (bf16*)(F.ws + WS_WFF2); bf16* Wpw1 = (bf16*)(F.ws + WS_WPW1); bf16* Wpw2 = (bf16*)(F.ws + WS_WPW2);
    constexpr int I1 = 16 * 96, I2 = 16 * 32, I3 = 16 * 32, I4 = 32 * 32, I5 = 16 * 128, I6 = 64 * 32, I7 = 16 * 64, I8 = 16 * 32;
    constexpr int NITEMS = I1 + I2 + I3 + I4 + 2 * I5 + 2 * I6 + I7 + I8;
#define P0_DECODE(it_, src_, ldw_, dst_, K_, ks_) do { \
        const float* W_; int ncols_, roff_ = 0, glu_ = 0; bf16* WT_; const float* ksc_ = nullptr; int r_ = (it_); \
        if (r_ < I1) { W_ = w_in; ldw_ = INC; K_ = 1024; ncols_ = 3072; WT_ = Win; ksc_ = nmix; } \
        else if ((r_ -= I1) < I2) { W_ = w_in + 3088; ldw_ = INC; K_ = 1024; ncols_ = 1024; WT_ = Win; roff_ = 3072; ksc_ = nmix; } \
        else if ((r_ -= I2) < I3) { W_ = F.inp(25); ldw_ = 1024; K_ = 1024; ncols_ = 1024; WT_ = Wglu; } \
        else if ((r_ -= I3) < I4) { W_ = F.inp(27); ldw_ = 1024; K_ = 2048; ncols_ = 1024; WT_ = Wout; } \
        else if ((r_ -= I4) < I5) { W_ = F.inp(36); ldw_ = 4096; K_ = 1024; ncols_ = 4096; WT_ = Wff1; ksc_ = nff; } \
        else if ((r_ -= I5) < I6) { W_ = F.inp(37); ldw_ = 1024; K_ = 4096; ncols_ = 1024; WT_ = Wff2; } \
        else if ((r_ -= I6) < I7) { W_ = F.inp(28); ldw_ = 2048; K_ = 1024; ncols_ = 2048; WT_ = Wpw1; ksc_ = nmix + 1024; glu_ = 1; } \
        else if ((r_ -= I7) < I5) { W_ = F.inp(36) + (size_t)1024 * 4096; ldw_ = 4096; K_ = 1024; ncols_ = 4096; WT_ = Wff1 + (size_t)4096 * 1024; ksc_ = nff + 1024; } \
        else if ((r_ -= I5) < I6) { W_ = F.inp(37) + (size_t)4096 * 1024; ldw_ = 1024; K_ = 4096; ncols_ = 1024; WT_ = Wff2 + (size_t)1024 * 4096; } \
        else { r_ -= I6; W_ = F.inp(34); ldw_ = 1024; K_ = 1024; ncols_ = 1024; WT_ = Wpw2; } \
        const int nblk_ = ncols_ >> 5, kb_ = r_ / nblk_, n0_ = 32 * (r_ - kb_ * nblk_); \
        int drow_ = roff_ + n0_; \
        if (glu_) drow_ = (n0_ < 1024) ? (256 * (n0_ >> 7) + 64 * ((n0_ & 127) >> 5)) : (256 * ((n0_ - 1024) >> 7) + 64 * (((n0_ - 1024) & 127) >> 5) + 32); \
        src_ = W_ + (size_t)(64 * kb_ + (F.lane >> 5)) * ldw_ + n0_ + (F.lane & 31); \
        dst_ = WT_ + (size_t)drow_ * K_ + 64 * kb_; ks_ = ksc_ ? ksc_ + 64 * kb_ : nullptr; } while (0)
    {
        float tv[32];
        const float* src; int ldw = 0, K = 0; bf16* dst; const float* ks;
        if (lo + gw < hi) { P0_DECODE(lo + gw, src, ldw, dst, K, ks);
#pragma unroll
            for (int i = 0; i < 32; ++i) tv[i] = __builtin_nontemporal_load(&src[(size_t)(2 * i) * ldw]); }
        for (int it = lo + gw; it < hi; it += NGW) {
            float nv_[32]; const float* nsrc; int nldw = 0, nK = 0; bf16* ndst = nullptr; const float* nks = nullptr;
            const bool more = it + NGW < hi;
            if (more) { P0_DECODE(it + NGW, nsrc, nldw, ndst, nK, nks);
#pragma unroll
                for (int i = 0; i < 32; ++i) nv_[i] = __builtin_nontemporal_load(&nsrc[(size_t)(2 * i) * nldw]); }
            const int c = F.lane & 7;
            f32x4 k0v = (f32x4){1.f, 1.f, 1.f, 1.f}, k1v = k0v;
            if (ks) { k0v = *(const f32x4*)(ks + 8 * c); k1v = *(const f32x4*)(ks + 8 * c + 4); }
#pragma unroll
            for (int i = 0; i < 32; ++i) { const int kk = 2 * i + (F.lane >> 5); scr[kk * 33 + (F.lane & 31)] = tv[i]; }
            LDS_WAIT(); asm volatile("" ::: "memory");
#pragma unroll
            for (int j = 0; j < 4; ++j) { const int n = (F.lane >> 3) + 8 * j; const LAS float* sp = scr + (8 * c) * 33 + n;
                v4u o; o.x = pk2(sp[0 * 33] * k0v.x, sp[1 * 33] * k0v.y); o.y = pk2(sp[2 * 33] * k0v.z, sp[3 * 33] * k0v.w); o.z = pk2(sp[4 * 33] * k1v.x, sp[5 * 33] * k1v.y); o.w = pk2(sp[6 * 33] * k1v.z, sp[7 * 33] * k1v.w);
                if (lo >= P0_WIN_ITEMS) __builtin_nontemporal_store(o, (GAS v4u*)(dst + (size_t)n * K + 8 * c));
                else *(GAS v4u*)(dst + (size_t)n * K + 8 * c) = o; }
            LDS_WAIT(); asm volatile("" ::: "memory");
            if (more) {
#pragma unroll
                for (int i = 0; i < 32; ++i) tv[i] = nv_[i];
                dst = ndst; K = nK; ks = nks; }
        }
    }
#undef P0_DECODE
}
__device__ __forceinline__ void p0_prologue(Frame& F) {
    LAS float* scr = (LAS float*)(F.lds + F.wave * P0_SCR_STRIDE);
    const int gw = F.vcu * NWAVES + F.wave, NGW = F.G * NWAVES;
    const float* w_in = F.inp(10); const float* nmix = F.inp(7); const float* nff = F.inp(8);
    { LAS unsigned char* WD = F.lds + P0_WD_OFF;
      for (int k = F.tid; k < 1024; k += NWAVES * 64) { const float nk = nmix[k]; const f32x4* wp = (const f32x4*)(w_in + (size_t)k * INC + 3072);
#pragma unroll
          for (int q = 0; q < 4; ++q) { const f32x4 w4 = wp[q];
              *(LAS unsigned short*)(WD + (4 * q) * P0_WDB_PITCH + k * 2) = (unsigned short)f2bf(w4.x * nk); *(LAS unsigned short*)(WD + (4 * q + 1) * P0_WDB_PITCH + k * 2) = (unsigned short)f2bf(w4.y * nk);
              *(LAS unsigned short*)(WD + (4 * q + 2) * P0_WDB_PITCH + k * 2) = (unsigned short)f2bf(w4.z * nk); *(LAS unsigned short*)(WD + (4 * q + 3) * P0_WDB_PITCH + k * 2) = (unsigned short)f2bf(w4.w * nk); } } }
    { float* WT = (float*)(F.ws + (235u << 20)); const float* wd = F.inp(30);
      for (int idx = (int)blockIdx.x * (NWAVES * 64) + F.tid; idx < 1024 * 32; idx += F.G * NWAVES * 64) { const int ch = idx >> 5, k = idx & 31; WT[idx] = (k < 31) ? wd[k * 1024 + ch] : 0.f; } }
    p0_weights(F, 0, P0_WIN_ITEMS);
    FSTAMP(F);
    bf16* CAT = (bf16*)(F.ws + WS_CAT); float* SS = (float*)(F.ws + WS_SS); float* DT = (float*)(F.ws + WS_DT); float* DA = (float*)(F.ws + WS_DA);
    typedef __bf16 p0_bf2 __attribute__((ext_vector_type(2)));
    __syncthreads();
    unsigned wdt[16][8];
#pragma unroll
    for (int h = 0; h < 16; ++h)
#pragma unroll
        for (int j = 0; j < 4; ++j) { const v2u w2 = *(const LAS v2u*)(F.lds + P0_WD_OFF + h * P0_WDB_PITCH + (4 * F.lane + 256 * j) * 2); wdt[h][2 * j] = w2.x; wdt[h][2 * j + 1] = w2.y; }
    const float dt_bias = F.inp(13)[F.lane & 15], dt_a = -__expf(F.inp(14)[F.lane & 15]);
    f32x4 nv[4];
    { const int m0 = gw < MT ? gw : 0; const float* xrow = (m0 < MP) ? F.inp(0) + (size_t)m0 * DM : F.inp(1) + (size_t)(m0 - MP) * DM; const GAS f32x4* xr = (const GAS f32x4*)xrow + F.lane;
#pragma unroll
      for (int j = 0; j < 4; ++j) nv[j] = __builtin_nontemporal_load(&xr[64 * j]); }
    for (int m = gw; m < MT; m += NGW) {
        f32x4 v[4]; float s = 0.f;
#pragma unroll
        for (int j = 0; j < 4; ++j) { v[j] = nv[j]; s += (v[j].x * v[j].x + v[j].y * v[j].y) + (v[j].z * v[j].z + v[j].w * v[j].w); }
        { const int mn = (m + NGW < MT) ? m + NGW : m; const float* xrow = (mn < MP) ? F.inp(0) + (size_t)mn * DM : F.inp(1) + (size_t)(mn - MP) * DM; const GAS f32x4* xr = (const GAS f32x4*)xrow + F.lane;
#pragma unroll
          for (int j = 0; j < 4; ++j) nv[j] = __builtin_nontemporal_load(&xr[64 * j]); }
        s = wave_sum(s);
        GAS unsigned long long* o8 = (GAS unsigned long long*)(CAT + (size_t)m * 2048 + 1024) + F.lane;
        unsigned xp[8];
#pragma unroll
        for (int j = 0; j < 4; ++j) { xp[2 * j] = pk2(v[j].x, v[j].y); xp[2 * j + 1] = pk2(v[j].z, v[j].w); o8[64 * j] = (unsigned long long)xp[2 * j] | ((unsigned long long)xp[2 * j + 1] << 32); }
        if (F.lane < 16) SS[(size_t)m * 16 + F.lane] = (F.lane == 0) ? s : 0.f;
        float dd[16];
#pragma unroll
        for (int h = 0; h < 16; ++h) {
            float d = 0.f;
#pragma unroll
            for (int q = 0; q < 8; ++q) d = __builtin_amdgcn_fdot2_f32_bf16(__builtin_bit_cast(p0_bf2, xp[q]), __builtin_bit_cast(p0_bf2, wdt[h][q]), d, false);
            dd[h] = d;
        }
        float dsel = row16_reduce_scatter(dd, F.lane);
        dsel += __shfl_xor(dsel, 16); dsel += __shfl_xor(dsel, 32);
        if (F.lane < 16) {
            const float xr_ = dsel * __builtin_amdgcn_rsqf(s * (1.0f / 1024.0f) + EPS) + dt_bias;
            const float dtv = xr_ > 20.f ? xr_ : log1pf(__expf(xr_));
            DT[(size_t)m * 16 + F.lane] = dtv; DA[(size_t)m * 16 + F.lane] = dtv * dt_a;
        }
    }
}
constexpr int DT_WPITCH = 2064;
__device__ __forceinline__ void dt_phase(Frame& F) {
    typedef short dt_bf16x8 __attribute__((ext_vector_type(8)));
    const bf16* WDT = (const bf16*)(F.ws + WS_WDT); const bf16* CAT = (const bf16*)(F.ws + WS_CAT); const float* SS = (const float*)(F.ws + WS_SS);
    float* DT = (float*)(F.ws + WS_DT); float* DA = (float*)(F.ws + WS_DA);
    LAS unsigned char* WL = F.lds;
    for (int pc = F.tid; pc < 16 * 128; pc += NWAVES * 64) { const int h = pc >> 7, q = pc & 127; *(LAS v4u*)(WL + h * DT_WPITCH + q * 16) = *(const v4u*)(WDT + (size_t)h * 1024 + q * 8); }
    __syncthreads();
    const int fr = F.lane & 15, fq = F.lane >> 4;
    const int gw = F.vcu * NWAVES + F.wave;
    if (gw < MT / 16) {
        const int row = gw * 16 + fr;
        const bf16* xp = CAT + (size_t)row * 2048 + 1024 + 8 * fq;
        f32x4 acc = (f32x4){0.f, 0.f, 0.f, 0.f};
#pragma unroll
        for (int s8 = 0; s8 < 4; ++s8) {
            dt_bf16x8 xf[8];
#pragma unroll
            for (int k = 0; k < 8; ++k) xf[k] = *(const dt_bf16x8*)(xp + 32 * (8 * s8 + k));
#pragma unroll
            for (int k = 0; k < 8; ++k) { const dt_bf16x8 wf = *(const LAS dt_bf16x8*)(WL + fr * DT_WPITCH + (32 * (8 * s8 + k) + 8 * fq) * 2);
                acc = __builtin_amdgcn_mfma_f32_16x16x32_bf16(wf, xf[k], acc, 0, 0, 0); }
        }
        const float rstd = row_rstd(SS, row);
        const f32x4 bias = *(const f32x4*)(F.inp(13) + 4 * fq), al = *(const f32x4*)(F.inp(14) + 4 * fq);
        f32x4 dtv, dav;
#pragma unroll
        for (int j = 0; j < 4; ++j) { const float xr_ = acc[j] * rstd + bias[j]; dtv[j] = xr_ > 20.f ? xr_ : log1pf(__expf(xr_)); dav[j] = -dtv[j] * __expf(al[j]); }
        *(f32x4*)(DT + (size_t)row * 16 + 4 * fq) = dtv; *(f32x4*)(DA + (size_t)row * 16 + 4 * fq) = dav;
    }
    __syncthreads();
}
typedef short s5_bf16x8 __attribute__((ext_vector_type(8)));
constexpr int S5_HB_ROW = 288;
constexpr int S5_HB_WAVE = 2 * 16 * S5_HB_ROW;
constexpr int S5_HE_OFF = NWAVES * S5_HB_WAVE;
constexpr int S5_YT_OFF = S5_HE_OFF + NWAVES * 2 * 64 * 2 * 4;
constexpr int S5_LDS_END = S5_YT_OFF + NWAVES * 1024;
static_assert(S5_LDS_END <= LDSCTL_OFF, "S5 LDS");
constexpr int S5_PROMPT_UNITS = 256, S5_SAMPLE_UNITS = 256, S5_UNITS = S5_PROMPT_UNITS + S5_SAMPLE_UNITS;

__device__ __forceinline__ float gelu_tanh(float x) {
    const float arg = x * __builtin_fmaf(x * x, 0.10294324f, 2.3022082f);
    const float r = frcp_(__builtin_amdgcn_exp2f(arg) + 1.0f);
    return __builtin_fmaf(-x, r, x);
}

struct S5Consts {
    float lr[2], li[2];
    s5_bf16x8 bfr[2][2];
    s5_bf16x8 cm[4];
    s5_bf16x8 dm;
};
__device__ __forceinline__ void s5_setup(const Frame& F, int g, S5Consts& K) {
    const int lane = F.lane, r = lane & 31, hh = lane >> 5;
    const float step = expf(F.inp(19)[g]);
#pragma unroll
    for (int pt = 0; pt < 2; ++pt) {
        const int p = 32 * pt + r;
        const float lr = F.inp(17)[g * 64 + p], li = F.inp(18)[g * 64 + p];
        const float mag = expf(lr * step), ar = mag * cosf(li * step), ai = mag * sinf(li * step);
        const float den = lr * lr + li * li;
        const float kr = ((ar - 1.0f) * lr + ai * li) / den, ki = (ai * lr - (ar - 1.0f) * li) / den;
        K.lr[pt] = ar; K.li[pt] = ai;
        const float* br = F.inp(20) + ((size_t)(g * 64 + p) * 16 + 8 * hh); const float* bi = F.inp(21) + ((size_t)(g * 64 + p) * 16 + 8 * hh);
        unsigned wr_[4], wi_[4];
#pragma unroll
        for (int j = 0; j < 4; ++j) {
            const float b0r = br[2 * j], b0i = bi[2 * j], b1r = br[2 * j + 1], b1i = bi[2 * j + 1];
            wr_[j] = pk2(kr * b0r - ki * b0i, kr * b1r - ki * b1i);
            wi_[j] = pk2(kr * b0i + ki * b0r, kr * b1i + ki * b1r);
        }
        K.bfr[pt][0] = __builtin_bit_cast(s5_bf16x8, (v4u){wr_[0], wr_[1], wr_[2], wr_[3]});
        K.bfr[pt][1] = __builtin_bit_cast(s5_bf16x8, (v4u){wi_[0], wi_[1], wi_[2], wi_[3]});
    }
    const int c = lane & 15, q = lane >> 4;
#pragma unroll
    for (int s = 0; s < 4; ++s) {
        const int p0 = 16 * s + 4 * q;
        const float* cr = F.inp(22) + ((size_t)(g * 16 + c) * 64 + p0); const float* ci = F.inp(23) + ((size_t)(g * 16 + c) * 64 + p0);
        unsigned w[4];
#pragma unroll
        for (int j = 0; j < 4; ++j) w[j] = pk2(cr[j], -ci[j]);
        K.cm[s] = __builtin_bit_cast(s5_bf16x8, (v4u){w[0], w[1], w[2], w[3]});
    }
    { const float dv = F.inp(24)[g * 16 + c]; unsigned w[4];
#pragma unroll
      for (int j = 0; j < 4; ++j) { const int k0 = 8 * q + 2 * j; w[j] = pk2((q < 2 && k0 == c) ? dv : 0.f, (q < 2 && k0 + 1 == c) ? dv : 0.f); }
      K.dm = __builtin_bit_cast(s5_bf16x8, (v4u){w[0], w[1], w[2], w[3]}); }
}

struct S5Frags { s5_bf16x8 a, u0, u1; };
template <bool WITH_Y>
__device__ __forceinline__ S5Frags s5_load_a(const Frame& F, const bf16* U, int g, int base0, int base1) {
    S5Frags fr;
    const int r = F.lane & 31, hh = F.lane >> 5, h = (r >> 2) & 1, i = (r & 3) + 4 * (r >> 3);
    const int arow = (h ? base1 : base0) + i;
    fr.a = *(const GAS s5_bf16x8*)(U + (size_t)arow * 1024 + g * 16 + 8 * hh);
    const s5_bf16x8 zz = (s5_bf16x8){0, 0, 0, 0, 0, 0, 0, 0};
    fr.u0 = zz; fr.u1 = zz;
    if (WITH_Y) {
        const int t = F.lane & 15, q = F.lane >> 4;
        if (q < 2) { fr.u0 = *(const GAS s5_bf16x8*)(U + (size_t)(base0 + t) * 1024 + g * 16 + 8 * q); fr.u1 = *(const GAS s5_bf16x8*)(U + (size_t)(base1 + t) * 1024 + g * 16 + 8 * q); }
    }
    return fr;
}

template <int SEGLEN, bool WITH_Y>
__device__ __forceinline__ void s5_step(const Frame& F, const S5Consts& K, bf16* U, int g, int base0, int base1, const S5Frags& fg,
                                        float (&hr)[2][2], float (&hi)[2][2]  , LAS unsigned char* hb, LAS unsigned char* yt) {
    const s5_bf16x8 afrag = fg.a;
    const int lane = F.lane, hh = lane >> 5, r = lane & 31;
    f32x16 bu[2][2];
#pragma unroll
    for (int pt = 0; pt < 2; ++pt)
#pragma unroll
        for (int ri = 0; ri < 2; ++ri) {
            f32x16 z;
#pragma unroll
            for (int i = 0; i < 16; ++i) z[i] = 0.f;
            bu[pt][ri] = __builtin_amdgcn_mfma_f32_32x32x16_bf16(afrag, K.bfr[pt][ri], z, 0, 0, 0);
        }
#pragma unroll
    for (int i = 0; i < 16; ++i) {
        constexpr int dummy = 0; (void)dummy;
        const int cs = (SEGLEN == 8) ? (i >> 3) : 0;
#pragma unroll
        for (int pt = 0; pt < 2; ++pt) {
            const float nr = __builtin_fmaf(K.lr[pt], hr[cs][pt], __builtin_fmaf(-K.li[pt], hi[cs][pt], bu[pt][0][i]));
            const float ni = __builtin_fmaf(K.lr[pt], hi[cs][pt], __builtin_fmaf(K.li[pt], hr[cs][pt], bu[pt][1][i]));
            hr[cs][pt] = nr; hi[cs][pt] = ni;
            if (WITH_Y) *(LAS unsigned*)(hb + (hh * 16 + i) * S5_HB_ROW + (2 * (32 * pt + r)) * 2) = pk2(nr, ni);
        }
    }
    if (WITH_Y) {
        LDS_WAIT(); asm volatile("" ::: "memory");
        const int c = lane & 15, q = lane >> 4;
#pragma unroll
        for (int hf = 0; hf < 2; ++hf) {
            f32x4 y = (f32x4){0.f, 0.f, 0.f, 0.f};
#pragma unroll
            for (int s = 0; s < 4; ++s) {
                const s5_bf16x8 a = *(const LAS s5_bf16x8*)(hb + (hf * 16 + c) * S5_HB_ROW + (32 * s + 8 * q) * 2);
                y = __builtin_amdgcn_mfma_f32_16x16x32_bf16(a, K.cm[s], y, 0, 0, 0);
            }
            y = __builtin_amdgcn_mfma_f32_16x16x32_bf16(hf ? fg.u1 : fg.u0, K.dm, y, 0, 0, 0);
#pragma unroll
            for (int j = 0; j < 4; ++j) *(LAS unsigned short*)(yt + ((hf * 16 + 4 * q + j) * 16 + c) * 2) = (unsigned short)f2bf(gelu_tanh(y[j]));
        }
        {
            const int hf2 = lane >> 5, t = (lane & 31) >> 1, ck = lane & 1;
            const v4u o = *(const LAS v4u*)(yt + ((hf2 * 16 + t) * 16 + 8 * ck) * 2);
            *(GAS v4u*)(U + (size_t)((hf2 ? base1 : base0) + t) * 1024 + g * 16 + 8 * ck) = o;
        }
        LDS_WAIT(); asm volatile("" ::: "memory");
    }
}

__device__ __forceinline__ void s5_block_unit(Frame& F, int unit, S5Consts& K, int& kg  ) {
    bf16* U = (bf16*)(F.ws + WS_U);
    LAS unsigned char* hb = F.lds + F.wave * S5_HB_WAVE;
    LAS unsigned char* yt = F.lds + S5_YT_OFF + F.wave * 1024;
    LAS float* HE = (LAS float*)(F.lds + S5_HE_OFF);
    const int lane = F.lane, hh = lane >> 5, r = lane & 31, w = F.wave;
    if (unit < S5_PROMPT_UNITS) {
        const int g = unit & 63, bp = unit >> 6;
        FSTAMP(F);
        const int rb0 = bp * SEQ + 256 * w, rb1 = (bp + 4) * SEQ + 256 * w;
        S5Frags pf0 = s5_load_a<false>(F, U, g, rb0, rb1), pf1 = s5_load_a<false>(F, U, g, rb0 + 16, rb1 + 16);
        if (kg != g) { s5_setup(F, g, K); kg = g; }
        FSTAMP(F);
        float hr[2][2], hi[2][2];
#pragma unroll
        for (int a = 0; a < 2; ++a)
#pragma unroll
            for (int b = 0; b < 2; ++b) { hr[a][b] = 0.f; hi[a][b] = 0.f; }
        if (w < 7) {
            S5Frags af = pf0, af1 = pf1;
            for (int s = 0; s < 16; ++s) {
                const int s2 = (s + 2) & 15;
                const S5Frags af2 = s5_load_a<false>(F, U, g, rb0 + 16 * s2, rb1 + 16 * s2);
                s5_step<16, false>(F, K, U, g, rb0 + 16 * s, rb1 + 16 * s, af, hr, hi, hb, yt);
                af = af1; af1 = af2;
            }
        }
        S5Frags qf0 = s5_load_a<true>(F, U, g, rb0, rb1), qf1 = s5_load_a<true>(F, U, g, rb0 + 16, rb1 + 16);
#pragma unroll
        for (int pt = 0; pt < 2; ++pt) { HE[((w * 2 + hh) * 64 + 32 * pt + r) * 2 + 0] = hr[0][pt]; HE[((w * 2 + hh) * 64 + 32 * pt + r) * 2 + 1] = hi[0][pt]; }
        FSTAMP(F);
        __syncthreads();
        FSTAMP(F);
        float l256r[2], l256i[2];
#pragma unroll
        for (int pt = 0; pt < 2; ++pt) { float ar = K.lr[pt], ai = K.li[pt];
#pragma unroll
            for (int k = 0; k < 8; ++k) { const float nr = ar * ar - ai * ai, ni = 2.0f * ar * ai; ar = nr; ai = ni; }
            l256r[pt] = ar; l256i[pt] = ai; hr[0][pt] = 0.f; hi[0][pt] = 0.f; }
        for (int cp = 0; cp < w; ++cp) {
#pragma unroll
            for (int pt = 0; pt < 2; ++pt) {
                const float er = HE[((cp * 2 + hh) * 64 + 32 * pt + r) * 2 + 0], ei = HE[((cp * 2 + hh) * 64 + 32 * pt + r) * 2 + 1];
                const float nr = l256r[pt] * hr[0][pt] - l256i[pt] * hi[0][pt] + er, ni = l256r[pt] * hi[0][pt] + l256i[pt] * hr[0][pt] + ei;
                hr[0][pt] = nr; hi[0][pt] = ni; }
        }
        FSTAMP(F);
        {
            S5Frags af = qf0, af1 = qf1;
            for (int s = 0; s < 16; ++s) {
                const int s2 = (s + 2 < 16) ? s + 2 : 15;
                const S5Frags af2 = s5_load_a<true>(F, U, g, rb0 + 16 * s2, rb1 + 16 * s2);
                s5_step<16, true>(F, K, U, g, rb0 + 16 * s, rb1 + 16 * s, af, hr, hi, hb, yt);
                af = af1; af1 = af2;
            }
        }
        FSTAMP(F);
        if (w == 7) {
            const int b = hh ? bp + 4 : bp;
#pragma unroll
            for (int pt = 0; pt < 2; ++pt) { F.out[O_PBR + (size_t)(b * 64 + g) * 64 + 32 * pt + r] = hr[0][pt]; F.out[O_PBI + (size_t)(b * 64 + g) * 64 + 32 * pt + r] = hi[0][pt]; }
        }
        __syncthreads();
    } else {
        const int su = unit - S5_PROMPT_UNITS, g = su & 63, quarter = su >> 6;
        if (kg != g) { s5_setup(F, g, K); kg = g; }
        for (int qq = 0; qq < 1; ++qq) {
            const int quad = quarter * 8 + w, sb0 = 4 * quad;
            const int base0 = MP + sb0 * 8, base1 = base0 + 16;
            float hr[2][2], hi[2][2];
#pragma unroll
            for (int cs = 0; cs < 2; ++cs)
#pragma unroll
                for (int pt = 0; pt < 2; ++pt) { const int seq = sb0 + 2 * hh + cs; const size_t o = (size_t)(seq * 64 + g) * 64 + 32 * pt + r; hr[cs][pt] = F.inp(4)[o]; hi[cs][pt] = F.inp(5)[o]; }
            const S5Frags af = s5_load_a<true>(F, U, g, base0, base1);
            s5_step<8, true>(F, K, U, g, base0, base1, af, hr, hi, hb, yt);
#pragma unroll
            for (int cs = 0; cs < 2; ++cs)
#pragma unroll
                for (int pt = 0; pt < 2; ++pt) { const int seq = sb0 + 2 * hh + cs; const size_t o = (size_t)(seq * 64 + g) * 64 + 32 * pt + r; F.out[O_SBR + o] = hr[cs][pt]; F.out[O_SBI + o] = hi[cs][pt]; }
        }
    }
}
constexpr size_t WS_HALO = 230 * MiB;
constexpr size_t WS_CDEC = 234 * MiB;
typedef short ssd_bf16x8 __attribute__((ext_vector_type(8)));
constexpr int SSD_PITCH = 272;

constexpr int SSDS_XS = 0, SSDS_BS = SSDS_XS + 8 * 256 * 4, SSDS_CS = SSDS_BS + 8 * 128 * 4, SSDS_YS = SSDS_CS + 8 * 128 * 4, SSDS_END = SSDS_YS + 8 * 256 * 4;
__device__ __forceinline__ void ssd_sample_unit(Frame& F, int unit) {
    const int b = unit >> 2, g = unit & 3, tid = F.tid, lane = F.lane;
    const bf16* XBC = (const bf16*)(F.ws + WS_XBC); bf16* CAT = (bf16*)(F.ws + WS_CAT);
    const float* DT = (const float*)(F.ws + WS_DT); const float* DA = (const float*)(F.ws + WS_DA);
    LAS float* xs = (LAS float*)(F.lds + SSDS_XS); LAS float* Bs = (LAS float*)(F.lds + SSDS_BS); LAS float* Cs = (LAS float*)(F.lds + SSDS_CS); LAS float* ys = (LAS float*)(F.lds + SSDS_YS);
    const int row0 = MP + b * 8;
    const int p = tid >> 3, ns = tid & 7;
    f32x4 hst[4][4];
#pragma unroll
    for (int e = 0; e < 4; ++e) { const float* sp = F.inp(3) + ((size_t)(b * 16 + 4 * g + e) * 64 + p) * 128 + ns * 4;
#pragma unroll
        for (int k = 0; k < 4; ++k) hst[e][k] = __builtin_nontemporal_load((const f32x4*)(sp + 32 * k)); }
    f32x4 dt4[8], da4[8];
#pragma unroll
    for (int t = 0; t < 8; ++t) { dt4[t] = *(const f32x4*)(DT + (size_t)(row0 + t) * 16 + 4 * g); da4[t] = *(const f32x4*)(DA + (size_t)(row0 + t) * 16 + 4 * g); }
    bf16* zp = CAT + (size_t)(row0 + F.wave) * 2048 + g * 256 + 4 * lane;
    const v2u zw = *(const v2u*)zp;
    {
        const int col = (tid < 256) ? (g * 256 + tid) : ((tid < 384) ? (1024 + g * 128 + (tid - 256)) : (1536 + g * 128 + (tid - 384)));
        const float* cw = F.inp(11); const float w0 = cw[col], w1 = cw[2048 + col], w2 = cw[4096 + col], w3 = cw[6144 + col], bias = F.inp(12)[col];
        const float* st = F.inp(2) + (size_t)b * 3 * 2048 + col;
        float x0 = st[0], x1 = st[2048], x2 = st[4096];
        float xr[8];
#pragma unroll
        for (int t = 0; t < 8; ++t) xr[t] = bf2f(XBC[(size_t)(row0 + t) * 2048 + col]);
#pragma unroll
        for (int t = 0; t < 8; ++t) {
            const float x3 = xr[t];
            const float o = siluf_(bias + w0 * x0 + w1 * x1 + w2 * x2 + w3 * x3);
            if (tid < 256) xs[t * 256 + tid] = o; else if (tid < 384) Bs[t * 128 + (tid - 256)] = o; else Cs[t * 128 + (tid - 384)] = o;
            x0 = x1; x1 = x2; x2 = x3;
        }
    }
    __syncthreads();
#pragma unroll
    for (int e = 0; e < 4; ++e) {
        const int head = 4 * g + e;
        const size_t so = ((size_t)(b * 16 + head) * 64 + p) * 128 + ns * 4;
        const float dsk = F.inp(15)[head];
#pragma unroll
        for (int t = 0; t < 8; ++t) {
            const float dec = __expf(da4[t][e]);
            const float xv = xs[t * 256 + e * 64 + p], dtx = dt4[t][e] * xv;
            float yp = 0.f, yq = 0.f;
#pragma unroll
            for (int k = 0; k < 4; ++k) {
                const f32x4 bv = *(const LAS f32x4*)(Bs + t * 128 + ns * 4 + 32 * k), cv = *(const LAS f32x4*)(Cs + t * 128 + ns * 4 + 32 * k);
                hst[e][k] = hst[e][k] * dec + bv * dtx;
                yp = __builtin_fmaf(cv.x, hst[e][k].x, yp); yq = __builtin_fmaf(cv.y, hst[e][k].y, yq);
                yp = __builtin_fmaf(cv.z, hst[e][k].z, yp); yq = __builtin_fmaf(cv.w, hst[e][k].w, yq);
            }
            yp = dpp_sum8(yp + yq);
            if (ns == 0) ys[t * 256 + e * 64 + p] = yp + dsk * xv;
            asm volatile("" ::: "memory");
        }
#pragma unroll
        for (int k = 0; k < 4; ++k) __builtin_nontemporal_store(hst[e][k], (f32x4*)(F.out + O_SAS + so + 32 * k));
    }
    __syncthreads();
    {
        const int t = F.wave, ch = 4 * lane;
        const f32x4 yv = *(const LAS f32x4*)(ys + t * 256 + ch);
        f32x4 gv; gv.x = yv.x * siluf_(bflo(zw.x)); gv.y = yv.y * siluf_(bfhi(zw.x)); gv.z = yv.z * siluf_(bflo(zw.y)); gv.w = yv.w * siluf_(bfhi(zw.y));
        const float ssq = wave_sum((gv.x * gv.x + gv.y * gv.y) + (gv.z * gv.z + gv.w * gv.w));
        const float rs = __builtin_amdgcn_rsqf(ssq * (1.0f / 256.0f) + EPS);
        const f32x4 nw = *(const f32x4*)(F.inp(16) + g * 256 + ch);
        v2u o; o.x = pk2(gv.x * rs * nw.x, gv.y * rs * nw.y); o.y = pk2(gv.z * rs * nw.z, gv.w * rs * nw.w);
        *(v2u*)zp = o;
    }
    __syncthreads();
}

__device__ __forceinline__ void ssd_cum(Frame& F, int rowc  , int g, LAS float* cum, LAS float* dtl) {
    if (F.wave < 4) {
        const int e = F.wave, l = F.lane; const float* DT = (const float*)(F.ws + WS_DT); const float* DA = (const float*)(F.ws + WS_DA);
        const float a0 = DA[(size_t)(rowc + 2 * l) * 16 + 4 * g + e], a1 = DA[(size_t)(rowc + 2 * l + 1) * 16 + 4 * g + e];
        dtl[e * 128 + 2 * l] = DT[(size_t)(rowc + 2 * l) * 16 + 4 * g + e]; dtl[e * 128 + 2 * l + 1] = DT[(size_t)(rowc + 2 * l + 1) * 16 + 4 * g + e];
        float s = a0 + a1;
#pragma unroll
        for (int o = 1; o < 64; o <<= 1) { const float t = __shfl_up(s, o); if (l >= o) s += t; }
        cum[e * 128 + 2 * l + 1] = s * 1.4426950408889634f; cum[e * 128 + 2 * l] = (s - a1) * 1.4426950408889634f;
    }
}

constexpr int SSD2_XT = 0, SSD2_BT = SSD2_XT + 256 * SSD_PITCH, SSD2_CUM = SSD2_BT + 128 * SSD_PITCH, SSD2_DT = SSD2_CUM + 4 * 128 * 4, SSD2_W = SSD2_DT + 4 * 128 * 4, SSD2_END = SSD2_W + 4 * 128 * 4;
static_assert(SSD2_END <= LDSCTL_OFF, "SSD2 LDS");
__device__ __forceinline__ void ssd_state_unit(Frame& F, int unit) {
    const int g = unit & 3, c = (unit >> 2) & 15, b = unit >> 6, tid = F.tid, lane = F.lane;
    bf16* XBC = (bf16*)(F.ws + WS_XBC); const bf16* HALO = (const bf16*)(F.ws + WS_HALO);
    bf16* SSTB = (bf16*)(F.out + O_Y); float* CDEC = (float*)(F.ws + WS_CDEC);
    LAS unsigned char* XT = F.lds + SSD2_XT; LAS unsigned char* BT = F.lds + SSD2_BT;
    LAS float* cum = (LAS float*)(F.lds + SSD2_CUM); LAS float* dtl = (LAS float*)(F.lds + SSD2_DT); LAS float* wl = (LAS float*)(F.lds + SSD2_W);
    const int rowc = b * SEQ + c * 128;
    {
        const int cp = tid & 255, th = tid >> 8;
        const int kind = (cp < 128) ? 0 : ((cp < 192) ? 1 : 2);
        const int lc = (kind == 0) ? 2 * cp : ((kind == 1) ? 2 * (cp - 128) : 2 * (cp - 192));
        const int col = (kind == 0) ? (g * 256 + lc) : ((kind == 1) ? (1024 + g * 128 + lc) : (1536 + g * 128 + lc));
        const float* cw = F.inp(11);
        const float wa0 = cw[col], wa1 = cw[2048 + col], wa2 = cw[4096 + col], wa3 = cw[6144 + col], ba = F.inp(12)[col];
        const float wb0 = cw[col + 1], wb1 = cw[2048 + col + 1], wb2 = cw[4096 + col + 1], wb3 = cw[6144 + col + 1], bb = F.inp(12)[col + 1];
        const int seg = c * 2 + th;
        float xa0 = 0.f, xa1 = 0.f, xa2 = 0.f, xb0 = 0.f, xb1 = 0.f, xb2 = 0.f;
        if (seg > 0) { const bf16* hp = HALO + ((size_t)(b * 32 + seg - 1) * 3) * 2048 + col;
            const unsigned h0 = *(const unsigned*)hp, h1 = *(const unsigned*)(hp + 2048), h2 = *(const unsigned*)(hp + 4096);
            xa0 = bflo(h0); xb0 = bfhi(h0); xa1 = bflo(h1); xb1 = bfhi(h1); xa2 = bflo(h2); xb2 = bfhi(h2); }
        const int e = lc >> 6;
        bf16* xp = XBC + (size_t)(rowc + 64 * th) * 2048 + col;
        unsigned nxt[8], nx2[8];
#pragma unroll
        for (int k = 0; k < 8; ++k) { nxt[k] = __builtin_nontemporal_load((const unsigned*)(xp + (size_t)k * 2048)); nx2[k] = __builtin_nontemporal_load((const unsigned*)(xp + (size_t)(8 + k) * 2048)); }
        ssd_cum(F, rowc, g, cum, dtl);
        __syncthreads();
        { const int e2 = tid >> 7, j = tid & 127; wl[e2 * 128 + j] = __builtin_amdgcn_exp2f(cum[e2 * 128 + 127] - cum[e2 * 128 + j]) * dtl[e2 * 128 + j];
          if (j == 127) CDEC[(b * 16 + c) * 16 + 4 * g + e2] = __builtin_amdgcn_exp2f(cum[e2 * 128 + 127]); }
        __syncthreads();
        for (int t8 = 0; t8 < 8; ++t8) {
            unsigned raw[8];
#pragma unroll
            for (int k = 0; k < 8; ++k) { raw[k] = nxt[k]; nxt[k] = nx2[k]; }
            if (t8 < 6) {
#pragma unroll
                for (int k = 0; k < 8; ++k) nx2[k] = __builtin_nontemporal_load((const unsigned*)(xp + (size_t)(t8 * 8 + 16 + k) * 2048));
            }
            unsigned oa[4], ob[4]; float pa = 0.f, pb = 0.f;
#pragma unroll
            for (int k = 0; k < 8; ++k) {
                const float xa3 = bflo(raw[k]), xb3 = bfhi(raw[k]);
                const float va = siluf_(ba + wa0 * xa0 + wa1 * xa1 + wa2 * xa2 + wa3 * xa3), vb = siluf_(bb + wb0 * xb0 + wb1 * xb1 + wb2 * xb2 + wb3 * xb3);
                xa0 = xa1; xa1 = xa2; xa2 = xa3; xb0 = xb1; xb1 = xb2; xb2 = xb3;
                *(unsigned*)(xp + (size_t)(t8 * 8 + k) * 2048) = pk2(va, vb);
                float sa = va, sb = vb;
                if (kind == 0) { const float ww = wl[e * 128 + 64 * th + t8 * 8 + k]; sa *= ww; sb *= ww; }
                if (k & 1) { oa[k >> 1] = pk2(pa, sa); ob[k >> 1] = pk2(pb, sb); } else { pa = sa; pb = sb; }
            }
            if (kind == 0) { *(LAS v4u*)(XT + lc * SSD_PITCH + (64 * th + t8 * 8) * 2) = (v4u){oa[0], oa[1], oa[2], oa[3]}; *(LAS v4u*)(XT + (lc + 1) * SSD_PITCH + (64 * th + t8 * 8) * 2) = (v4u){ob[0], ob[1], ob[2], ob[3]}; }
            else if (kind == 1) { *(LAS v4u*)(BT + lc * SSD_PITCH + (64 * th + t8 * 8) * 2) = (v4u){oa[0], oa[1], oa[2], oa[3]}; *(LAS v4u*)(BT + (lc + 1) * SSD_PITCH + (64 * th + t8 * 8) * 2) = (v4u){ob[0], ob[1], ob[2], ob[3]}; }
        }
    }
    __syncthreads();
    {
        const int e = F.wave >> 1, ph = F.wave & 1, r = lane & 31, hh = lane >> 5;
        f32x16 acc[4];
#pragma unroll
        for (int nt = 0; nt < 4; ++nt)
#pragma unroll
            for (int i = 0; i < 16; ++i) acc[nt][i] = 0.f;
#pragma unroll
        for (int s = 0; s < 8; ++s) {
            const ssd_bf16x8 a = *(const LAS ssd_bf16x8*)(XT + (e * 64 + 32 * ph + r) * SSD_PITCH + (16 * s + 8 * hh) * 2);
#pragma unroll
            for (int nt = 0; nt < 4; ++nt) {
                const ssd_bf16x8 bq = *(const LAS ssd_bf16x8*)(BT + (32 * nt + r) * SSD_PITCH + (16 * s + 8 * hh) * 2);
                acc[nt] = __builtin_amdgcn_mfma_f32_32x32x16_bf16(a, bq, acc[nt], 0, 0, 0);
            }
        }
        bf16* sp = SSTB + ((size_t)((b * 16 + c) * 16 + 4 * g + e) * 64 + 32 * ph) * 128;
#pragma unroll
        for (int nt = 0; nt < 4; ++nt)
#pragma unroll
            for (int i = 0; i < 16; ++i) { const int prow = (i & 3) + 8 * (i >> 2) + 4 * hh; sp[(size_t)prow * 128 + 32 * nt + r] = (bf16)f2bf_int(acc[nt][i]); }
    }
    __syncthreads();
}

__device__ __forceinline__ void ssd_carry(Frame& F) {
    bf16* SSTB = (bf16*)(F.out + O_Y); const float* CDEC = (const float*)(F.ws + WS_CDEC);
    const int gt = (int)blockIdx.x * 512 + F.tid, NT = F.G * 512;
    for (int idx = gt; idx < 8 * 16 * 1024; idx += NT) {
        const int q8 = idx & 1023, head = (idx >> 10) & 15, b = idx >> 14;
        float h[8];
#pragma unroll
        for (int k = 0; k < 8; ++k) h[k] = 0.f;
        v4u cur = __builtin_nontemporal_load((const v4u*)(SSTB + ((size_t)((b * 16 + 0) * 16 + head)) * 8192) + q8);
        for (int c = 0; c < 16; ++c) {
            v4u* sp = (v4u*)(SSTB + ((size_t)((b * 16 + c) * 16 + head)) * 8192) + q8;
            const v4u sv = cur;
            if (c < 15) cur = __builtin_nontemporal_load((const v4u*)(SSTB + ((size_t)((b * 16 + c + 1) * 16 + head)) * 8192) + q8);
            *sp = (v4u){pk2(h[0], h[1]), pk2(h[2], h[3]), pk2(h[4], h[5]), pk2(h[6], h[7])};
            const float d = CDEC[(b * 16 + c) * 16 + head];
            h[0] = h[0] * d + bflo(sv.x); h[1] = h[1] * d + bfhi(sv.x); h[2] = h[2] * d + bflo(sv.y); h[3] = h[3] * d + bfhi(sv.y);
            h[4] = h[4] * d + bflo(sv.z); h[5] = h[5] * d + bfhi(sv.z); h[6] = h[6] * d + bflo(sv.w); h[7] = h[7] * d + bfhi(sv.w);
        }
        f32x4* op = (f32x4*)(F.out + O_PAS + (size_t)(b * 16 + head) * 8192) + 2 * q8;
        __builtin_nontemporal_store((f32x4){h[0], h[1], h[2], h[3]}, &op[0]); __builtin_nontemporal_store((f32x4){h[4], h[5], h[6], h[7]}, &op[1]);
    }
}

constexpr int SSD4_ZP = 144, SSD4_OP = 528;
constexpr int SSD4_CS = 0, SSD4_BS = SSD4_CS + 128 * SSD_PITCH, SSD4_L = SSD4_BS + 128 * SSD_PITCH, SSD4_XT = SSD4_L + 128 * SSD_PITCH, SSD4_HIN = SSD4_XT + 64 * SSD_PITCH,
              SSD4_CUM = SSD4_HIN + 64 * SSD_PITCH, SSD4_DT = SSD4_CUM + 4 * 128 * 4, SSD4_RED = SSD4_DT + 4 * 128 * 4, SSD4_END = SSD4_RED + 2 * 128 * 4;
static_assert(SSD4_END <= LDSCTL_OFF && 128 * SSD4_ZP <= 128 * SSD_PITCH && 128 * SSD4_OP <= SSD4_XT, "SSD4 LDS");
__device__ __forceinline__ void ssd_y_unit(Frame& F, int unit) {
    const int g = unit & 3, c = (unit >> 2) & 15, b = unit >> 6, tid = F.tid, lane = F.lane, wv = F.wave, r = lane & 31, hh = lane >> 5;
    const bf16* XBC = (const bf16*)(F.ws + WS_XBC); bf16* CAT = (bf16*)(F.ws + WS_CAT); const bf16* HINB = (const bf16*)(F.out + O_Y);
    LAS unsigned char* Cs = F.lds + SSD4_CS; LAS unsigned char* Bs = F.lds + SSD4_BS; LAS unsigned char* Lm = F.lds + SSD4_L; LAS unsigned char* XT = F.lds + SSD4_XT; LAS unsigned char* Hn = F.lds + SSD4_HIN;
    LAS float* cum = (LAS float*)(F.lds + SSD4_CUM); LAS float* dtl = (LAS float*)(F.lds + SSD4_DT); LAS float* red = (LAS float*)(F.lds + SSD4_RED);
    const int rowc = b * SEQ + c * 128;
    const bool stp = unit < 256;
    if (stp) FSTAMP(F);
    unsigned pre_raw[8]; v4u pre_z[2]; v4u pre_h[2];
#define SSD4_PREFETCH(EE) do { const int _e = (EE); \
        { const int cp = tid & 31, tb = tid >> 5; _Pragma("unroll") for (int k = 0; k < 8; ++k) pre_raw[k] = __builtin_nontemporal_load((const unsigned*)(XBC + (size_t)(rowc + tb * 8 + k) * 2048 + g * 256 + _e * 64 + 2 * cp)); } \
        _Pragma("unroll") for (int k = 0; k < 2; ++k) { const int pc = tid + 512 * k, row = pc >> 3, q = pc & 7; pre_z[k] = __builtin_nontemporal_load((const v4u*)(CAT + (size_t)(rowc + row) * 2048 + g * 256 + _e * 64 + q * 8)); } \
        { const int p = tid >> 3, n0 = (tid & 7) * 16; const v4u* hp = (const v4u*)(HINB + ((size_t)((b * 16 + c) * 16 + 4 * g + _e) * 64 + p) * 128 + n0); \
          pre_h[0] = __builtin_nontemporal_load(&hp[0]); pre_h[1] = __builtin_nontemporal_load(&hp[1]); } } while (0)
    v4u bcb[4], bcc[4];
#pragma unroll
    for (int k = 0; k < 4; ++k) { const int pc = tid + 512 * k, row = pc >> 4, q = pc & 15;
        bcb[k] = __builtin_nontemporal_load((const v4u*)(XBC + (size_t)(rowc + row) * 2048 + 1024 + g * 128 + q * 8)); bcc[k] = __builtin_nontemporal_load((const v4u*)(XBC + (size_t)(rowc + row) * 2048 + 1536 + g * 128 + q * 8)); }
    SSD4_PREFETCH(0);
    ssd_cum(F, rowc, g, cum, dtl);
#pragma unroll
    for (int k = 0; k < 4; ++k) { const int pc = tid + 512 * k, row = pc >> 4, q = pc & 15;
        *(LAS v4u*)(Bs + row * SSD_PITCH + q * 16) = bcb[k]; *(LAS v4u*)(Cs + row * SSD_PITCH + q * 16) = bcc[k]; }
    __syncthreads();
    if (stp) FSTAMP(F);
    const int pw = (0x50317642 >> (4 * wv)) & 7;
    f32x16 G[2];
#pragma unroll
    for (int tt = 0; tt < 2; ++tt) {
        const int idx = 2 * pw + tt, it = idx >> 2, jt = idx & 3;
#pragma unroll
        for (int i = 0; i < 16; ++i) G[tt][i] = 0.f;
        if (jt <= it) {
#pragma unroll
            for (int s = 0; s < 8; ++s) {
                const ssd_bf16x8 a = *(const LAS ssd_bf16x8*)(Cs + (32 * it + r) * SSD_PITCH + (16 * s + 8 * hh) * 2);
                const ssd_bf16x8 bq = *(const LAS ssd_bf16x8*)(Bs + (32 * jt + r) * SSD_PITCH + (16 * s + 8 * hh) * 2);
                G[tt] = __builtin_amdgcn_mfma_f32_32x32x16_bf16(a, bq, G[tt], 0, 0, 0);
            }
        }
    }
    __syncthreads();
    if (stp) FSTAMP(F);
    const int yit = wv >> 1, ypt = wv & 1;
    v4u ya0, yb0, ya1, yb1, ya2, yb2, ya3, yb3;
    float ssq_acc = 0.f;
    for (int e = 0; e < 4; ++e) {
        asm volatile("" ::: "memory");
#pragma unroll
        for (int tt = 0; tt < 2; ++tt) {
            const int idx = 2 * pw + tt, it = idx >> 2, jt = idx & 3;
            const int j = 32 * jt + r;
            if (jt > it) {
                if (e == 0) {
#pragma unroll
                    for (int i16 = 0; i16 < 16; ++i16) { const int i = 32 * it + (i16 & 3) + 8 * (i16 >> 2) + 4 * hh; *(LAS unsigned short*)(Lm + i * SSD_PITCH + j * 2) = (unsigned short)0; }
                }
                continue;
            }
            const float cj = cum[e * 128 + j], dj = dtl[e * 128 + j];
#pragma unroll
            for (int a4 = 0; a4 < 4; ++a4) {
                const f32x4 ci = *(const LAS f32x4*)(cum + e * 128 + 32 * it + 8 * a4 + 4 * hh);
#pragma unroll
                for (int b4 = 0; b4 < 4; ++b4) {
                    const int i16 = 4 * a4 + b4, i = 32 * it + b4 + 8 * a4 + 4 * hh;
                    float v = 0.f;
                    if (j <= i) v = G[tt][i16] * __builtin_amdgcn_exp2f(ci[b4] - cj) * dj;
                    *(LAS unsigned short*)(Lm + i * SSD_PITCH + j * 2) = (unsigned short)f2bf(v);
                }
            }
        }
        { const int cp = tid & 31, tb = tid >> 5;
          v4u oa, ob;
          oa.x = (pre_raw[0] & 0xffffu) | (pre_raw[1] << 16); oa.y = (pre_raw[2] & 0xffffu) | (pre_raw[3] << 16); oa.z = (pre_raw[4] & 0xffffu) | (pre_raw[5] << 16); oa.w = (pre_raw[6] & 0xffffu) | (pre_raw[7] << 16);
          ob.x = (pre_raw[0] >> 16) | (pre_raw[1] & 0xffff0000u); ob.y = (pre_raw[2] >> 16) | (pre_raw[3] & 0xffff0000u); ob.z = (pre_raw[4] >> 16) | (pre_raw[5] & 0xffff0000u); ob.w = (pre_raw[6] >> 16) | (pre_raw[7] & 0xffff0000u);
          *(LAS v4u*)(XT + (2 * cp) * SSD_PITCH + tb * 16) = oa; *(LAS v4u*)(XT + (2 * cp + 1) * SSD_PITCH + tb * 16) = ob; }
#pragma unroll
        for (int k = 0; k < 2; ++k) { const int pc = tid + 512 * k, row = pc >> 3, q = pc & 7; *(LAS v4u*)(Bs + row * SSD4_ZP + q * 16) = pre_z[k]; }
        { const int p = tid >> 3, n0 = (tid & 7) * 16;
          *(LAS v4u*)(Hn + p * SSD_PITCH + n0 * 2) = pre_h[0]; *(LAS v4u*)(Hn + p * SSD_PITCH + n0 * 2 + 16) = pre_h[1]; }
        if (stp && e == 0) FSTAMP(F);
        __syncthreads();
        if (stp && e == 0) FSTAMP(F);
        if (e < 3) SSD4_PREFETCH(e + 1);
        f32x16 yd;
#pragma unroll
        for (int i = 0; i < 16; ++i) yd[i] = 0.f;
#pragma unroll
        for (int s = 0; s < 8; ++s) {
            const ssd_bf16x8 ah = *(const LAS ssd_bf16x8*)(Hn + (32 * ypt + r) * SSD_PITCH + (16 * s + 8 * hh) * 2);
            const ssd_bf16x8 bc = *(const LAS ssd_bf16x8*)(Cs + (32 * yit + r) * SSD_PITCH + (16 * s + 8 * hh) * 2);
            yd = __builtin_amdgcn_mfma_f32_32x32x16_bf16(ah, bc, yd, 0, 0, 0);
        }
        const float dsk = F.inp(15)[4 * g + e];
        const int ti = 32 * yit + r;
        const float ec = __builtin_amdgcn_exp2f(cum[e * 128 + ti]);
#pragma unroll
        for (int i16 = 0; i16 < 16; ++i16) {
            const int pl = 32 * ypt + (i16 & 3) + 8 * (i16 >> 2) + 4 * hh;
            const float xv = bf2f(*(const LAS unsigned short*)(XT + pl * SSD_PITCH + ti * 2));
            yd[i16] = ec * yd[i16] + dsk * xv;
        }
#pragma unroll
        for (int s = 0; s < 8; ++s) {
            const ssd_bf16x8 ax = *(const LAS ssd_bf16x8*)(XT + (32 * ypt + r) * SSD_PITCH + (16 * s + 8 * hh) * 2);
            const ssd_bf16x8 bl = *(const LAS ssd_bf16x8*)(Lm + (32 * yit + r) * SSD_PITCH + (16 * s + 8 * hh) * 2);
            yd = __builtin_amdgcn_mfma_f32_32x32x16_bf16(ax, bl, yd, 0, 0, 0);
        }
#pragma unroll
        for (int g4 = 0; g4 < 4; ++g4) {
            const v2u zw = *(const LAS v2u*)(Bs + ti * SSD4_ZP + (32 * ypt + 8 * g4 + 4 * hh) * 2);
            const float g0 = yd[4 * g4] * siluf_(bflo(zw.x)), g1 = yd[4 * g4 + 1] * siluf_(bfhi(zw.x)), g2 = yd[4 * g4 + 2] * siluf_(bflo(zw.y)), g3 = yd[4 * g4 + 3] * siluf_(bfhi(zw.y));
            yd[4 * g4] = g0; yd[4 * g4 + 1] = g1; yd[4 * g4 + 2] = g2; yd[4 * g4 + 3] = g3;
            ssq_acc += (g0 * g0 + g1 * g1) + (g2 * g2 + g3 * g3);
        }
        { const v4u pa = (v4u){pk2(yd[0], yd[1]), pk2(yd[2], yd[3]), pk2(yd[4], yd[5]), pk2(yd[6], yd[7])}, pb = (v4u){pk2(yd[8], yd[9]), pk2(yd[10], yd[11]), pk2(yd[12], yd[13]), pk2(yd[14], yd[15])};
          if (e == 0) { ya0 = pa; yb0 = pb; } else if (e == 1) { ya1 = pa; yb1 = pb; } else if (e == 2) { ya2 = pa; yb2 = pb; } else { ya3 = pa; yb3 = pb; } }
        __syncthreads();
    }
#undef SSD4_PREFETCH
    const int ti = 32 * yit + r;
    ssq_acc += __shfl_xor(ssq_acc, 32);
    if (hh == 0) red[ypt * 128 + ti] = ssq_acc;
    __syncthreads();
    LAS unsigned char* Ot = F.lds;
    {
        const float rs = __builtin_amdgcn_rsqf((red[ti] + red[128 + ti]) * (1.0f / 256.0f) + EPS);
        const float* nwp = F.inp(16) + g * 256 + 32 * ypt + 4 * hh;
#pragma unroll
        for (int g4 = 0; g4 < 4; ++g4) {
            const unsigned w00 = (g4 == 0) ? ya0.x : (g4 == 1) ? ya0.z : (g4 == 2) ? yb0.x : yb0.z, w01 = (g4 == 0) ? ya0.y : (g4 == 1) ? ya0.w : (g4 == 2) ? yb0.y : yb0.w;
            const unsigned w10 = (g4 == 0) ? ya1.x : (g4 == 1) ? ya1.z : (g4 == 2) ? yb1.x : yb1.z, w11 = (g4 == 0) ? ya1.y : (g4 == 1) ? ya1.w : (g4 == 2) ? yb1.y : yb1.w;
            const unsigned w20 = (g4 == 0) ? ya2.x : (g4 == 1) ? ya2.z : (g4 == 2) ? yb2.x : yb2.z, w21 = (g4 == 0) ? ya2.y : (g4 == 1) ? ya2.w : (g4 == 2) ? yb2.y : yb2.w;
            const unsigned w30 = (g4 == 0) ? ya3.x : (g4 == 1) ? ya3.z : (g4 == 2) ? yb3.x : yb3.z, w31 = (g4 == 0) ? ya3.y : (g4 == 1) ? ya3.w : (g4 == 2) ? yb3.y : yb3.w;
            const f32x4 n0 = *(const f32x4*)(nwp + 8 * g4), n1 = *(const f32x4*)(nwp + 64 + 8 * g4), n2 = *(const f32x4*)(nwp + 128 + 8 * g4), n3 = *(const f32x4*)(nwp + 192 + 8 * g4);
            LAS unsigned char* op = Ot + ti * SSD4_OP + (32 * ypt + 8 * g4 + 4 * hh) * 2;
            *(LAS v2u*)(op)       = (v2u){pk2(bflo(w00) * rs * n0.x, bfhi(w00) * rs * n0.y), pk2(bflo(w01) * rs * n0.z, bfhi(w01) * rs * n0.w)};
            *(LAS v2u*)(op + 128) = (v2u){pk2(bflo(w10) * rs * n1.x, bfhi(w10) * rs * n1.y), pk2(bflo(w11) * rs * n1.z, bfhi(w11) * rs * n1.w)};
            *(LAS v2u*)(op + 256) = (v2u){pk2(bflo(w20) * rs * n2.x, bfhi(w20) * rs * n2.y), pk2(bflo(w21) * rs * n2.z, bfhi(w21) * rs * n2.w)};
            *(LAS v2u*)(op + 384) = (v2u){pk2(bflo(w30) * rs * n3.x, bfhi(w30) * rs * n3.y), pk2(bflo(w31) * rs * n3.z, bfhi(w31) * rs * n3.w)};
        }
    }
    __syncthreads();
#pragma unroll
    for (int k = 0; k < 8; ++k) { const int pc = tid + 512 * k, row = pc >> 5, q = pc & 31;
        *(v4u*)(CAT + (size_t)(rowc + row) * 2048 + g * 256 + q * 8) = *(const LAS v4u*)(Ot + row * SSD4_OP + q * 16); }
    __syncthreads();
}
constexpr size_t WS_WDWT = 235 * MiB;
typedef float cf32x2 __attribute__((ext_vector_type(2)));
template <int T, int NT, bool SAMPLE>
__device__ __forceinline__ void cconv_run(Frame& F, int row0  , bool has_hist  , const float* state  ) {
    const bf16* G = (const bf16*)(F.ws + WS_G); bf16* CV = (bf16*)(F.ws + WS_CV); const float* WT = (const float*)(F.ws + WS_WDWT);
    const int tid = F.tid, lane = F.lane;
    constexpr int ROWS = T + 30;
    const unsigned* gp = (const unsigned*)(G + (size_t)row0 * 1024) + tid;
    cf32x2 xv[ROWS], wv[31];
    {
        unsigned cur[T];
        if (SAMPLE) {
            cf32x2 sv[30];
#pragma unroll
            for (int k = 0; k < 30; ++k) sv[k] = *(const cf32x2*)(state + (size_t)k * 1024 + 2 * tid);
#pragma unroll
            for (int k = 0; k < T; ++k) cur[k] = __builtin_nontemporal_load(&gp[k * 512]);
#pragma unroll
            for (int k = 0; k < 30; ++k) xv[k] = sv[k];
        } else {
            unsigned xr[30];
#pragma unroll
            for (int k = 0; k < 30; ++k) xr[k] = 0u;
            if (has_hist) {
#pragma unroll
                for (int k = 0; k < 30; ++k) xr[k] = __builtin_nontemporal_load(&gp[(k - 30) * 512]);
            }
#pragma unroll
            for (int k = 0; k < T; ++k) cur[k] = __builtin_nontemporal_load(&gp[k * 512]);
#pragma unroll
            for (int k = 0; k < 30; ++k) xv[k] = (cf32x2){bflo(xr[k]), bfhi(xr[k])};
        }
        { const f32x4* wp = (const f32x4*)(WT + (size_t)(2 * tid) * 32);
#pragma unroll
          for (int k4 = 0; k4 < 8; ++k4) { const f32x4 t4 = wp[k4], u4 = wp[8 + k4];
              wv[4 * k4] = (cf32x2){t4.x, u4.x}; wv[4 * k4 + 1] = (cf32x2){t4.y, u4.y}; wv[4 * k4 + 2] = (cf32x2){t4.z, u4.z}; if (k4 < 7) wv[4 * k4 + 3] = (cf32x2){t4.w, u4.w}; } }
#pragma unroll
        for (int k = 0; k < T; ++k) xv[30 + k] = (cf32x2){bflo(cur[k]), bfhi(cur[k])};
    }
    const cf32x2 bias2 = *(const cf32x2*)(F.inp(31) + 2 * tid);
    const cf32x2 lw = *(const cf32x2*)(F.inp(32) + 2 * tid), lb = *(const cf32x2*)(F.inp(33) + 2 * tid);
    LAS float* red = (LAS float*)(F.lds);
#pragma unroll 1
    for (int tile = 0; tile < NT; ++tile) {
        unsigned nx[T];
        if (tile + 1 < NT) {
#pragma unroll
            for (int k = 0; k < T; ++k) nx[k] = __builtin_nontemporal_load(&gp[((tile + 1) * T + k) * 512]);
        }
        float o0[T], o1[T];
#pragma unroll
        for (int t = 0; t < T; ++t) {
            cf32x2 a0 = bias2, a1 = (cf32x2){0.f, 0.f};
#pragma unroll
            for (int k = 0; k < 30; k += 2) { a0 += wv[k] * xv[t + k]; a1 += wv[k + 1] * xv[t + k + 1]; }
            a0 += wv[30] * xv[t + 30];
            a0 += a1;
            o0[t] = a0.x; o1[t] = a0.y;
        }
        LAS float* rb = red + (tile & 1) * 256;
        if constexpr (T == 16) {
            float rs, rq;
            { float sa[16];
#pragma unroll
              for (int t = 0; t < 16; ++t) sa[t] = o0[t] + o1[t];
              rs = row16_reduce_scatter(sa, lane); }
            asm volatile("" ::: "memory");
            { float qa[16];
#pragma unroll
              for (int t = 0; t < 16; ++t) qa[t] = o0[t] * o0[t] + o1[t] * o1[t];
              rq = row16_reduce_scatter(qa, lane); }
            rs += __shfl_xor(rs, 16); rq += __shfl_xor(rq, 16); rs += __shfl_xor(rs, 32); rq += __shfl_xor(rq, 32);
            if (lane < 16) { rb[lane * 16 + F.wave] = rs; rb[lane * 16 + 8 + F.wave] = rq; }
        } else {
#pragma unroll
            for (int t = 0; t < T; ++t) { const float s = wave_sum(o0[t] + o1[t]), q = wave_sum(o0[t] * o0[t] + o1[t] * o1[t]); if (lane == 0) { rb[t * 16 + F.wave] = s; rb[t * 16 + 8 + F.wave] = q; } }
        }
        __syncthreads();
        bf16* cvp = CV + (size_t)(row0 + tile * T) * 1024 + 2 * tid;
        float meanv, rstdv;
        { const int tl = lane & (T - 1);
          const f32x4 s0 = *(const LAS f32x4*)(rb + tl * 16), s1 = *(const LAS f32x4*)(rb + tl * 16 + 4), q0 = *(const LAS f32x4*)(rb + tl * 16 + 8), q1 = *(const LAS f32x4*)(rb + tl * 16 + 12);
          const float s = ((s0.x + s0.y) + (s0.z + s0.w)) + ((s1.x + s1.y) + (s1.z + s1.w)), q = ((q0.x + q0.y) + (q0.z + q0.w)) + ((q1.x + q1.y) + (q1.z + q1.w));
          meanv = s * (1.0f / 1024.0f); const float var = fmaxf(q * (1.0f / 1024.0f) - meanv * meanv, 0.f); rstdv = __builtin_amdgcn_rsqf(var + EPS); }
#pragma unroll
        for (int t = 0; t < T; ++t) {
            const float mean = __builtin_bit_cast(float, __builtin_amdgcn_readlane(__builtin_bit_cast(int, meanv), t)), rstd = __builtin_bit_cast(float, __builtin_amdgcn_readlane(__builtin_bit_cast(int, rstdv), t));
            *(unsigned*)(cvp + (size_t)t * 1024) = pk2(siluf_((o0[t] - mean) * rstd * lw.x + lb.x), siluf_((o1[t] - mean) * rstd * lw.y + lb.y));
            asm volatile("" ::: "memory");
        }
        if (tile + 1 < NT) {
#pragma unroll
            for (int k = 0; k < 30; ++k) xv[k] = xv[k + T];
#pragma unroll
            for (int k = 0; k < T; ++k) xv[30 + k] = (cf32x2){bflo(nx[k]), bfhi(nx[k])};
        }
    }
    __syncthreads();
}
constexpr int CCONV_RUNS = NBP * (SEQ / 64);
__device__ __forceinline__ void cconv_phase(Frame& F) {
    for (int b = (int)blockIdx.x; b < NBS; b += F.G) cconv_run<8, 1, true>(F, MP + 8 * b, false, F.inp(6) + (size_t)b * 30 * 1024);
    for (int u = F.vcu; u < CCONV_RUNS; u += F.G) { const int b = u >> 5, j = u & 31; cconv_run<16, 4, false>(F, b * SEQ + 64 * j, j > 0, nullptr); }
    { const bool split = (int)F.G >= 2 * NBS;
      constexpr int P9_SMALL = NBS * NWAVES;
      __syncthreads();
      if (!split) p0_weights(F, P0_PW1_ITEMS, P0_ALL_ITEMS);
      else if ((int)blockIdx.x < NBS) p0_weights(F, P0_PW1_ITEMS, P0_PW1_ITEMS + P9_SMALL, (int)blockIdx.x * NWAVES + F.wave, NBS * NWAVES);
      else p0_weights(F, P0_PW1_ITEMS + P9_SMALL, P0_ALL_ITEMS, ((int)blockIdx.x - NBS) * NWAVES + F.wave, ((int)F.G - NBS) * NWAVES);
      __syncthreads(); }
    for (int b = (int)F.G - 1 - (int)blockIdx.x; b < NBS; b += F.G) { const float* st = F.inp(6) + (size_t)b * 30 * 1024;
        for (int i = F.tid; i < 22 * 256; i += NWAVES * 64) __builtin_nontemporal_store(__builtin_nontemporal_load(&((const f32x4*)(st + 8 * 1024))[i]), &((f32x4*)(F.out + O_SCC + (size_t)b * 30 * 1024))[i]);
    }
}
#define P2_WEIGHTS() do { __syncthreads(); p0_weights(F, P0_WIN_ITEMS, P0_L0_ITEMS); __syncthreads(); } while (0)
#define PHASE2_BODY { \
    const bool wfirst = ((bx >> 4) & 1) != 0; \
    if (wfirst) P2_WEIGHTS(); \
    if ((bx >> 3) & 1) { for (int u = bx; u < 512; u += F.G) ssd_sample_unit(F, u); TSTAMP(); } \
    { S5Consts K5; int kg = -1; for (int u = bx; u < S5_UNITS; u += F.G) s5_block_unit(F, u, K5, kg); } \
    __syncthreads(); TSTAMP(); \
    if (!wfirst) P2_WEIGHTS(); \
    for (int u = bx; u < 512; u += F.G) ssd_state_unit(F, u); TSTAMP(); \
    if (!((bx >> 3) & 1)) { for (int u = bx; u < 512; u += F.G) ssd_sample_unit(F, u); TSTAMP(); } }
#define PHASE3_BODY { ssd_carry(F); }
#define PHASE4_GLU() do { \
        { const int _pre = (F.vcu & 1); pg8::gemm_tail<pg8::EpiGlu>(lds_s + RING_OFF, g.A + (size_t)MP * g.lda, g.lda, g.Bt, g.K, g.N / 64, E, F.vcu, F.G, 0, _pre); } \
        pg8::gemm_phase<pg8::EpiGlu, pg8::StaticOrder, true, true>(lds_s + RING_OFF, g, S, E); \
        { const int _pre = (F.vcu & 1); pg8::gemm_tail<pg8::EpiGlu>(lds_s + RING_OFF, g.A + (size_t)MP * g.lda, g.lda, g.Bt, g.K, g.N / 64, E, F.vcu, F.G, _pre, 1); } } while (0)
#define PHASE4_BODY { \
    pg8::Gemm g{U, (const bf16*)(F.ws + WS_WGLU), MT, 1024, 1024, 1024}; pg8::StaticOrder S; S.init(MP, 1024, F.G, bx); \
    pg8::EpiGlu E{U, CAT, F.inp(26)}; \
    const bool glu_first = ((F.vcu >> 1) & 1) != 0;                        \
    if (!glu_first) { __syncthreads(); p0_weights(F, P0_L0_ITEMS, P0_PW1_ITEMS); __syncthreads(); }        \
    if (glu_first) PHASE4_GLU(); \
    for (int u = bx; u < 512; u += F.G) ssd_y_unit(F, u); TSTAMP(); \
    if (glu_first) { __syncthreads(); p0_weights(F, P0_L0_ITEMS, P0_PW1_ITEMS); __syncthreads(); } \
    if (!glu_first) PHASE4_GLU(); \
    TSTAMP(); }
#define PHASE9_BODY { cconv_phase(F); }
struct Args { const float* in[38]; float* out; unsigned char* ws; int ph_lo, ph_hi; };
constexpr int N_PHASES = 14;

__global__ void __launch_bounds__(NWAVES * 64, 2) hybrid_fwd(Args args) {
    extern __shared__ __attribute__((aligned(16))) unsigned char lds[];
    Frame F;
    { unsigned vz; asm volatile("v_mov_b32 %0, 0" : "=v"(vz)); F.lds = (LAS unsigned char*)lds + vz; }
    LAS unsigned char* const lds_s = (LAS unsigned char*)lds;
    F.MISC = (volatile LAS unsigned*)(F.lds + MISC_OFF);
    F.tid = threadIdx.x; F.lane = F.tid & 63; F.wave = __builtin_amdgcn_readfirstlane(F.tid >> 6);
    F.G = gridDim.x; { const int bx = blockIdx.x; F.vcu = (F.G % 8 == 0) ? (bx % 8) * (F.G / 8) + bx / 8 : bx; }
    F.ws = args.ws; F.out = args.out; F.ctl = (gu32*)(args.ws + WS_CTL);
    F.in = (LAS cfp*)(F.lds + PTRTAB_OFF);
    for (int u = F.tid; u < (LDS_BYTES - LDSCTL_OFF) / 4; u += NWAVES * 64) ((LAS unsigned*)(F.lds + LDSCTL_OFF))[u] = 0u;
    __syncthreads();
    if (F.tid < 38) F.in[F.tid] = args.in[F.tid];
    __syncthreads();
    XcdBarrier bar = xcd_barrier_post((unsigned*)(F.ctl + CW_BAR), F.MISC + 8);
    const int lo = args.ph_lo, hi = args.ph_hi;
#define IN(k) (lo <= (k) && (k) < hi)
#if defined(MK_TIMING)
    volatile LAS unsigned* TS = (volatile LAS unsigned*)(F.lds + LDSCTL_OFF);
    F.nts = 0;
#define TSTAMP() FSTAMP(F)
#define SEAM(k) do { if (IN(k) && IN((k) + 1)) xcd_barrier(bar); TSTAMP(); } while (0)
    TSTAMP();
#else
#define TSTAMP() do {} while (0)
#define SEAM(k) do { if (IN(k) && IN((k) + 1)) xcd_barrier(bar); } while (0)
#endif

    bf16* CAT = (bf16*)(F.ws + WS_CAT); bf16* XBC = (bf16*)(F.ws + WS_XBC); bf16* U = (bf16*)(F.ws + WS_U); bf16* XB = (bf16*)(F.ws + WS_XB);
    bf16* H = (bf16*)(F.ws + WS_H); bf16* Gb = (bf16*)(F.ws + WS_G); bf16* CV = (bf16*)(F.ws + WS_CV);
    float* SS = (float*)(F.ws + WS_SS); float* X = F.out + O_Y;
    const int bx = (int)blockIdx.x;

    if (IN(0)) { p0_prologue(F); } SEAM(0);
    if (IN(1)) {
        pg8::Gemm g{CAT + 1024, (const bf16*)(F.ws + WS_WIN), MT, 4096, 1024, 2048}; pg8::StaticOrder S; S.init(MP, 4096, F.G, bx);
        pg8::EpiInProj E{CAT, XBC, U, SS, F.out, (bf16*)(F.ws + WS_HALO)};
        if ((F.vcu & 1)) pg8::gemm_tail_wide<4, pg8::EpiInProj>(lds_s + RING_OFF, g.A + (size_t)MP * g.lda, g.lda, g.Bt, g.K, E, F.vcu, F.G);
        pg8::gemm_phase<pg8::EpiInProj, pg8::StaticOrder, true, true>(lds_s + RING_OFF, g, S, E, SS); TSTAMP();
        if (!(F.vcu & 1)) pg8::gemm_tail_wide<4, pg8::EpiInProj>(lds_s + RING_OFF, g.A + (size_t)MP * g.lda, g.lda, g.Bt, g.K, E, F.vcu, F.G);
    } SEAM(1);
    if (IN(2)) { PHASE2_BODY } SEAM(2);
    if (IN(3)) { PHASE3_BODY } SEAM(3);
    if (IN(4)) { PHASE4_BODY } SEAM(4);
    if (IN(5)) {
        pg8::Gemm g{CAT, (const bf16*)(F.ws + WS_WOUT), MT, 1024, 2048, 2048}; pg8::StaticOrder S; S.init(MP, 1024, F.G, bx);
        pg8::EpiRes E{F.inp(0), F.inp(1), nullptr, nullptr, XB, SS, nullptr};
        { const int _n = (g.N / 64) * 16 / F.G, _pre = (_n == 1) ? (F.vcu & 1) : ((_n * (F.vcu & 3)) >> 2); pg8::gemm_tail<pg8::EpiRes>(lds_s + RING_OFF, g.A + (size_t)MP * g.lda, g.lda, g.Bt, g.K, g.N / 64, E, F.vcu, F.G, 0, _pre); }
        pg8::gemm_phase<pg8::EpiRes, pg8::StaticOrder, true, true>(lds_s + RING_OFF, g, S, E); TSTAMP();
        { const int _n = (g.N / 64) * 16 / F.G, _pre = (_n == 1) ? (F.vcu & 1) : ((_n * (F.vcu & 3)) >> 2); pg8::gemm_tail<pg8::EpiRes>(lds_s + RING_OFF, g.A + (size_t)MP * g.lda, g.lda, g.Bt, g.K, g.N / 64, E, F.vcu, F.G, _pre, _n); }
    } SEAM(5);
    if (IN(6)) {
        pg8::Gemm g{XB, (const bf16*)(F.ws + WS_WFF1), MT, FF, 1024, 1024}; pg8::StaticOrder S; S.init(MP, FF, F.G, bx);
        pg8::EpiFF1 E{H, SS};
        if ((F.vcu & 1)) pg8::gemm_tail_wide<4, pg8::EpiFF1>(lds_s + RING_OFF, g.A + (size_t)MP * g.lda, g.lda, g.Bt, g.K, E, F.vcu, F.G);
        pg8::gemm_phase<pg8::EpiFF1, pg8::StaticOrder, true, true>(lds_s + RING_OFF, g, S, E, SS); TSTAMP();
        if (!(F.vcu & 1)) pg8::gemm_tail_wide<4, pg8::EpiFF1>(lds_s + RING_OFF, g.A + (size_t)MP * g.lda, g.lda, g.Bt, g.K, E, F.vcu, F.G);
    } SEAM(6);
    if (IN(7)) {
        pg8::Gemm g{H, (const bf16*)(F.ws + WS_WFF2), MT, 1024, FF, FF}; pg8::StaticOrder S; S.init(MP, 1024, F.G, bx);
        pg8::EpiRes E{nullptr, nullptr, XB, nullptr, XB, SS, nullptr};
        { const int _n = (g.N / 64) * 16 / F.G, _pre = (_n == 1) ? (F.vcu & 1) : ((_n * (F.vcu & 3)) >> 2); pg8::gemm_tail<pg8::EpiRes>(lds_s + RING_OFF, g.A + (size_t)MP * g.lda, g.lda, g.Bt, g.K, g.N / 64, E, F.vcu, F.G, 0, _pre); }
        pg8::gemm_phase<pg8::EpiRes, pg8::StaticOrder, true, true>(lds_s + RING_OFF, g, S, E); TSTAMP();
        { const int _n = (g.N / 64) * 16 / F.G, _pre = (_n == 1) ? (F.vcu & 1) : ((_n * (F.vcu & 3)) >> 2); pg8::gemm_tail<pg8::EpiRes>(lds_s + RING_OFF, g.A + (size_t)MP * g.lda, g.lda, g.Bt, g.K, g.N / 64, E, F.vcu, F.G, _pre, _n); }
    } SEAM(7);
    if (IN(8)) {
        pg8::Gemm g{XB, (const bf16*)(F.ws + WS_WPW1), MT, 2048, 1024, 1024}; pg8::StaticOrder S; S.init(MP, 2048, F.G, bx);
        pg8::EpiPw1 E{Gb, SS, F.inp(29), F.out};
        if ((F.vcu & 1)) pg8::gemm_tail_wide<2, pg8::EpiPw1>(lds_s + RING_OFF, g.A + (size_t)MP * g.lda, g.lda, g.Bt, g.K, E, F.vcu, F.G);
        pg8::gemm_phase<pg8::EpiPw1, pg8::StaticOrder, true, true>(lds_s + RING_OFF, g, S, E, SS); TSTAMP();
        if (!(F.vcu & 1)) pg8::gemm_tail_wide<2, pg8::EpiPw1>(lds_s + RING_OFF, g.A + (size_t)MP * g.lda, g.lda, g.Bt, g.K, E, F.vcu, F.G);
    } SEAM(8);
    if (IN(9)) { PHASE9_BODY } SEAM(9);
    if (IN(10)) {
        pg8::Gemm g{CV, (const bf16*)(F.ws + WS_WPW2), MT, 1024, 1024, 1024}; pg8::StaticOrder S; S.init(MP, 1024, F.G, bx);
        pg8::EpiRes E{nullptr, nullptr, XB, nullptr, XB, SS, F.inp(35)};
        { const int _n = (g.N / 64) * 16 / F.G, _pre = (_n == 1) ? (F.vcu & 1) : ((_n * (F.vcu & 3)) >> 2); pg8::gemm_tail<pg8::EpiRes>(lds_s + RING_OFF, g.A + (size_t)MP * g.lda, g.lda, g.Bt, g.K, g.N / 64, E, F.vcu, F.G, 0, _pre); }
        pg8::gemm_phase<pg8::EpiRes, pg8::StaticOrder, true, true>(lds_s + RING_OFF, g, S, E); TSTAMP();
        { const int _n = (g.N / 64) * 16 / F.G, _pre = (_n == 1) ? (F.vcu & 1) : ((_n * (F.vcu & 3)) >> 2); pg8::gemm_tail<pg8::EpiRes>(lds_s + RING_OFF, g.A + (size_t)MP * g.lda, g.lda, g.Bt, g.K, g.N / 64, E, F.vcu, F.G, _pre, _n); }
    } SEAM(10);
    if (IN(11)) {
        pg8::Gemm g{XB, (const bf16*)(F.ws + WS_WFF1) + (size_t)FF * 1024, MT, FF, 1024, 1024}; pg8::StaticOrder S; S.init(MP, FF, F.G, bx);
        pg8::EpiFF1 E{H, SS};
        if ((F.vcu & 1)) pg8::gemm_tail_wide<4, pg8::EpiFF1>(lds_s + RING_OFF, g.A + (size_t)MP * g.lda, g.lda, g.Bt, g.K, E, F.vcu, F.G);
        pg8::gemm_phase<pg8::EpiFF1, pg8::StaticOrder, true, true>(lds_s + RING_OFF, g, S, E, SS); TSTAMP();
        if (!(F.vcu & 1)) pg8::gemm_tail_wide<4, pg8::EpiFF1>(lds_s + RING_OFF, g.A + (size_t)MP * g.lda, g.lda, g.Bt, g.K, E, F.vcu, F.G);
    } SEAM(11);
    if (IN(12)) {
        pg8::Gemm g{H, (const bf16*)(F.ws + WS_WFF2) + (size_t)1024 * FF, MT, 1024, FF, FF}; pg8::StaticOrder S; S.init(MP, 1024, F.G, bx);
        pg8::EpiRes E{nullptr, nullptr, XB, nullptr, XB, SS, nullptr};
        { const int _n = (g.N / 64) * 16 / F.G, _pre = (_n == 1) ? (F.vcu & 1) : ((_n * (F.vcu & 3)) >> 2); pg8::gemm_tail<pg8::EpiRes>(lds_s + RING_OFF, g.A + (size_t)MP * g.lda, g.lda, g.Bt, g.K, g.N / 64, E, F.vcu, F.G, 0, _pre); }
        pg8::gemm_phase<pg8::EpiRes, pg8::StaticOrder, true, true>(lds_s + RING_OFF, g, S, E); TSTAMP();
        { const int _n = (g.N / 64) * 16 / F.G, _pre = (_n == 1) ? (F.vcu & 1) : ((_n * (F.vcu & 3)) >> 2); pg8::gemm_tail<pg8::EpiRes>(lds_s + RING_OFF, g.A + (size_t)MP * g.lda, g.lda, g.Bt, g.K, g.N / 64, E, F.vcu, F.G, _pre, _n); }
    } SEAM(12);
    if (IN(13)) {
        const int gw = F.vcu * NWAVES + F.wave, NGW = F.G * NWAVES; const float* nf = F.inp(9);
        f32x4 wv[4];
#pragma unroll
        for (int j = 0; j < 2; ++j) { wv[2 * j] = ((const f32x4*)nf)[128 * j + 2 * F.lane]; wv[2 * j + 1] = ((const f32x4*)nf)[128 * j + 2 * F.lane + 1]; }
        for (int m = gw; m < MT; m += NGW) {
            const float rs = row_rstd(SS, m);
            const v4u* xb = (const v4u*)(XB + (size_t)m * DM) + F.lane;
            f32x4* yr = (f32x4*)(X + (size_t)m * DM) + 2 * F.lane;
#pragma unroll
            for (int j = 0; j < 2; ++j) { const v4u w = __builtin_nontemporal_load(&xb[64 * j]);
                __builtin_nontemporal_store((f32x4){bflo(w.x), bfhi(w.x), bflo(w.y), bfhi(w.y)} * rs * wv[2 * j], &yr[128 * j]);
                __builtin_nontemporal_store((f32x4){bflo(w.z), bfhi(w.z), bflo(w.w), bfhi(w.w)} * rs * wv[2 * j + 1], &yr[128 * j + 1]); }
        }
    }
#if defined(MK_TIMING)
    TSTAMP();
    xcd_barrier(bar);
    if (blockIdx.x == 0) {
        __syncthreads();
#if defined(MK_COLDPROBE)
        { volatile unsigned* cwp = (volatile unsigned*)(F.ws + 65536 + 256); volatile unsigned* store = (volatile unsigned*)(F.ws + 65536 + 512);
          const bool cold = (*cwp == 0xAAAAAAAAu);
          __syncthreads();
          if (F.tid < 64) { if (cold) store[F.tid] = TS[F.tid]; else TS[F.tid] = store[F.tid]; }
          __syncthreads();
          if (F.tid == 0) *cwp = 0x12345678u;
          __syncthreads(); }
#endif
        const size_t offs[12] = {O_Y, O_Y + (size_t)MP * 1024, O_PAC, O_PAS, O_PBR, O_PBI, O_PCC, O_SAC, O_SAS, O_SBR, O_SBI, O_SCC};
#pragma unroll
        for (int k = 0; k < 12; ++k) {
            const unsigned t0 = TS[MK_TIMING + k], t1 = (MK_TIMING + k + 1 < F.nts) ? TS[MK_TIMING + k + 1] : t0;
#if defined(MK_DEBUGCNT)
            const unsigned us = __hip_atomic_load((unsigned*)(F.ws + WS_CTL) + 2048 + k, __ATOMIC_RELAXED, __HIP_MEMORY_SCOPE_AGENT);
#else
            const unsigned us = (t1 - t0) / 100u;
#endif
            for (unsigned i = F.tid; i < us; i += NWAVES * 64) ((unsigned*)F.out)[offs[k] + i] = 0xAAAAAAAAu;
        }
    }
#endif
#undef IN
#undef SEAM
}

extern "C" void kernel_launch(void* const* d_in, const int* in_sizes, int n_in, void* d_out, int out_size, void* d_ws, size_t ws_size, hipStream_t stream) {
    static int grid = 0;
    if (grid == 0) {
        if (n_in != 38 || out_size != (int)O_END || ws_size < WS_END) { fprintf(stderr, "kernel_launch: unexpected shapes: n_in %d out %d ws %zu\n", n_in, out_size, ws_size); grid = -1; return; }
        int dev = 0, cus = 0, per_cu = 0;
        if (hipGetDevice(&dev) != hipSuccess || hipDeviceGetAttribute(&cus, hipDeviceAttributeMultiprocessorCount, dev) != hipSuccess) { grid = -1; return; }
        if (hipFuncSetAttribute((const void*)hybrid_fwd, hipFuncAttributeMaxDynamicSharedMemorySize, LDS_BYTES) != hipSuccess) { fprintf(stderr, "kernel_launch: hipFuncSetAttribute failed\n"); grid = -1; return; }
        if (hipOccupancyMaxActiveBlocksPerMultiprocessor(&per_cu, (const void*)hybrid_fwd, NWAVES * 64, LDS_BYTES) != hipSuccess || per_cu < 1)
            fprintf(stderr, "kernel_launch: note: occupancy query reports %d blocks per CU\n", per_cu);
        (void)hipGetLastError();
        grid = cus;
    }
    if (grid < 0) return;
    if (hipMemsetAsync((char*)d_ws + WS_CTL, 0, CTL_ZERO_BYTES, stream) != hipSuccess) { fprintf(stderr, "kernel_launch: memset failed\n"); return; }
    Args a{};
    for (int i = 0; i < 38; ++i) a.in[i] = (const float*)d_in[i];
    a.out = (float*)d_out; a.ws = (unsigned char*)d_ws;
#if MK_N_LAUNCHES == 1
    a.ph_lo = 0; a.ph_hi = N_PHASES;
    hipLaunchKernelGGL(hybrid_fwd, dim3(grid), dim3(NWAVES * 64), LDS_BYTES, stream, a);
#else
    for (int p = 0; p < N_PHASES; ++p) { a.ph_lo = p; a.ph_hi = p + 1; hipLaunchKernelGGL(hybrid_fwd, dim3(grid), dim3(NWAVES * 64), LDS_BYTES, stream, a); }
#endif
    const hipError_t le = hipPeekAtLastError();
    if (le != hipSuccess) fprintf(stderr, "kernel_launch: launch failed: %s\n", hipGetErrorName(le));
}
```
